# Optimizing an MI355X kernel written in HIP

```python
import math
import jax, jax.numpy as jnp
from jax import lax
import numpy as np

D_MODEL = 1024
BATCH = 2
SEQ = 8192
DEPTH = 2

CHUNK = 64
N_MIXERS = 2

SG_FFN = 6 * D_MODEL
SG_WIDTH = SG_FFN // 2
SG_BLOCK = 128
SG_GROUPS = 8
SG_GC = SG_WIDTH // SG_GROUPS

GLA_HEADS = 4
GLA_KD = D_MODEL // 2
GLA_VD = D_MODEL
GLA_DK = GLA_KD // GLA_HEADS
GLA_DV = GLA_VD // GLA_HEADS
GLA_RANK = 16
GLA_TAU = 16.0
GLA_IN = 2 * GLA_KD + 2 * GLA_VD + GLA_RANK

FFN_HIDDEN = ((8 * D_MODEL + 3 * 256 - 1) // (3 * 256)) * 256

EPS = 1e-6

kernel_name = "hybrid_gmlp_gla_chunk_causal_trunk"


def rmsnorm(x, g):
    xf = x.astype(jnp.float32)
    y = xf * lax.rsqrt(jnp.mean(xf * xf, axis=-1, keepdims=True) + EPS)
    return (y * g.astype(jnp.float32)).astype(x.dtype)


def layernorm(x, g, b):
    xf = x.astype(jnp.float32)
    mu = jnp.mean(xf, axis=-1, keepdims=True)
    xc = xf - mu
    y = xc * lax.rsqrt(jnp.mean(xc * xc, axis=-1, keepdims=True) + EPS)
    return (y * g.astype(jnp.float32) + b.astype(jnp.float32)).astype(x.dtype)


def sgu_mixer(h, w_in, ln_g, ln_b, w_s, b_s, w_out):
    B_, T, _ = h.shape
    z = jax.nn.gelu(h @ w_in, approximate=False)
    u, v = jnp.split(z, 2, axis=-1)
    v = layernorm(v, ln_g, ln_b)
    n = T // SG_BLOCK
    v = v.reshape(B_, n, SG_BLOCK, SG_GROUPS, SG_GC)
    chunk_id = jnp.arange(SG_BLOCK) // CHUNK
    mask = chunk_id[:, None] >= chunk_id[None, :]
    ws = jnp.where(mask[None], w_s, jnp.zeros((), w_s.dtype))
    s = jnp.einsum('gts,bnsgc->bntgc', ws, v) + b_s.T[None, None, :, :, None]
    y = u * s.reshape(B_, T, SG_WIDTH)
    return y @ w_out


def gla_mixer(h, w_in, w_g2, b_g, gn_g, w_out):
    B_, T, _ = h.shape
    proj = h @ w_in
    q, k, v, r, gz = jnp.split(
        proj, [GLA_KD, 2 * GLA_KD, 2 * GLA_KD + GLA_VD, 2 * GLA_KD + 2 * GLA_VD], axis=-1)
    log_a = jax.nn.log_sigmoid((gz @ w_g2 + b_g).astype(jnp.float32)) / GLA_TAU
    n = T // CHUNK

    def to_chunks(z, d):
        return z.astype(jnp.float32).reshape(B_, n, CHUNK, GLA_HEADS, d).transpose(1, 0, 3, 2, 4)

    qc = to_chunks(q, GLA_DK) * (GLA_DK ** -0.5)
    kc = to_chunks(k, GLA_DK)
    vc = to_chunks(v, GLA_DV)
    Gc = jnp.cumsum(to_chunks(log_a, GLA_DK), axis=3)
    causal = jnp.tril(jnp.ones((CHUNK, CHUNK), dtype=bool))

    def step(S, inp):
        qi, ki, vi, Gi = inp
        diff = Gi[:, :, :, None, :] - Gi[:, :, None, :, :]
        decay = jnp.exp(jnp.where(causal[None, None, :, :, None], diff, -jnp.inf))
        A = jnp.sum(qi[:, :, :, None, :] * ki[:, :, None, :, :] * decay, axis=-1)
        o = jnp.einsum('bhij,bhjv->bhiv', A, vi) + jnp.einsum('bhik,bhkv->bhiv', qi * jnp.exp(Gi), S)
        G_last = Gi[:, :, -1:, :]
        S = jnp.exp(G_last[:, :, 0, :])[..., None] * S + jnp.einsum(
            'bhjk,bhjv->bhkv', ki * jnp.exp(G_last - Gi), vi)
        return S, o

    S0 = jnp.zeros((B_, GLA_HEADS, GLA_DK, GLA_DV), jnp.float32)
    _, o = lax.scan(step, S0, (qc, kc, vc, Gc))
    o = o.transpose(1, 0, 3, 2, 4).reshape(B_, T, GLA_HEADS, GLA_DV)
    o = o * lax.rsqrt(jnp.mean(o * o, axis=-1, keepdims=True) + EPS) * gn_g.astype(jnp.float32)
    o = o.reshape(B_, T, GLA_VD).astype(h.dtype)
    return (jax.nn.silu(r) * o) @ w_out


def swiglu(h, w_gate, w_up, w_down):
    return (jax.nn.silu(h @ w_gate) * (h @ w_up)) @ w_down


def setup_inputs(seed: int = 0) -> dict:
    key = jax.random.key(seed)
    ks = jax.random.split(key, 24)
    na = (DEPTH + 1) // 2
    nb = DEPTH // 2
    f32 = jnp.float32

    def w(k, shape, fan_in):
        return jax.random.normal(k, shape, f32) * (fan_in ** -0.5)

    def gain(k, shape):
        return 1.0 + 0.05 * jax.random.normal(k, shape, f32)

    return {
        "x": jax.random.normal(ks[0], (BATCH, SEQ, D_MODEL), f32),
        "mix_norm": gain(ks[1], (DEPTH, D_MODEL)),
        "a_w_in": w(ks[2], (na, D_MODEL, SG_FFN), D_MODEL),
        "a_ln_g": gain(ks[3], (na, SG_WIDTH)),
        "a_ln_b": 0.02 * jax.random.normal(ks[4], (na, SG_WIDTH), f32),
        "a_w_s": w(ks[5], (na, SG_GROUPS, SG_BLOCK, SG_BLOCK), SG_BLOCK),
        "a_b_s": gain(ks[6], (na, SG_GROUPS, SG_BLOCK)),
        "a_w_out": w(ks[7], (na, SG_WIDTH, D_MODEL), SG_WIDTH),
        "b_w_in": w(ks[8], (nb, D_MODEL, GLA_IN), D_MODEL),
        "b_w_g2": w(ks[9], (nb, GLA_RANK, GLA_KD), GLA_RANK),
        "b_b_g": 0.01 * jax.random.normal(ks[10], (nb, GLA_KD), f32),
        "b_gn_g": gain(ks[11], (nb, GLA_HEADS, GLA_DV)),
        "b_w_out": w(ks[12], (nb, GLA_VD, D_MODEL), GLA_VD),
        "ffn_norm": gain(ks[13], (DEPTH, D_MODEL)),
        "ffn_w_gate": w(ks[14], (DEPTH, D_MODEL, FFN_HIDDEN), D_MODEL),
        "ffn_w_up": w(ks[15], (DEPTH, D_MODEL, FFN_HIDDEN), D_MODEL),
        "ffn_w_down": w(ks[16], (DEPTH, FFN_HIDDEN, D_MODEL), FFN_HIDDEN),
        "final_norm": gain(ks[17], (D_MODEL,)),
    }


def reference(x, mix_norm, a_w_in, a_ln_g, a_ln_b, a_w_s, a_b_s, a_w_out,
              b_w_in, b_w_g2, b_b_g, b_gn_g, b_w_out,
              ffn_norm, ffn_w_gate, ffn_w_up, ffn_w_down, final_norm):
    for i in range(DEPTH):
        h = rmsnorm(x, mix_norm[i])
        j = i // N_MIXERS
        if i % N_MIXERS == 0:
            x = x + sgu_mixer(h, a_w_in[j], a_ln_g[j], a_ln_b[j], a_w_s[j], a_b_s[j], a_w_out[j])
        else:
            x = x + gla_mixer(h, b_w_in[j], b_w_g2[j], b_b_g[j], b_gn_g[j], b_w_out[j])
        h = rmsnorm(x, ffn_norm[i])
        x = x + swiglu(h, ffn_w_gate[i], ffn_w_up[i], ffn_w_down[i])
    return rmsnorm(x, final_norm)
```

```cpp
#include <hip/hip_runtime.h>
#include <hip/hip_cooperative_groups.h>
#include <cstdio>
#include <cstdint>
namespace cg = cooperative_groups;
namespace pg8 {
#define PG8_LAS __attribute__((address_space(3)))
typedef unsigned short bf16_t;
typedef short bf16x8 __attribute__((ext_vector_type(8)));
typedef float f32x4 __attribute__((ext_vector_type(4)));
typedef unsigned u32x4 __attribute__((ext_vector_type(4)));
constexpr int BM = 256, BK = 64, HALF = 128, HTB = HALF * BK * 2  , STAGE_BYTES = 8 * HTB, NXCD = 8, WGM = 8;

__host__ __device__ __forceinline__ int lds_byte(int r, int c) { const int st = (r >> 4) * 2 + (c >> 5), rr = r & 15, cc = c & 31, ob = rr * 64 + cc * 2; return st * 1024 + (ob ^ (((ob >> 9) & 1) << 5)); }
__host__ __device__ __forceinline__ void stage_rc(int b, int& R, int& C) { const int st = b / 1024, sb = b % 1024, swz = sb ^ (((sb >> 9) & 1) << 5); R = (st >> 1) * 16 + swz / 64; C = (st & 1) * 32 + (swz % 64) / 2; }
__host__ __device__ __forceinline__ int perm32(int rho) { const int n = rho >> 4, i = rho & 15; return 8 * (i >> 2) + 4 * n + (i & 3); }

struct Unit { int pm, pn; };
struct Gemm { const bf16_t* A; const bf16_t* Bt; int M, N, K; };

struct StaticOrder {
    int nM, nN, nwg, G, c;
    __host__ __device__ void init(int M, int N, int G_, int c_) { nM = M / BM; nN = N / BM; nwg = nM * nN; G = G_; c = c_; }
    __host__ __device__ bool next(int i, Unit& u) const {
        const long L = (long)i * G + c; if (L >= nwg) return false;
        int wgid = (int)L; { const int q = nwg / NXCD, r = nwg % NXCD, xcd = wgid % NXCD, off = wgid / NXCD; wgid = (xcd < r ? xcd * (q + 1) : r * (q + 1) + (xcd - r) * q) + off; }
        const int nig = WGM * nN, gid = wgid / nig, fm = gid * WGM, gsz = (nM - fm) < WGM ? (nM - fm) : WGM;
        u.pm = fm + ((wgid % nig) % gsz); u.pn = (wgid % nig) / gsz; return true;
    }
    __device__ __forceinline__ void a_ready(const Unit&) const {}
    __device__ __forceinline__ void done(const Unit&) const {}
};

typedef float f32x2 __attribute__((ext_vector_type(2)));
typedef __bf16 bf16x2v __attribute__((ext_vector_type(2)));
__device__ __forceinline__ unsigned cvt_pk_bf16(float lo, float hi) { const bf16x2v r = __builtin_convertvector((f32x2){lo, hi}, bf16x2v); return __builtin_bit_cast(unsigned, r); }
__device__ __forceinline__ f32x2 gelu_pk(f32x2 v) {
    const f32x2 av = __builtin_elementwise_abs(v), d = av * 0.2316418882f + 1.0f;
    f32x2 t; t.x = __builtin_amdgcn_rcpf(d.x); t.y = __builtin_amdgcn_rcpf(d.y);
    f32x2 q = t * 0.5307027145f + (-0.7265760135f); q = q * t + 0.7107068705f; q = q * t + (-0.142248368f); q = q * t + 0.127414796f; q = q * t;
    const f32x2 s = (v * v) * (-0.72134752044f);
    f32x2 e; e.x = __builtin_amdgcn_exp2f(s.x); e.y = __builtin_amdgcn_exp2f(s.y);
    const f32x2 m = v * (q * e), r = v - m;
    f32x2 o; o.x = v.x < 0.f ? m.x : r.x; o.y = v.y < 0.f ? m.y : r.y; return o;
}

constexpr int EM = 16384;
constexpr float EEPS = 1e-6f;
__device__ __forceinline__ float row_rs(const float* rsq, int row) {
    const f32x4 p = *(const f32x4*)(rsq + (size_t)row * 4);
    return __builtin_amdgcn_rsqf(((p[0] + p[1]) + (p[2] + p[3])) * (1.0f / 1024.0f) + EEPS);
}
__device__ __forceinline__ float silu_f(float v) { return v * __builtin_amdgcn_rcpf(1.0f + __expf(-v)); }

struct EpiSguIn {
    static constexpr bool PERM = true, AFTER_DRAIN = false;
    bf16_t* U; bf16_t* V; const float* rsq; f32x2* statP;
    __device__ __forceinline__ void operator()(const f32x4 (&acc)[2][2][4][2], const Unit& u, int wr, int wc, int fr, int fq) const {
        const bool isv = u.pn >= 12;
        bf16_t* base = isv ? V : U; const int colt = (isv ? u.pn - 12 : u.pn) * BM + wc * 32 + 8 * fq;
        const int row0 = u.pm * BM + wr * 64 + fr;
#pragma unroll
        for (int ai = 0; ai < 2; ++ai)
#pragma unroll
            for (int m = 0; m < 4; ++m) { const int row = row0 + ai * HALF + m * 16; const float rs = row_rs(rsq, row);
                bf16_t* rowp = base + (size_t)row * 3072 + colt; float s1 = 0.f, s2 = 0.f;
#pragma unroll
                for (int bj = 0; bj < 2; ++bj) { const f32x4 v0 = acc[ai][bj][m][0] * rs, v1 = acc[ai][bj][m][1] * rs;
                    const f32x2 a = gelu_pk((f32x2){v0[0], v0[1]}), b = gelu_pk((f32x2){v0[2], v0[3]}), c = gelu_pk((f32x2){v1[0], v1[1]}), d = gelu_pk((f32x2){v1[2], v1[3]});
                    s1 += ((a.x + a.y) + (b.x + b.y)) + ((c.x + c.y) + (d.x + d.y));
                    s2 += ((a.x * a.x + a.y * a.y) + (b.x * b.x + b.y * b.y)) + ((c.x * c.x + c.y * c.y) + (d.x * d.x + d.y * d.y));
                    u32x4 w; w.x = cvt_pk_bf16(a.x, a.y); w.y = cvt_pk_bf16(b.x, b.y); w.z = cvt_pk_bf16(c.x, c.y); w.w = cvt_pk_bf16(d.x, d.y);
                    *(u32x4*)(rowp + bj * HALF) = w; }
                if (isv) { s1 += __shfl_xor(s1, 16); s1 += __shfl_xor(s1, 32); s2 += __shfl_xor(s2, 16); s2 += __shfl_xor(s2, 32);
                    if (fq == 0) statP[(size_t)((u.pn - 12) * 4 + wc) * EM + row] = (f32x2){s1, s2}; } }
    }
};
struct EpiSwiGLU {
    static constexpr bool PERM = true, AFTER_DRAIN = false;
    bf16_t* Hd; int ldh; const float* rsq;
    __device__ __forceinline__ void operator()(const f32x4 (&acc)[2][2][4][2], const Unit& u, int wr, int wc, int fr, int fq) const {
        const int row0 = u.pm * BM + wr * 64 + fr, col0 = u.pn * HALF + wc * 32 + 8 * fq;
#pragma unroll
        for (int ai = 0; ai < 2; ++ai)
#pragma unroll
            for (int m = 0; m < 4; ++m) { const int row = row0 + ai * HALF + m * 16; const float rs = row_rs(rsq, row);
                const f32x4 g0 = acc[ai][0][m][0] * rs, g1 = acc[ai][0][m][1] * rs, u0 = acc[ai][1][m][0] * rs, u1 = acc[ai][1][m][1] * rs;
                u32x4 w; w.x = cvt_pk_bf16(silu_f(g0[0]) * u0[0], silu_f(g0[1]) * u0[1]); w.y = cvt_pk_bf16(silu_f(g0[2]) * u0[2], silu_f(g0[3]) * u0[3]);
                w.z = cvt_pk_bf16(silu_f(g1[0]) * u1[0], silu_f(g1[1]) * u1[1]); w.w = cvt_pk_bf16(silu_f(g1[2]) * u1[2], silu_f(g1[3]) * u1[3]);
                *(u32x4*)(Hd + (size_t)row * ldh + col0) = w; }
    }
};
struct EpiGlaIn {
    static constexpr bool PERM = true, AFTER_DRAIN = false;
    bf16_t* Q; bf16_t* Kk; bf16_t* Vv; bf16_t* SR; float* GZ; const float* rsq;
    __device__ __forceinline__ void operator()(const f32x4 (&acc)[2][2][4][2], const Unit& u, int wr, int wc, int fr, int fq) const {
        const int row0 = u.pm * BM + wr * 64 + fr, pn = u.pn;
        if (pn == 12) {
            if (wc == 0 && fq < 2) {
#pragma unroll
                for (int ai = 0; ai < 2; ++ai)
#pragma unroll
                    for (int m = 0; m < 4; ++m) { const int row = row0 + ai * HALF + m * 16; const float rs = row_rs(rsq, row);
                        float* p = GZ + (size_t)row * 16 + 8 * fq; *(f32x4*)p = acc[ai][0][m][0] * rs; *(f32x4*)(p + 4) = acc[ai][0][m][1] * rs; }
            }
            return;
        }
        bf16_t* base; int ld, colt; float sc = 1.f; const bool act = pn >= 8;
        if (pn < 2) { base = Q; ld = 512; colt = pn * BM; sc = 0.08838834764831845f; } else if (pn < 4) { base = Kk; ld = 512; colt = (pn - 2) * BM; }
        else if (pn < 8) { base = Vv; ld = 1024; colt = (pn - 4) * BM; } else { base = SR; ld = 1024; colt = (pn - 8) * BM; }
        colt += wc * 32 + 8 * fq;
#pragma unroll
        for (int ai = 0; ai < 2; ++ai)
#pragma unroll
            for (int m = 0; m < 4; ++m) { const int row = row0 + ai * HALF + m * 16; const float rs = row_rs(rsq, row) * sc;
                bf16_t* rowp = base + (size_t)row * ld + colt;
#pragma unroll
                for (int bj = 0; bj < 2; ++bj) { f32x4 v0 = acc[ai][bj][m][0] * rs, v1 = acc[ai][bj][m][1] * rs;
                    if (act) { v0 = (f32x4){silu_f(v0[0]), silu_f(v0[1]), silu_f(v0[2]), silu_f(v0[3])}; v1 = (f32x4){silu_f(v1[0]), silu_f(v1[1]), silu_f(v1[2]), silu_f(v1[3])}; }
                    u32x4 w; w.x = cvt_pk_bf16(v0[0], v0[1]); w.y = cvt_pk_bf16(v0[2], v0[3]); w.z = cvt_pk_bf16(v1[0], v1[1]); w.w = cvt_pk_bf16(v1[2], v1[3]);
                    *(u32x4*)(rowp + bj * HALF) = w; } }
    }
};
struct EpiResid {
    static constexpr bool PERM = false, AFTER_DRAIN = true;
    const float* base; float* out; bf16_t* xb; float* rsq;
    __device__ __forceinline__ void fused(f32x4 (&acc)[2][2][4][2], const Unit& u, int wr, int wc, int fr, int fq, PG8_LAS unsigned char* lds, int wid, int lane) const {
        typedef unsigned u32x2v __attribute__((ext_vector_type(2)));
        PG8_LAS float* P = (PG8_LAS float*)lds;
        const int col0 = u.pn * BM + wc * 32 + 4 * fq;
#pragma unroll
        for (int ai = 0; ai < 2; ++ai)
#pragma unroll
            for (int m = 0; m < 4; ++m) { const int r = ai * HALF + wr * 64 + m * 16 + fr; const size_t off = (size_t)(u.pm * BM + r) * 1024 + col0; float ss = 0.f;
#pragma unroll
                for (int bj = 0; bj < 2; ++bj)
#pragma unroll
                    for (int n = 0; n < 2; ++n) { const f32x4 o = *(const f32x4*)(base + off + bj * HALF + n * 16) + acc[ai][bj][m][n];
                        *(f32x4*)(out + off + bj * HALF + n * 16) = o; u32x2v w; w.x = cvt_pk_bf16(o[0], o[1]); w.y = cvt_pk_bf16(o[2], o[3]);
                        *(u32x2v*)(xb + off + bj * HALF + n * 16) = w; ss += (o[0] * o[0] + o[1] * o[1]) + (o[2] * o[2] + o[3] * o[3]); }
                ss += __shfl_xor(ss, 16); ss += __shfl_xor(ss, 32);
                if (fq == 0) P[r * 4 + wc] = ss;
                if (m & 1) asm volatile("" ::: "memory"); }
        asm volatile("s_waitcnt lgkmcnt(0)" ::: "memory"); __builtin_amdgcn_s_barrier(); asm volatile("" ::: "memory");
        const int t = wid * 64 + lane;
        if (t < 256) { const f32x4 p = *(const PG8_LAS f32x4*)(P + t * 4); rsq[(size_t)(u.pm * BM + t) * 4 + u.pn] = (p[0] + p[1]) + (p[2] + p[3]); }
    }
};
template <class Epi, class Sched, bool ALIGN_EPI = false, bool SP2 = false>
__device__ __forceinline__ void gemm_phase(PG8_LAS unsigned char* lds, const Gemm g, const Sched& S, const Epi& E) {
    const int tid = threadIdx.x, wid = __builtin_amdgcn_readfirstlane(tid >> 6), lane = tid & 63, wr = wid >> 2, wc = wid & 3, fr = lane & 15, fq = lane >> 4;
    const int K = g.K, nt = K / BK;
    unsigned voffA[2], voffB[2];
#pragma unroll
    for (int i = 0; i < 2; ++i) { int R, C; stage_rc(tid * 16 + i * 8192, R, C); const int Rb = Epi::PERM ? ((R & ~31) + perm32(R & 31)) : R;
        voffA[i] = (unsigned)(R * K + C) * 2u; voffB[i] = (unsigned)(Rb * K + C) * 2u; }
    const size_t kstep = (size_t)(BK * 2);
    const size_t hstep = (size_t)HALF * K * 2;
    const size_t tstep = 2 * hstep;
    const unsigned ldsw = (unsigned)wid * 1024u;
    const int aoff = lds_byte(wr * 64 + fr, fq * 8), boff = lds_byte(wc * 32 + fr, fq * 8);
#define PG8_SA(b, h) (((b) * 2 + (h)) * HTB)
#define PG8_SB(b, h) ((4 + (b) * 2 + (h)) * HTB)
#define PG8_STAGE(bufoff, gbase, voff) do { _Pragma("unroll") for (int _i = 0; _i < 2; ++_i) \
        __builtin_amdgcn_global_load_lds((const unsigned*)((const char*)(gbase) + (voff)[_i]), (PG8_LAS unsigned*)(lds + (bufoff) + ldsw + _i * 8192), 16, 0, 0); } while (0)
#define PG8_LDA(dst, b, h) do { _Pragma("unroll") for (int m = 0; m < 4; ++m) _Pragma("unroll") for (int k = 0; k < 2; ++k) dst[m][k] = *(const PG8_LAS bf16x8*)(lds + PG8_SA(b, h) + aoff + m * 2048 + k * 1024); } while (0)
#define PG8_LDB(dst, b, h) do { _Pragma("unroll") for (int n = 0; n < 2; ++n) _Pragma("unroll") for (int k = 0; k < 2; ++k) dst[n][k] = *(const PG8_LAS bf16x8*)(lds + PG8_SB(b, h) + boff + n * 2048 + k * 1024); } while (0)
#define PG8_MMA(ai, bj, At, Bt) do { __builtin_amdgcn_s_setprio(1); _Pragma("unroll") for (int m = 0; m < 4; ++m) _Pragma("unroll") for (int n = 0; n < 2; ++n) _Pragma("unroll") for (int k = 0; k < 2; ++k) \
        acc[ai][bj][m][n] = __builtin_amdgcn_mfma_f32_16x16x32_bf16(Bt[n][k], At[m][k], acc[ai][bj][m][n], 0, 0, 0); __builtin_amdgcn_s_setprio(0); } while (0)
#define PG8_WAIT_V(n) asm volatile("s_waitcnt vmcnt(" #n ")" ::: "memory")
#define PG8_WAIT_L(n) asm volatile("s_waitcnt lgkmcnt(" #n ")" ::: "memory")
#define PG8_BAR __builtin_amdgcn_s_barrier()
#define PG8_SCHED __builtin_amdgcn_sched_barrier(0)
    Unit cur, nxt; int ui = 0;
    if (!S.next(0, cur)) return;
    f32x4 acc[2][2][4][2];
#pragma unroll
    for (int a = 0; a < 2; ++a)
#pragma unroll
        for (int b = 0; b < 2; ++b)
#pragma unroll
            for (int m = 0; m < 4; ++m)
#pragma unroll
                for (int n = 0; n < 2; ++n) acc[a][b][m][n] = (f32x4){0.f, 0.f, 0.f, 0.f};
    bf16x8 At[4][2], B0[2][2], B1[2][2];
    const char* cA = (const char*)g.A + (size_t)cur.pm * tstep; const char* cB = (const char*)g.Bt + (size_t)cur.pn * tstep;
    S.a_ready(cur);
    if constexpr (SP2) {
        PG8_STAGE(PG8_SB(0, 0), cB, voffB); PG8_STAGE(PG8_SB(0, 1), cB + hstep, voffB); PG8_STAGE(PG8_SA(0, 0), cA, voffA); PG8_STAGE(PG8_SA(0, 1), cA + hstep, voffA);
        if (wr == 1) PG8_BAR;
        PG8_WAIT_V(2); PG8_BAR;
        PG8_STAGE(PG8_SB(1, 0), cB + kstep, voffB); PG8_STAGE(PG8_SA(1, 0), cA + kstep, voffA); PG8_STAGE(PG8_SB(1, 1), cB + hstep + kstep, voffB);
        PG8_WAIT_V(6); PG8_BAR;
    } else {
        PG8_STAGE(PG8_SB(0, 0), cB, voffB); PG8_STAGE(PG8_SA(0, 0), cA, voffA); PG8_STAGE(PG8_SB(0, 1), cB + hstep, voffB); PG8_STAGE(PG8_SA(0, 1), cA + hstep, voffA);
        if (wr == 1) PG8_BAR;
        PG8_WAIT_V(4); PG8_BAR;
        PG8_STAGE(PG8_SB(1, 0), cB + kstep, voffB); PG8_STAGE(PG8_SA(1, 0), cA + kstep, voffA); PG8_STAGE(PG8_SB(1, 1), cB + hstep + kstep, voffB);
        PG8_WAIT_V(6); PG8_BAR;
    }
    for (;;) {
        const bool has_next = S.next(ui + 1, nxt);
        const char* nA = has_next ? (const char*)g.A + (size_t)nxt.pm * tstep : cA; const char* nB = has_next ? (const char*)g.Bt + (size_t)nxt.pn * tstep : cB;
        for (int t = 0; t < nt; t += 2) {
            const bool last = (t == nt - 2);
            const char* a1 = cA + (size_t)(t + 1) * kstep;
            const char* a2 = last ? nA : cA + (size_t)(t + 2) * kstep; const char* b2 = last ? nB : cB + (size_t)(t + 2) * kstep;
            const char* a3 = a2 + kstep; const char* b3 = b2 + kstep;
            if (last && has_next) S.a_ready(nxt);
            if constexpr (SP2) {
            PG8_LDB(B0, 0, 0); PG8_LDB(B1, 0, 1); PG8_SCHED; PG8_LDA(At, 0, 0); PG8_STAGE(PG8_SA(1, 1), a1 + hstep, voffA);
            PG8_WAIT_V(8); PG8_WAIT_L(0); PG8_BAR; PG8_MMA(0, 0, At, B0); PG8_MMA(0, 1, At, B1); PG8_BAR; PG8_SCHED;
            PG8_LDA(At, 0, 1); PG8_STAGE(PG8_SB(0, 0), b2, voffB); PG8_STAGE(PG8_SB(0, 1), b2 + hstep, voffB); PG8_STAGE(PG8_SA(0, 0), a2, voffA);
            PG8_WAIT_V(8); PG8_WAIT_L(0); PG8_BAR; PG8_MMA(1, 0, At, B0); PG8_MMA(1, 1, At, B1); PG8_BAR; PG8_SCHED;
            PG8_LDB(B0, 1, 0); PG8_LDB(B1, 1, 1); PG8_SCHED; PG8_LDA(At, 1, 0); PG8_STAGE(PG8_SA(0, 1), a2 + hstep, voffA);
            PG8_WAIT_V(8); PG8_WAIT_L(0); PG8_BAR; PG8_MMA(0, 0, At, B0); PG8_MMA(0, 1, At, B1); PG8_BAR; PG8_SCHED;
            PG8_LDA(At, 1, 1); PG8_STAGE(PG8_SB(1, 0), b3, voffB); PG8_STAGE(PG8_SB(1, 1), b3 + hstep, voffB); PG8_STAGE(PG8_SA(1, 0), a3, voffA);
            PG8_WAIT_V(8); PG8_WAIT_L(0); PG8_BAR; PG8_MMA(1, 0, At, B0); PG8_MMA(1, 1, At, B1); PG8_BAR; PG8_SCHED;
            } else {
            PG8_LDB(B0, 0, 0); PG8_SCHED; PG8_LDA(At, 0, 0); PG8_STAGE(PG8_SA(1, 1), a1 + hstep, voffA);
            PG8_WAIT_L(8); PG8_BAR; PG8_WAIT_L(0); PG8_MMA(0, 0, At, B0); PG8_BAR; PG8_SCHED;
            PG8_LDB(B1, 0, 1); PG8_STAGE(PG8_SB(0, 0), b2, voffB);
            PG8_BAR; PG8_WAIT_L(0); PG8_MMA(0, 1, At, B1); PG8_BAR;
            PG8_LDA(At, 0, 1); PG8_STAGE(PG8_SA(0, 0), a2, voffA);
            PG8_BAR; PG8_WAIT_L(0); PG8_MMA(1, 0, At, B0); PG8_BAR; PG8_SCHED;
            PG8_STAGE(PG8_SB(0, 1), b2 + hstep, voffB);
            PG8_WAIT_V(6); PG8_BAR; PG8_MMA(1, 1, At, B1); PG8_BAR;
            PG8_LDB(B0, 1, 0); PG8_SCHED; PG8_LDA(At, 1, 0); PG8_STAGE(PG8_SA(0, 1), a2 + hstep, voffA);
            PG8_WAIT_L(8); PG8_BAR; PG8_WAIT_L(0); PG8_MMA(0, 0, At, B0); PG8_BAR; PG8_SCHED;
            PG8_LDB(B1, 1, 1); PG8_STAGE(PG8_SB(1, 0), b3, voffB);
            PG8_BAR; PG8_WAIT_L(0); PG8_MMA(0, 1, At, B1); PG8_BAR;
            PG8_LDA(At, 1, 1); PG8_STAGE(PG8_SA(1, 0), a3, voffA);
            PG8_BAR; PG8_WAIT_L(0); PG8_MMA(1, 0, At, B0); PG8_BAR; PG8_SCHED;
            PG8_STAGE(PG8_SB(1, 1), b3 + hstep, voffB);
            PG8_WAIT_V(6); PG8_BAR; PG8_MMA(1, 1, At, B1); PG8_BAR;
            }
        }
        if constexpr (ALIGN_EPI) { if (wr == 0) PG8_BAR; }
        if constexpr (!Epi::AFTER_DRAIN) { E(acc, cur, wr, wc, fr, fq); S.done(cur); }
        if (!has_next) break;
#pragma unroll
        for (int a = 0; a < 2; ++a)
#pragma unroll
            for (int b = 0; b < 2; ++b)
#pragma unroll
                for (int m = 0; m < 4; ++m)
#pragma unroll
                    for (int n = 0; n < 2; ++n) acc[a][b][m][n] = (f32x4){0.f, 0.f, 0.f, 0.f};
        cur = nxt; cA = nA; cB = nB; ++ui;
        if constexpr (ALIGN_EPI) { if (wr == 1) PG8_BAR; }
    }
    PG8_WAIT_V(0);
    if constexpr (!ALIGN_EPI) { if (wr == 0) PG8_BAR; }
    PG8_BAR;
    if constexpr (Epi::AFTER_DRAIN) { E.fused(acc, cur, wr, wc, fr, fq, lds, wid, lane); S.done(cur); }
#undef PG8_SA
#undef PG8_SB
#undef PG8_STAGE
#undef PG8_LDA
#undef PG8_LDB
#undef PG8_MMA
#undef PG8_WAIT_V
#undef PG8_WAIT_L
#undef PG8_BAR
#undef PG8_SCHED
}
}

constexpr int NWAVES = 8, NTHREADS = 512;
constexpr int BATCH = 2, T = 8192, D = 1024, M = BATCH * T;
constexpr int SGF = 6144, SGW = 3072, SGC = 384;
constexpr int KD = 512, VD = 1024, DK = 128, DV = 256, GIN = 3088, GIN_PAD = 3328;
constexpr int FH = 2816;
constexpr int NITEM = (M / 64) * 4;
constexpr float EPS = 1e-6f;
static_assert(M == pg8::EM, "rows");

constexpr size_t MiB = 1u << 20;
constexpr size_t WS_WAIN = 1 * MiB, WS_WAOUT = 13 * MiB, WS_WGU0 = 19 * MiB, WS_WGU1 = 30 * MiB, WS_WDN0 = 41 * MiB, WS_WDN1 = 46 * MiB + MiB / 2;
constexpr size_t WS_WBIN = 52 * MiB, WS_WBOUT = 58 * MiB + MiB / 2, WS_WM = 60 * MiB + MiB / 2;
constexpr size_t WS_RU = 61 * MiB, WS_RV = 157 * MiB;
constexpr size_t WS_RSQ = 253 * MiB, WS_GZ = 253 * MiB + MiB / 2, WS_DEC = 254 * MiB + MiB / 2, WS_END = 256 * MiB;
constexpr int LDS_BYTES = 147456, RING_BYTES = 131072;

#define GAS __attribute__((address_space(1)))
#define LAS __attribute__((address_space(3)))
typedef unsigned short bf16;
typedef unsigned v4u __attribute__((ext_vector_type(4)));
typedef unsigned v2u __attribute__((ext_vector_type(2)));
typedef float f32x4 __attribute__((ext_vector_type(4)));
typedef float f32x2 __attribute__((ext_vector_type(2)));
typedef short bf16x8 __attribute__((ext_vector_type(8)));
typedef short s16x4 __attribute__((ext_vector_type(4)));
#define LDS_WAIT() asm volatile("s_waitcnt lgkmcnt(0)" ::: "memory")
__device__ __forceinline__ unsigned f2bf(float f) { unsigned u = __builtin_bit_cast(unsigned, f); return (u + 0x7fffu + ((u >> 16) & 1u)) >> 16; }
__device__ __forceinline__ unsigned pk2(float lo, float hi) { return pg8::cvt_pk_bf16(lo, hi); }
__device__ __forceinline__ float bf_lo(unsigned w) { return __builtin_bit_cast(float, w << 16); }
__device__ __forceinline__ float bf_hi(unsigned w) { return __builtin_bit_cast(float, w & 0xffff0000u); }
__device__ __forceinline__ float bf1(bf16 h) { return __builtin_bit_cast(float, (unsigned)h << 16); }
__device__ __forceinline__ float wave_sum(float v) {
#pragma unroll
    for (int o = 1; o < 64; o <<= 1) v += __shfl_xor(v, o);
    return v;
}
#ifndef USE_TR
#define USE_TR 1
#endif
__device__ __forceinline__ bf16x8 tr_frag(LAS unsigned char* tile, int pitch, int k0, int n0, int lane) {
#if USE_TR
    const int g = lane >> 4, q = (lane & 15) >> 2, p = lane & 3;
    LAS unsigned char* a0 = tile + (k0 + 8 * g + q) * pitch + (n0 + 4 * p) * 2;
    const s16x4 lo = __builtin_amdgcn_ds_read_tr16_b64_v4i16((LAS s16x4*)a0);
    const s16x4 hi = __builtin_amdgcn_ds_read_tr16_b64_v4i16((LAS s16x4*)(a0 + 4 * pitch));
    return (bf16x8){lo[0], lo[1], lo[2], lo[3], hi[0], hi[1], hi[2], hi[3]};
#else
    bf16x8 r; const int g = lane >> 4;
#pragma unroll
    for (int j = 0; j < 8; ++j) r[j] = *(LAS short*)(tile + (k0 + 8 * g + j) * pitch + (n0 + (lane & 15)) * 2);
    return r;
#endif
}
#define MFMA16(a, b, c) __builtin_amdgcn_mfma_f32_16x16x32_bf16((a), (b), (c), 0, 0, 0)

__device__ __forceinline__ void p0_transpose_item(const float* W, int K, int N, bf16* WT, int drow0, const float* gain, LAS float* scr, int k0, int n0, int lane) {
    const int n = n0 + (lane & 31);
#pragma unroll 8
    for (int i = 0; i < 32; ++i) { const int kk = 2 * i + (lane >> 5); float v = (n < N) ? W[(size_t)(k0 + kk) * N + n] : 0.f; if (gain) v *= gain[k0 + kk]; scr[kk * 33 + (lane & 31)] = v; }
    LDS_WAIT(); asm volatile("" ::: "memory");
    const int c = lane & 7;
#pragma unroll
    for (int j = 0; j < 4; ++j) { const int nn = (lane >> 3) + 8 * j; const LAS float* s = scr + (8 * c) * 33 + nn;
        v4u o; o.x = pk2(s[0 * 33], s[1 * 33]); o.y = pk2(s[2 * 33], s[3 * 33]); o.z = pk2(s[4 * 33], s[5 * 33]); o.w = pk2(s[6 * 33], s[7 * 33]);
        *(GAS v4u*)(WT + (size_t)(drow0 + nn) * K + k0 + 8 * c) = o; }
    LDS_WAIT(); asm volatile("" ::: "memory");
}

struct Args { const float* in[18]; float* out; unsigned char* ws; int ph_lo, ph_hi; };

__device__ __forceinline__ void p0_prologue(const Args& A, LAS unsigned char* lds, int gw, int NGW, int lane, int wave, int gtid, int NGT) {
    LAS float* scr = (LAS float*)(lds + wave * 16384);
    unsigned char* ws = A.ws;
    const float* mixn = A.in[1]; const float* ffnn = A.in[13];
    constexpr int I_AIN = 16 * 192, I_AOUT = 48 * 32, I_GU = 16 * 88, I_DN = 44 * 32, I_BIN = 16 * 97, I_BOUT = 16 * 32;
    constexpr int NITEMS = I_AIN + I_AOUT + 4 * I_GU + 2 * I_DN + I_BIN + I_BOUT;
    for (int it = gw; it < NITEMS; it += NGW) {
        int r = it;
        if (r < I_AIN) { const int kb = r / 192, nb = r % 192; p0_transpose_item(A.in[2], D, SGF, (bf16*)(ws + WS_WAIN), 32 * nb, mixn, scr, 64 * kb, 32 * nb, lane); continue; } r -= I_AIN;
        if (r < I_AOUT) { const int kb = r / 32, nb = r % 32; p0_transpose_item(A.in[7], SGW, D, (bf16*)(ws + WS_WAOUT), 32 * nb, nullptr, scr, 64 * kb, 32 * nb, lane); continue; } r -= I_AOUT;
        if (r < 4 * I_GU) { const int l = r / (2 * I_GU), r2 = r % (2 * I_GU), up = r2 / I_GU, r3 = r2 % I_GU, kb = r3 / 88, nb = r3 % 88, n0 = 32 * nb;
            const float* W = (up ? A.in[15] : A.in[14]) + (size_t)l * D * FH;
            p0_transpose_item(W, D, FH, (bf16*)(ws + (l ? WS_WGU1 : WS_WGU0)), 256 * (n0 >> 7) + (n0 & 127) + 128 * up, ffnn + l * D, scr, 64 * kb, n0, lane); continue; } r -= 4 * I_GU;
        if (r < 2 * I_DN) { const int l = r / I_DN, r2 = r % I_DN, kb = r2 / 32, nb = r2 % 32;
            p0_transpose_item(A.in[16] + (size_t)l * FH * D, FH, D, (bf16*)(ws + (l ? WS_WDN1 : WS_WDN0)), 32 * nb, nullptr, scr, 64 * kb, 32 * nb, lane); continue; } r -= 2 * I_DN;
        if (r < I_BIN) { const int kb = r / 97, nb = r % 97; p0_transpose_item(A.in[8], D, GIN, (bf16*)(ws + WS_WBIN), 32 * nb, mixn + D, scr, 64 * kb, 32 * nb, lane); continue; } r -= I_BIN;
        { const int kb = r / 32, nb = r % 32; p0_transpose_item(A.in[12], D, D, (bf16*)(ws + WS_WBOUT), 32 * nb, nullptr, scr, 64 * kb, 32 * nb, lane); }
    }
    { GAS v4u* z = (GAS v4u*)(ws + WS_WBIN + (size_t)3104 * D * 2); const int nz = (GIN_PAD - 3104) * D * 2 / 16;
      for (int i = gtid; i < nz; i += NGT) z[i] = (v4u){0u, 0u, 0u, 0u}; }
    { const float* wsrc = A.in[5]; bf16* wm = (bf16*)(ws + WS_WM);
      for (int i = gtid; i < 8 * 128 * 128 / 2; i += NGT) { const int e = 2 * i, t = (e >> 7) & 127, s = e & 127; const bool keep = (t >= 64) || (s < 64);
          const f32x2 v = *(const f32x2*)(wsrc + e); ((GAS unsigned*)wm)[i] = keep ? pk2(v.x, v.y) : 0u; } }
    { const float* x = A.in[0]; bf16* xb0 = (bf16*)A.out; float* rsq = (float*)(ws + WS_RSQ);
      for (int m = gw; m < M; m += NGW) { const GAS f32x4* xr = (const GAS f32x4*)(x + (size_t)m * D) + lane; f32x4 v[4]; float s = 0.f;
#pragma unroll
          for (int j = 0; j < 4; ++j) { v[j] = xr[64 * j]; s += (v[j].x * v[j].x + v[j].y * v[j].y) + (v[j].z * v[j].z + v[j].w * v[j].w); }
          s = wave_sum(s);
          GAS v2u* o8 = (GAS v2u*)(xb0 + (size_t)m * D) + lane;
#pragma unroll
          for (int j = 0; j < 4; ++j) o8[64 * j] = (v2u){pk2(v[j].x, v[j].y), pk2(v[j].z, v[j].w)};
          if (lane == 0) *(f32x4*)(rsq + (size_t)m * 4) = (f32x4){s, 0.f, 0.f, 0.f}; } }
}

__device__ __forceinline__ void sgu_phase(LAS unsigned char* lds, const bf16* Wm, const bf16* V, bf16* UY, const f32x2* statP, const float* ln_g, const float* ln_b, const float* b_s,
                                          int G, int bid, int tid, int lane, int wid) {
    constexpr int PA = 272;
    LAS unsigned char* As = lds; LAS unsigned char* Bs = lds + 34816;
    LAS f32x2* red = (LAS f32x2*)(lds + 69632); LAS f32x2* murs = (LAS f32x2*)(lds + 69632 + 4096);
    const int wr = wid >> 2, wc = wid & 3, fr = lane & 15, fq = lane >> 4;
    for (int item = bid; item < 256; item += G) {
        const int w = item >> 1, hh = item & 1, row0 = w * 128;
        { const int r = tid & 127, part = tid >> 7; float s1 = 0.f, s2 = 0.f;
#pragma unroll
          for (int j = 0; j < 12; ++j) { const f32x2 p = statP[(size_t)(part * 12 + j) * M + row0 + r]; s1 += p.x; s2 += p.y; }
          red[part * 128 + r] = (f32x2){s1, s2}; }
        __syncthreads();
        if (tid < 128) { const f32x2 a = red[tid], b = red[128 + tid], c = red[256 + tid], d = red[384 + tid];
            const float mean = ((a.x + b.x) + (c.x + d.x)) * (1.0f / 3072.0f), ex2 = ((a.y + b.y) + (c.y + d.y)) * (1.0f / 3072.0f);
            murs[tid] = (f32x2){mean, __builtin_amdgcn_rsqf(fmaxf(ex2 - mean * mean, 0.f) + EPS)}; }
        __syncthreads();
        const int ch = tid & 15, srow = tid >> 4;
        for (int gi = 0; gi < 4; ++gi) { const int g = hh * 4 + gi;
#pragma unroll
            for (int i = 0; i < 4; ++i) { const int id = tid + 512 * i, r = id >> 4, c = id & 15; *(LAS v4u*)(As + r * PA + c * 16) = *(const GAS v4u*)(Wm + (size_t)(g * 128 + r) * 128 + c * 8); }
            for (int cb = 0; cb < 3; ++cb) { const int c0 = g * SGC + cb * 128;
                const f32x4 lg0 = *(const f32x4*)(ln_g + c0 + 8 * ch), lg1 = *(const f32x4*)(ln_g + c0 + 8 * ch + 4), lb0 = *(const f32x4*)(ln_b + c0 + 8 * ch), lb1 = *(const f32x4*)(ln_b + c0 + 8 * ch + 4);
#pragma unroll
                for (int i = 0; i < 4; ++i) { const int s = srow + 32 * i; const v4u raw = *(const GAS v4u*)(V + (size_t)(row0 + s) * SGW + c0 + 8 * ch); const f32x2 ms = murs[s];
                    const f32x4 a = (f32x4){bf_lo(raw.x), bf_hi(raw.x), bf_lo(raw.y), bf_hi(raw.y)}, b = (f32x4){bf_lo(raw.z), bf_hi(raw.z), bf_lo(raw.w), bf_hi(raw.w)};
                    const f32x4 ya = (a - ms.x) * ms.y * lg0 + lb0, yb = (b - ms.x) * ms.y * lg1 + lb1;
                    *(LAS v4u*)(Bs + s * PA + ch * 16) = (v4u){pk2(ya[0], ya[1]), pk2(ya[2], ya[3]), pk2(yb[0], yb[1]), pk2(yb[2], yb[3])}; }
                __syncthreads();
                f32x4 acc[4][2];
#pragma unroll
                for (int m = 0; m < 4; ++m) { acc[m][0] = (f32x4){0.f, 0.f, 0.f, 0.f}; acc[m][1] = (f32x4){0.f, 0.f, 0.f, 0.f}; }
#pragma unroll
                for (int ks = 0; ks < 4; ++ks) { bf16x8 bfr[4];
#pragma unroll
                    for (int m = 0; m < 4; ++m) bfr[m] = *(const LAS bf16x8*)(As + (wr * 64 + m * 16 + fr) * PA + (ks * 32 + fq * 8) * 2);
#pragma unroll
                    for (int n = 0; n < 2; ++n) { const bf16x8 afr = tr_frag(Bs, PA, ks * 32, wc * 32 + n * 16, lane);
#pragma unroll
                        for (int m = 0; m < 4; ++m) acc[m][n] = MFMA16(afr, bfr[m], acc[m][n]); } }
#pragma unroll
                for (int m = 0; m < 4; ++m) { const int t = wr * 64 + m * 16 + fr; const float bs = b_s[g * 128 + t];
#pragma unroll
                    for (int n = 0; n < 2; ++n) { GAS v2u* p = (GAS v2u*)(UY + (size_t)(row0 + t) * SGW + c0 + wc * 32 + n * 16 + 4 * fq); const v2u uu = *p; const f32x4 sv = acc[m][n] + bs;
                        *p = (v2u){pk2(bf_lo(uu.x) * sv[0], bf_hi(uu.x) * sv[1]), pk2(bf_lo(uu.y) * sv[2], bf_hi(uu.y) * sv[3])}; } }
                __syncthreads();
            }
        }
    }
}

__device__ __forceinline__ float logsig16(float z) { return (fminf(z, 0.f) - __logf(1.0f + __expf(-fabsf(z)))) * (1.0f / 16.0f); }
#define GLA_G(lds, GZ, w_g2, b_g, r0, h, tid, Gv, Glast) do { \
    LAS float* gzs_ = (LAS float*)(lds); LAS float* tot_ = (LAS float*)((lds) + 4096); \
    if ((tid) < 256) *(LAS f32x4*)(gzs_ + 4 * (tid)) = *(const GAS f32x4*)((GZ) + (size_t)(r0) * 16 + 4 * (tid)); \
    const int kk_ = (tid) & 127, seg_ = (tid) >> 7; float w2_[16]; \
    _Pragma("unroll") for (int r_ = 0; r_ < 16; ++r_) w2_[r_] = (w_g2)[r_ * KD + (h) * DK + kk_]; \
    const float bg_ = (b_g)[(h) * DK + kk_]; \
    __syncthreads(); \
    float run_ = 0.f; \
    _Pragma("unroll") for (int tt_ = 0; tt_ < 16; ++tt_) { const LAS f32x4* gr_ = (const LAS f32x4*)(gzs_ + (seg_ * 16 + tt_) * 16); float z_ = bg_; \
        _Pragma("unroll") for (int q_ = 0; q_ < 4; ++q_) { const f32x4 g4_ = gr_[q_]; z_ += g4_[0] * w2_[4 * q_] + g4_[1] * w2_[4 * q_ + 1] + g4_[2] * w2_[4 * q_ + 2] + g4_[3] * w2_[4 * q_ + 3]; } \
        run_ += logsig16(z_); Gv[tt_] = run_; } \
    tot_[seg_ * 128 + kk_] = run_; \
    __syncthreads(); \
    { const float t0_ = tot_[kk_], t1_ = tot_[128 + kk_], t2_ = tot_[256 + kk_], t3_ = tot_[384 + kk_]; \
      const float pre_ = (seg_ > 0 ? t0_ : 0.f) + (seg_ > 1 ? t1_ : 0.f) + (seg_ > 2 ? t2_ : 0.f); \
      _Pragma("unroll") for (int tt_ = 0; tt_ < 16; ++tt_) Gv[tt_] += pre_; \
      Glast = ((t0_ + t1_) + t2_) + t3_; } \
} while (0)

constexpr int G_KT = 8192, G_QT = 8192 + 17408, G_VT = 43008, G_PM = 76800, G_RED = 86016;
constexpr int PK = 272, PV = 528, PP = 144;

__device__ __forceinline__ void gla_state_phase(LAS unsigned char* lds, const bf16* Kg, const bf16* Vg, const float* GZ, const float* w_g2, const float* b_g, bf16* dS, float* dec,
                                                int G, int bid, int tid, int lane, int wid) {
    const int fr = lane & 15, fq = lane >> 4;
    for (int item = bid; item < NITEM; item += G) {
        const int h = item & 3, r0 = (item >> 2) * 64;
        float Gv[16], Glast;
        GLA_G(lds, GZ, w_g2, b_g, r0, h, tid, Gv, Glast);
        const int kk = tid & 127, seg = tid >> 7;
#pragma unroll
        for (int tt = 0; tt < 16; ++tt) { const int t = seg * 16 + tt; const float kv = bf1(Kg[(size_t)(r0 + t) * KD + h * DK + kk]);
            *(LAS bf16*)(lds + G_KT + t * PK + kk * 2) = (bf16)f2bf(kv * __expf(Glast - Gv[tt])); }
#pragma unroll
        for (int i = 0; i < 4; ++i) { const int id = tid + 512 * i, t = id >> 5, c = id & 31; *(LAS v4u*)(lds + G_VT + t * PV + c * 16) = *(const GAS v4u*)(Vg + (size_t)(r0 + t) * VD + h * DV + c * 8); }
        if (seg == 0) dec[(size_t)item * DK + kk] = __expf(Glast);
        __syncthreads();
        f32x4 acc[2][8];
#pragma unroll
        for (int d = 0; d < 2; ++d)
#pragma unroll
            for (int kt = 0; kt < 8; ++kt) acc[d][kt] = (f32x4){0.f, 0.f, 0.f, 0.f};
#pragma unroll
        for (int ks = 0; ks < 2; ++ks) { bf16x8 bfr[2];
#pragma unroll
            for (int d = 0; d < 2; ++d) bfr[d] = tr_frag(lds + G_VT, PV, ks * 32, 16 * (2 * wid + d), lane);
#pragma unroll
            for (int kt = 0; kt < 8; ++kt) { const bf16x8 afr = tr_frag(lds + G_KT, PK, ks * 32, 16 * kt, lane);
#pragma unroll
                for (int d = 0; d < 2; ++d) acc[d][kt] = MFMA16(afr, bfr[d], acc[d][kt]); } }
#pragma unroll
        for (int d = 0; d < 2; ++d) { bf16* rowp = dS + (size_t)item * (DV * DK) + (size_t)(16 * (2 * wid + d) + fr) * DK + 4 * fq;
#pragma unroll
            for (int kt = 0; kt < 8; ++kt) *(GAS v2u*)(rowp + 16 * kt) = (v2u){pk2(acc[d][kt][0], acc[d][kt][1]), pk2(acc[d][kt][2], acc[d][kt][3])}; }
        __syncthreads();
    }
}

__device__ __forceinline__ void gla_scan_phase(bf16* dS, const float* dec, int gtid, int NGT) {
    for (int e = gtid; e < 8 * DV * DK / 2; e += NGT) {
        const int bh = e >> 14, rem = e & 16383, b = bh >> 2, h = bh & 3;
        GAS unsigned* p = (GAS unsigned*)(dS + ((size_t)(b * 128) * 4 + h) * (DV * DK)) + rem;
        const GAS f32x2* dp = (const GAS f32x2*)(dec + ((size_t)(b * 128) * 4 + h) * DK) + (rem & 63);
        float s0 = 0.f, s1 = 0.f;
        for (int n0 = 0; n0 < 128; n0 += 8) { unsigned d[8]; f32x2 dc[8];
#pragma unroll
            for (int j = 0; j < 8; ++j) { d[j] = p[(size_t)(n0 + j) * (2 * DV * DK)]; dc[j] = dp[(size_t)(n0 + j) * (2 * DK)]; }
#pragma unroll
            for (int j = 0; j < 8; ++j) { p[(size_t)(n0 + j) * (2 * DV * DK)] = pk2(s0, s1); s0 = s0 * dc[j].x + bf_lo(d[j]); s1 = s1 * dc[j].y + bf_hi(d[j]); } }
    }
}

__device__ __forceinline__ void gla_out_phase(LAS unsigned char* lds, const bf16* Qg, const bf16* Kg, const bf16* Vg, bf16* SROG, const float* GZ, const float* w_g2, const float* b_g, const float* gn_g,
                                              const bf16* Sprev, int G, int bid, int tid, int lane, int wid) {
    const int fr = lane & 15, fq = lane >> 4;
    LAS float* red = (LAS float*)(lds + G_RED);
    for (int item = bid; item < NITEM; item += G) {
        const int h = item & 3, r0 = (item >> 2) * 64;
        float Gv[16], Glast;
        GLA_G(lds, GZ, w_g2, b_g, r0, h, tid, Gv, Glast);
        const int kk = tid & 127, seg = tid >> 7;
#pragma unroll
        for (int tt = 0; tt < 16; ++tt) { const int t = seg * 16 + tt; const size_t go = (size_t)(r0 + t) * KD + h * DK + kk; const float qv = bf1(Qg[go]), kv = bf1(Kg[go]);
            *(LAS bf16*)(lds + G_QT + t * PK + kk * 2) = (bf16)f2bf(qv * __expf(Gv[tt])); *(LAS bf16*)(lds + G_KT + t * PK + kk * 2) = (bf16)f2bf(kv * __expf(-Gv[tt])); }
#pragma unroll
        for (int i = 0; i < 4; ++i) { const int id = tid + 512 * i, t = id >> 5, c = id & 31; *(LAS v4u*)(lds + G_VT + t * PV + c * 16) = *(const GAS v4u*)(Vg + (size_t)(r0 + t) * VD + h * DV + c * 8); }
        __syncthreads();
        { const int it = wid >> 1;
#pragma unroll
          for (int jj = 0; jj < 2; ++jj) { const int jt = 2 * (wid & 1) + jj; f32x4 pa = (f32x4){0.f, 0.f, 0.f, 0.f};
#pragma unroll
              for (int ks = 0; ks < 4; ++ks) { const bf16x8 a = *(const LAS bf16x8*)(lds + G_KT + (16 * jt + fr) * PK + (32 * ks + 8 * fq) * 2), b = *(const LAS bf16x8*)(lds + G_QT + (16 * it + fr) * PK + (32 * ks + 8 * fq) * 2);
                  pa = MFMA16(a, b, pa); }
              const int i = 16 * it + fr, j0 = 16 * jt + 4 * fq;
              *(LAS v2u*)(lds + G_PM + i * PP + j0 * 2) = (v2u){pk2(j0 <= i ? pa[0] : 0.f, j0 + 1 <= i ? pa[1] : 0.f), pk2(j0 + 2 <= i ? pa[2] : 0.f, j0 + 3 <= i ? pa[3] : 0.f)}; } }
        __syncthreads();
        f32x4 acc[4][2];
#pragma unroll
        for (int it = 0; it < 4; ++it) { acc[it][0] = (f32x4){0.f, 0.f, 0.f, 0.f}; acc[it][1] = (f32x4){0.f, 0.f, 0.f, 0.f}; }
#pragma unroll
        for (int ks = 0; ks < 2; ++ks) { bf16x8 a[2];
#pragma unroll
            for (int d = 0; d < 2; ++d) a[d] = tr_frag(lds + G_VT, PV, ks * 32, 16 * (2 * wid + d), lane);
#pragma unroll
            for (int it = 0; it < 4; ++it) { const bf16x8 b = *(const LAS bf16x8*)(lds + G_PM + (16 * it + fr) * PP + (32 * ks + 8 * fq) * 2);
#pragma unroll
                for (int d = 0; d < 2; ++d) acc[it][d] = MFMA16(a[d], b, acc[it][d]); } }
#pragma unroll
        for (int ks = 0; ks < 4; ++ks) { bf16x8 a[2];
#pragma unroll
            for (int d = 0; d < 2; ++d) a[d] = *(const GAS bf16x8*)(Sprev + (size_t)item * (DV * DK) + (size_t)(16 * (2 * wid + d) + fr) * DK + 32 * ks + 8 * fq);
#pragma unroll
            for (int it = 0; it < 4; ++it) { const bf16x8 b = *(const LAS bf16x8*)(lds + G_QT + (16 * it + fr) * PK + (32 * ks + 8 * fq) * 2);
#pragma unroll
                for (int d = 0; d < 2; ++d) acc[it][d] = MFMA16(a[d], b, acc[it][d]); } }
#pragma unroll
        for (int it = 0; it < 4; ++it) { float ss = 0.f;
#pragma unroll
            for (int d = 0; d < 2; ++d) ss += (acc[it][d][0] * acc[it][d][0] + acc[it][d][1] * acc[it][d][1]) + (acc[it][d][2] * acc[it][d][2] + acc[it][d][3] * acc[it][d][3]);
            ss += __shfl_xor(ss, 16); ss += __shfl_xor(ss, 32);
            if (fq == 0) red[wid * 64 + 16 * it + fr] = ss; }
        __syncthreads();
#pragma unroll
        for (int it = 0; it < 4; ++it) { const int i = 16 * it + fr; float tot = 0.f;
#pragma unroll
            for (int w8 = 0; w8 < 8; ++w8) tot += red[w8 * 64 + i];
            const float rms = __builtin_amdgcn_rsqf(tot * (1.0f / 256.0f) + EPS);
#pragma unroll
            for (int d = 0; d < 2; ++d) { const int dv = 16 * (2 * wid + d) + 4 * fq; const f32x4 gn = *(const f32x4*)(gn_g + h * DV + dv);
                GAS v2u* p = (GAS v2u*)(SROG + (size_t)(r0 + i) * VD + h * DV + dv); const v2u sr = *p; const f32x4 o = acc[it][d] * rms * gn;
                *p = (v2u){pk2(o[0] * bf_lo(sr.x), o[1] * bf_hi(sr.x)), pk2(o[2] * bf_lo(sr.y), o[3] * bf_hi(sr.y))}; } }
        __syncthreads();
    }
}

constexpr int NPHASE = 14;
__global__ void __launch_bounds__(NTHREADS, 2) mk_fwd(Args args) {
    extern __shared__ __attribute__((aligned(16))) unsigned char lds_raw[];
    LAS unsigned char* lds = (LAS unsigned char*)lds_raw;
    cg::grid_group grid = cg::this_grid();
    const int tid = threadIdx.x, lane = tid & 63, wave = __builtin_amdgcn_readfirstlane(tid >> 6);
    const int G = gridDim.x, bid = blockIdx.x;
    const int vcu = (G % 8 == 0) ? (bid % 8) * (G / 8) + bid / 8 : bid;
    const int gw = vcu * NWAVES + wave, NGW = G * NWAVES, gtid = vcu * NTHREADS + tid, NGT = G * NTHREADS;
    unsigned char* ws = args.ws;
    const int lo = args.ph_lo, hi = args.ph_hi;
#define IN(k) (lo <= (k) && (k) < hi)
#define SEAM(k) do { if (IN(k) && IN((k) + 1)) grid.sync(); } while (0)
    float* X = args.out;
    float* rsq = (float*)(ws + WS_RSQ);
    bf16* XB = (bf16*)(ws + WS_RV);

    if (IN(0)) { p0_prologue(args, lds, gw, NGW, lane, wave, gtid, NGT); } SEAM(0);
    if (IN(1)) {
        pg8::Gemm g{(const bf16*)args.out, (const bf16*)(ws + WS_WAIN), M, SGF, D}; pg8::StaticOrder S; S.init(M, SGF, G, bid);
        pg8::EpiSguIn E{(bf16*)(ws + WS_RU), (bf16*)(ws + WS_RV), rsq, (pg8::f32x2*)((unsigned char*)args.out + 32 * MiB)};
        pg8::gemm_phase<pg8::EpiSguIn, pg8::StaticOrder, true, true>(lds, g, S, E);
    } SEAM(1);
    if (IN(2)) { sgu_phase(lds, (const bf16*)(ws + WS_WM), (const bf16*)(ws + WS_RV), (bf16*)(ws + WS_RU), (const f32x2*)((unsigned char*)args.out + 32 * MiB), args.in[3], args.in[4], args.in[6], G, vcu, tid, lane, wave); } SEAM(2);
    if (IN(3)) {
        pg8::Gemm g{(const bf16*)(ws + WS_RU), (const bf16*)(ws + WS_WAOUT), M, D, SGW}; pg8::StaticOrder S; S.init(M, D, G, bid);
        pg8::EpiResid E{args.in[0], X, XB, rsq};
        pg8::gemm_phase<pg8::EpiResid, pg8::StaticOrder, false, true>(lds, g, S, E);
    } SEAM(3);
    if (IN(4)) {
        pg8::Gemm g{XB, (const bf16*)(ws + WS_WGU0), M, 2 * FH, D}; pg8::StaticOrder S; S.init(M, 2 * FH, G, bid);
        pg8::EpiSwiGLU E{(bf16*)(ws + WS_RU), FH, rsq};
        pg8::gemm_phase<pg8::EpiSwiGLU, pg8::StaticOrder, true, true>(lds, g, S, E);
    } SEAM(4);
    if (IN(5)) {
        pg8::Gemm g{(const bf16*)(ws + WS_RU), (const bf16*)(ws + WS_WDN0), M, D, FH}; pg8::StaticOrder S; S.init(M, D, G, bid);
        pg8::EpiResid E{X, X, XB, rsq};
        pg8::gemm_phase<pg8::EpiResid, pg8::StaticOrder, false, true>(lds, g, S, E);
    } SEAM(5);
    bf16* Qg = (bf16*)(ws + WS_RU); bf16* Kg = (bf16*)(ws + WS_RU + 16 * MiB); bf16* Vg = (bf16*)(ws + WS_RU + 32 * MiB); bf16* SR = (bf16*)(ws + WS_RU + 64 * MiB);
    bf16* dS = (bf16*)(ws + WS_RV + 32 * MiB); float* GZ = (float*)(ws + WS_GZ); float* dec = (float*)(ws + WS_DEC);
    if (IN(6)) {
        pg8::Gemm g{XB, (const bf16*)(ws + WS_WBIN), M, GIN_PAD, D}; pg8::StaticOrder S; S.init(M, GIN_PAD, G, bid);
        pg8::EpiGlaIn E{Qg, Kg, Vg, SR, GZ, rsq};
        pg8::gemm_phase<pg8::EpiGlaIn, pg8::StaticOrder, true, true>(lds, g, S, E);
    } SEAM(6);
    if (IN(7)) { gla_state_phase(lds, Kg, Vg, GZ, args.in[9], args.in[10], dS, dec, G, vcu, tid, lane, wave); } SEAM(7);
    if (IN(8)) { gla_scan_phase(dS, dec, gtid, NGT); } SEAM(8);
    if (IN(9)) { gla_out_phase(lds, Qg, Kg, Vg, SR, GZ, args.in[9], args.in[10], args.in[11], dS, G, vcu, tid, lane, wave); } SEAM(9);
    if (IN(10)) {
        pg8::Gemm g{SR, (const bf16*)(ws + WS_WBOUT), M, D, VD}; pg8::StaticOrder S; S.init(M, D, G, bid);
        pg8::EpiResid E{X, X, XB, rsq};
        pg8::gemm_phase<pg8::EpiResid, pg8::StaticOrder, false, true>(lds, g, S, E);
    } SEAM(10);
    if (IN(11)) {
        pg8::Gemm g{XB, (const bf16*)(ws + WS_WGU1), M, 2 * FH, D}; pg8::StaticOrder S; S.init(M, 2 * FH, G, bid);
        pg8::EpiSwiGLU E{(bf16*)(ws + WS_RU), FH, rsq};
        pg8::gemm_phase<pg8::EpiSwiGLU, pg8::StaticOrder, true, true>(lds, g, S, E);
    } SEAM(11);
    if (IN(12)) {
        pg8::Gemm g{(const bf16*)(ws + WS_RU), (const bf16*)(ws + WS_WDN1), M, D, FH}; pg8::StaticOrder S; S.init(M, D, G, bid);
        pg8::EpiResid E{X, X, XB, rsq};
        pg8::gemm_phase<pg8::EpiResid, pg8::StaticOrder, false, true>(lds, g, S, E);
    } SEAM(12);
    if (IN(13)) {
        const float* fg = args.in[17];
        for (int m = gw; m < M; m += NGW) { GAS f32x4* xr = (GAS f32x4*)(X + (size_t)m * D) + lane; const float rs = pg8::row_rs(rsq, m);
#pragma unroll
            for (int j = 0; j < 4; ++j) { const f32x4 gv = *(const f32x4*)(fg + 4 * lane + 256 * j); xr[64 * j] = xr[64 * j] * rs * gv; } }
    }
#undef IN
#undef SEAM
}


__global__ void digest_k(const unsigned short* a, size_t na, const float* f, size_t nf, float* out) {
    const size_t n = (size_t)16384 * 1024;
    for (size_t i = (size_t)blockIdx.x * blockDim.x + threadIdx.x; i < n; i += (size_t)gridDim.x * blockDim.x) {
        float v = 0.f;
        for (size_t k = 0; k * n + i < na; ++k) v += __builtin_bit_cast(float, (unsigned)a[k * n + i] << 16);
        if (nf) v += f[i % nf];
        if (!(fabsf(v) < 1e30f)) v = 1e30f;
        out[i] = v;
    }
}
#ifndef MK_N_LAUNCHES
#define MK_N_LAUNCHES 1
#define DBG_NPH 14
#endif
extern "C" void kernel_launch(void* const* d_in, const int* in_sizes, int n_in, void* d_out, int out_size, void* d_ws, size_t ws_size, hipStream_t stream) {
    static int grid = 0;
    if (grid == 0) {
        if (n_in != 18 || in_sizes[0] != M * D || out_size != M * D || ws_size < WS_END) { fprintf(stderr, "kernel_launch: unexpected shapes (n_in %d, in0 %d, out %d, ws %zu); nothing launched\n", n_in, n_in > 0 ? in_sizes[0] : -1, out_size, ws_size); grid = -1; return; }
        int dev = 0, cus = 0, per_cu = 0;
        if (hipGetDevice(&dev) != hipSuccess || hipDeviceGetAttribute(&cus, hipDeviceAttributeMultiprocessorCount, dev) != hipSuccess) { grid = -1; return; }
        if (hipFuncSetAttribute((const void*)mk_fwd, hipFuncAttributeMaxDynamicSharedMemorySize, LDS_BYTES) != hipSuccess) { fprintf(stderr, "kernel_launch: hipFuncSetAttribute failed\n"); grid = -1; return; }
        if (hipOccupancyMaxActiveBlocksPerMultiprocessor(&per_cu, (const void*)mk_fwd, NTHREADS, LDS_BYTES) != hipSuccess || per_cu < 1) { fprintf(stderr, "kernel_launch: occupancy query gives %d blocks per CU\n", per_cu); (void)hipGetLastError(); grid = -1; return; }
        grid = cus;
        if (grid != 256) { fprintf(stderr, "kernel_launch: built for a 256-CU device (got %d)\n", cus); grid = -1; return; }
    }
    if (grid < 0) return;
    Args a{};
    for (int i = 0; i < 18; ++i) a.in[i] = (const float*)d_in[i];
    a.out = (float*)d_out; a.ws = (unsigned char*)d_ws;
#if MK_N_LAUNCHES == 1
    a.ph_lo = 0; a.ph_hi = NPHASE;
    void* kargs[] = {&a};
    hipError_t e = hipLaunchCooperativeKernel((const void*)mk_fwd, dim3(grid), dim3(NTHREADS), kargs, LDS_BYTES, stream);
    if (e != hipSuccess) fprintf(stderr, "kernel_launch: cooperative launch failed: %s\n", hipGetErrorString(e));
#else
    for (int p = 0; p < DBG_NPH; ++p) { a.ph_lo = p; a.ph_hi = p + 1; hipLaunchKernelGGL(mk_fwd, dim3(grid), dim3(NTHREADS), LDS_BYTES, stream, a); }
#ifdef DBG_DIG
    { unsigned char* w = (unsigned char*)d_ws; const size_t n16 = (size_t)16384 * 1024;
      const unsigned short* da = nullptr; size_t na = 0; const float* df = nullptr; size_t nf = 0;
      if (DBG_DIG == 6) { da = (const unsigned short*)(w + WS_RU); na = 3 * n16; df = (const float*)(w + WS_GZ); nf = 262144; }
      if (DBG_DIG == 7 || DBG_DIG == 8) { da = (const unsigned short*)(w + WS_RV + 32 * MiB); na = 2 * n16; df = (const float*)(w + WS_DEC); nf = 131072; }
      if (DBG_DIG == 9) { da = (const unsigned short*)(w + WS_RU + 64 * MiB); na = n16; }
      hipLaunchKernelGGL(digest_k, dim3(2048), dim3(256), 0, stream, da, na, df, nf, (float*)d_out); }
#endif
#endif
}
```

```cpp
#include <hip/hip_runtime.h>
#include <hip/hip_cooperative_groups.h>
#include <cstdio>
#include <cstdint>
namespace cg = cooperative_groups;
namespace pg8 {
#define PG8_LAS __attribute__((address_space(3)))
typedef unsigned short bf16_t;
typedef short bf16x8 __attribute__((ext_vector_type(8)));
typedef float f32x4 __attribute__((ext_vector_type(4)));
typedef unsigned u32x4 __attribute__((ext_vector_type(4)));
constexpr int BM = 256, BK = 64, HALF = 128, HTB = HALF * BK * 2  , STAGE_BYTES = 8 * HTB, NXCD = 8, WGM = 8;

__host__ __device__ __forceinline__ int lds_byte(int r, int c) { const int st = (r >> 4) * 2 + (c >> 5), rr = r & 15, cc = c & 31, ob = rr * 64 + cc * 2; return st * 1024 + (ob ^ (((ob >> 9) & 1) << 5)); }
__host__ __device__ __forceinline__ void stage_rc(int b, int& R, int& C) { const int st = b / 1024, sb = b % 1024, swz = sb ^ (((sb >> 9) & 1) << 5); R = (st >> 1) * 16 + swz / 64; C = (st & 1) * 32 + (swz % 64) / 2; }
__host__ __device__ __forceinline__ int perm32(int rho) { const int n = rho >> 4, i = rho & 15; return 8 * (i >> 2) + 4 * n + (i & 3); }

struct Unit { int pm, pn; };
struct Gemm { const bf16_t* A; const bf16_t* Bt; int M, N, K; };

struct StaticOrder {
    int nM, nN, nwg, G, c;
    __host__ __device__ void init(int M, int N, int G_, int c_) { nM = M / BM; nN = N / BM; nwg = nM * nN; G = G_; c = c_; }
    __host__ __device__ bool next(int i, Unit& u) const {
        const long L = (long)i * G + c; if (L >= nwg) return false;
        int wgid = (int)L; { const int q = nwg / NXCD, r = nwg % NXCD, xcd = wgid % NXCD, off = wgid / NXCD; wgid = (xcd < r ? xcd * (q + 1) : r * (q + 1) + (xcd - r) * q) + off; }
        const int nig = WGM * nN, gid = wgid / nig, fm = gid * WGM, gsz = (nM - fm) < WGM ? (nM - fm) : WGM;
        u.pm = fm + ((wgid % nig) % gsz); u.pn = (wgid % nig) / gsz; return true;
    }
    __device__ __forceinline__ void a_ready(const Unit&) const {}
    __device__ __forceinline__ void done(const Unit&) const {}
};

typedef float f32x2 __attribute__((ext_vector_type(2)));
typedef __bf16 bf16x2v __attribute__((ext_vector_type(2)));
__device__ __forceinline__ unsigned cvt_pk_bf16(float lo, float hi) { const bf16x2v r = __builtin_convertvector((f32x2){lo, hi}, bf16x2v); return __builtin_bit_cast(unsigned, r); }
__device__ __forceinline__ f32x2 gelu_pk(f32x2 v) {
    const f32x2 av = __builtin_elementwise_abs(v), d = av * 0.2316418882f + 1.0f;
    f32x2 t; t.x = __builtin_amdgcn_rcpf(d.x); t.y = __builtin_amdgcn_rcpf(d.y);
    f32x2 q = t * 0.5307027145f + (-0.7265760135f); q = q * t + 0.7107068705f; q = q * t + (-0.142248368f); q = q * t + 0.127414796f; q = q * t;
    const f32x2 s = (v * v) * (-0.72134752044f);
    f32x2 e; e.x = __builtin_amdgcn_exp2f(s.x); e.y = __builtin_amdgcn_exp2f(s.y);
    const f32x2 m = v * (q * e), r = v - m;
    f32x2 o; o.x = v.x < 0.f ? m.x : r.x; o.y = v.y < 0.f ? m.y : r.y; return o;
}

constexpr int EM = 16384;
constexpr float EEPS = 1e-6f;
__device__ __forceinline__ float row_rs(const float* rsq, int row) {
    const f32x4 p = *(const f32x4*)(rsq + (size_t)row * 4);
    return __builtin_amdgcn_rsqf(((p[0] + p[1]) + (p[2] + p[3])) * (1.0f / 1024.0f) + EEPS);
}
__device__ __forceinline__ float silu_f(float v) { return v * __builtin_amdgcn_rcpf(1.0f + __expf(-v)); }

struct EpiSguIn {
    static constexpr bool PERM = true, AFTER_DRAIN = false;
    bf16_t* U; bf16_t* V; const float* rsq; f32x2* statP;
    __device__ __forceinline__ void operator()(const f32x4 (&acc)[2][2][4][2], const Unit& u, int wr, int wc, int fr, int fq) const {
        const bool isv = u.pn >= 12;
        bf16_t* base = isv ? V : U; const int colt = (isv ? u.pn - 12 : u.pn) * BM + wc * 32 + 8 * fq;
        const int row0 = u.pm * BM + wr * 64 + fr;
#pragma unroll
        for (int ai = 0; ai < 2; ++ai)
#pragma unroll
            for (int m = 0; m < 4; ++m) { const int row = row0 + ai * HALF + m * 16; const float rs = row_rs(rsq, row);
                bf16_t* rowp = base + (size_t)row * 3072 + colt; float s1 = 0.f, s2 = 0.f;
#pragma unroll
                for (int bj = 0; bj < 2; ++bj) { const f32x4 v0 = acc[ai][bj][m][0] * rs, v1 = acc[ai][bj][m][1] * rs;
                    const f32x2 a = gelu_pk((f32x2){v0[0], v0[1]}), b = gelu_pk((f32x2){v0[2], v0[3]}), c = gelu_pk((f32x2){v1[0], v1[1]}), d = gelu_pk((f32x2){v1[2], v1[3]});
                    s1 += ((a.x + a.y) + (b.x + b.y)) + ((c.x + c.y) + (d.x + d.y));
                    s2 += ((a.x * a.x + a.y * a.y) + (b.x * b.x + b.y * b.y)) + ((c.x * c.x + c.y * c.y) + (d.x * d.x + d.y * d.y));
                    u32x4 w; w.x = cvt_pk_bf16(a.x, a.y); w.y = cvt_pk_bf16(b.x, b.y); w.z = cvt_pk_bf16(c.x, c.y); w.w = cvt_pk_bf16(d.x, d.y);
                    *(u32x4*)(rowp + bj * HALF) = w; }
                if (isv) { s1 += __shfl_xor(s1, 16); s1 += __shfl_xor(s1, 32); s2 += __shfl_xor(s2, 16); s2 += __shfl_xor(s2, 32);
                    if (fq == 0) statP[(size_t)((u.pn - 12) * 4 + wc) * EM + row] = (f32x2){s1, s2}; } }
    }
};
struct EpiSwiGLU {
    static constexpr bool PERM = true, AFTER_DRAIN = false;
    bf16_t* Hd; int ldh; const float* rsq;
    __device__ __forceinline__ void operator()(const f32x4 (&acc)[2][2][4][2], const Unit& u, int wr, int wc, int fr, int fq) const {
        const int row0 = u.pm * BM + wr * 64 + fr, col0 = u.pn * HALF + wc * 32 + 8 * fq;
#pragma unroll
        for (int ai = 0; ai < 2; ++ai)
#pragma unroll
            for (int m = 0; m < 4; ++m) { const int row = row0 + ai * HALF + m * 16; const float rs = row_rs(rsq, row);
                const f32x4 g0 = acc[ai][0][m][0] * rs, g1 = acc[ai][0][m][1] * rs, u0 = acc[ai][1][m][0] * rs, u1 = acc[ai][1][m][1] * rs;
                u32x4 w; w.x = cvt_pk_bf16(silu_f(g0[0]) * u0[0], silu_f(g0[1]) * u0[1]); w.y = cvt_pk_bf16(silu_f(g0[2]) * u0[2], silu_f(g0[3]) * u0[3]);
                w.z = cvt_pk_bf16(silu_f(g1[0]) * u1[0], silu_f(g1[1]) * u1[1]); w.w = cvt_pk_bf16(silu_f(g1[2]) * u1[2], silu_f(g1[3]) * u1[3]);
                *(u32x4*)(Hd + (size_t)row * ldh + col0) = w; }
    }
};
struct EpiGlaIn {
    static constexpr bool PERM = true, AFTER_DRAIN = false;
    bf16_t* Q; bf16_t* Kk; bf16_t* Vv; bf16_t* SR; float* GZ; const float* rsq;
    __device__ __forceinline__ void operator()(const f32x4 (&acc)[2][2][4][2], const Unit& u, int wr, int wc, int fr, int fq) const {
        const int row0 = u.pm * BM + wr * 64 + fr, pn = u.pn;
        if (pn == 12) {
            if (wc == 0 && fq < 2) {
#pragma unroll
                for (int ai = 0; ai < 2; ++ai)
#pragma unroll
                    for (int m = 0; m < 4; ++m) { const int row = row0 + ai * HALF + m * 16; const float rs = row_rs(rsq, row);
                        float* p = GZ + (size_t)row * 16 + 8 * fq; *(f32x4*)p = acc[ai][0][m][0] * rs; *(f32x4*)(p + 4) = acc[ai][0][m][1] * rs; }
            }
            return;
        }
        bf16_t* base; int ld, colt; float sc = 1.f; const bool act = pn >= 8;
        if (pn < 2) { base = Q; ld = 512; colt = pn * BM; sc = 0.08838834764831845f; } else if (pn < 4) { base = Kk; ld = 512; colt = (pn - 2) * BM; }
        else if (pn < 8) { base = Vv; ld = 1024; colt = (pn - 4) * BM; } else { base = SR; ld = 1024; colt = (pn - 8) * BM; }
        colt += wc * 32 + 8 * fq;
#pragma unroll
        for (int ai = 0; ai < 2; ++ai)
#pragma unroll
            for (int m = 0; m < 4; ++m) { const int row = row0 + ai * HALF + m * 16; const float rs = row_rs(rsq, row) * sc;
                bf16_t* rowp = base + (size_t)row * ld + colt;
#pragma unroll
                for (int bj = 0; bj < 2; ++bj) { f32x4 v0 = acc[ai][bj][m][0] * rs, v1 = acc[ai][bj][m][1] * rs;
                    if (act) { v0 = (f32x4){silu_f(v0[0]), silu_f(v0[1]), silu_f(v0[2]), silu_f(v0[3])}; v1 = (f32x4){silu_f(v1[0]), silu_f(v1[1]), silu_f(v1[2]), silu_f(v1[3])}; }
                    u32x4 w; w.x = cvt_pk_bf16(v0[0], v0[1]); w.y = cvt_pk_bf16(v0[2], v0[3]); w.z = cvt_pk_bf16(v1[0], v1[1]); w.w = cvt_pk_bf16(v1[2], v1[3]);
                    *(u32x4*)(rowp + bj * HALF) = w; } }
    }
};
template <bool F32BASE> struct EpiResid {
    static constexpr bool PERM = true, AFTER_DRAIN = true;
    const void* base; bf16_t* xb; float* rsq;
    __device__ __forceinline__ void fused(f32x4 (&acc)[2][2][4][2], const Unit& u, int wr, int wc, int fr, int fq, PG8_LAS unsigned char* lds, int wid, int lane) const {
        PG8_LAS float* P = (PG8_LAS float*)lds;
        const int col0 = u.pn * BM + wc * 32 + 8 * fq;
#pragma unroll
        for (int ai = 0; ai < 2; ++ai)
#pragma unroll
            for (int m = 0; m < 4; ++m) { const int r = ai * HALF + wr * 64 + m * 16 + fr; const size_t off = (size_t)(u.pm * BM + r) * 1024 + col0; float ss = 0.f;
#pragma unroll
                for (int bj = 0; bj < 2; ++bj) { f32x4 b0, b1;
                    if (F32BASE) { const float* bp = (const float*)base + off + bj * HALF; b0 = *(const f32x4*)bp; b1 = *(const f32x4*)(bp + 4); }
                    else { const u32x4 w = *(const u32x4*)((const bf16_t*)base + off + bj * HALF);
                        b0 = (f32x4){__builtin_bit_cast(float, w.x << 16), __builtin_bit_cast(float, w.x & 0xffff0000u), __builtin_bit_cast(float, w.y << 16), __builtin_bit_cast(float, w.y & 0xffff0000u)};
                        b1 = (f32x4){__builtin_bit_cast(float, w.z << 16), __builtin_bit_cast(float, w.z & 0xffff0000u), __builtin_bit_cast(float, w.w << 16), __builtin_bit_cast(float, w.w & 0xffff0000u)}; }
                    const f32x4 o0 = b0 + acc[ai][bj][m][0], o1 = b1 + acc[ai][bj][m][1];
                    u32x4 w; w.x = cvt_pk_bf16(o0[0], o0[1]); w.y = cvt_pk_bf16(o0[2], o0[3]); w.z = cvt_pk_bf16(o1[0], o1[1]); w.w = cvt_pk_bf16(o1[2], o1[3]);
                    *(u32x4*)(xb + off + bj * HALF) = w;
                    ss += ((o0[0] * o0[0] + o0[1] * o0[1]) + (o0[2] * o0[2] + o0[3] * o0[3])) + ((o1[0] * o1[0] + o1[1] * o1[1]) + (o1[2] * o1[2] + o1[3] * o1[3])); }
                ss += __shfl_xor(ss, 16); ss += __shfl_xor(ss, 32);
                if (fq == 0) P[r * 4 + wc] = ss;
                if (m & 1) asm volatile("" ::: "memory"); }
        asm volatile("s_waitcnt lgkmcnt(0)" ::: "memory"); __builtin_amdgcn_s_barrier(); asm volatile("" ::: "memory");
        const int t = wid * 64 + lane;
        if (t < 256) { const f32x4 p = *(const PG8_LAS f32x4*)(P + t * 4); rsq[(size_t)(u.pm * BM + t) * 4 + u.pn] = (p[0] + p[1]) + (p[2] + p[3]); }
    }
};
template <class Epi, class Sched, bool ALIGN_EPI = false, bool SP2 = false>
__device__ __forceinline__ void gemm_phase(PG8_LAS unsigned char* lds, const Gemm g, const Sched& S, const Epi& E) {
    const int tid = threadIdx.x, wid = __builtin_amdgcn_readfirstlane(tid >> 6), lane = tid & 63, wr = wid >> 2, wc = wid & 3, fr = lane & 15, fq = lane >> 4;
    const int K = g.K, nt = K / BK;
    unsigned voffA[2], voffB[2];
#pragma unroll
    for (int i = 0; i < 2; ++i) { int R, C; stage_rc(tid * 16 + i * 8192, R, C); const int Rb = Epi::PERM ? ((R & ~31) + perm32(R & 31)) : R;
        voffA[i] = (unsigned)(R * K + C) * 2u; voffB[i] = (unsigned)(Rb * K + C) * 2u; }
    const size_t kstep = (size_t)(BK * 2);
    const size_t hstep = (size_t)HALF * K * 2;
    const size_t tstep = 2 * hstep;
    const unsigned ldsw = (unsigned)wid * 1024u;
    const int aoff = lds_byte(wr * 64 + fr, fq * 8), boff = lds_byte(wc * 32 + fr, fq * 8);
#define PG8_SA(b, h) (((b) * 2 + (h)) * HTB)
#define PG8_SB(b, h) ((4 + (b) * 2 + (h)) * HTB)
#define PG8_STAGE(bufoff, gbase, voff) do { _Pragma("unroll") for (int _i = 0; _i < 2; ++_i) \
        __builtin_amdgcn_global_load_lds((const unsigned*)((const char*)(gbase) + (voff)[_i]), (PG8_LAS unsigned*)(lds + (bufoff) + ldsw + _i * 8192), 16, 0, 0); } while (0)
#define PG8_LDA(dst, b, h) do { _Pragma("unroll") for (int m = 0; m < 4; ++m) _Pragma("unroll") for (int k = 0; k < 2; ++k) dst[m][k] = *(const PG8_LAS bf16x8*)(lds + PG8_SA(b, h) + aoff + m * 2048 + k * 1024); } while (0)
#define PG8_LDB(dst, b, h) do { _Pragma("unroll") for (int n = 0; n < 2; ++n) _Pragma("unroll") for (int k = 0; k < 2; ++k) dst[n][k] = *(const PG8_LAS bf16x8*)(lds + PG8_SB(b, h) + boff + n * 2048 + k * 1024); } while (0)
#define PG8_MMA(ai, bj, At, Bt) do { __builtin_amdgcn_s_setprio(1); _Pragma("unroll") for (int m = 0; m < 4; ++m) _Pragma("unroll") for (int n = 0; n < 2; ++n) _Pragma("unroll") for (int k = 0; k < 2; ++k) \
        acc[ai][bj][m][n] = __builtin_amdgcn_mfma_f32_16x16x32_bf16(Bt[n][k], At[m][k], acc[ai][bj][m][n], 0, 0, 0); __builtin_amdgcn_s_setprio(0); } while (0)
#define PG8_WAIT_V(n) asm volatile("s_waitcnt vmcnt(" #n ")" ::: "memory")
#define PG8_WAIT_L(n) asm volatile("s_waitcnt lgkmcnt(" #n ")" ::: "memory")
#define PG8_BAR __builtin_amdgcn_s_barrier()
#define PG8_SCHED __builtin_amdgcn_sched_barrier(0)
    Unit cur, nxt; int ui = 0;
    if (!S.next(0, cur)) return;
    f32x4 acc[2][2][4][2];
#pragma unroll
    for (int a = 0; a < 2; ++a)
#pragma unroll
        for (int b = 0; b < 2; ++b)
#pragma unroll
            for (int m = 0; m < 4; ++m)
#pragma unroll
                for (int n = 0; n < 2; ++n) acc[a][b][m][n] = (f32x4){0.f, 0.f, 0.f, 0.f};
    bf16x8 At[4][2], B0[2][2], B1[2][2];
    const char* cA = (const char*)g.A + (size_t)cur.pm * tstep; const char* cB = (const char*)g.Bt + (size_t)cur.pn * tstep;
    S.a_ready(cur);
    if constexpr (SP2) {
        PG8_STAGE(PG8_SB(0, 0), cB, voffB); PG8_STAGE(PG8_SB(0, 1), cB + hstep, voffB); PG8_STAGE(PG8_SA(0, 0), cA, voffA); PG8_STAGE(PG8_SA(0, 1), cA + hstep, voffA);
        if (wr == 1) PG8_BAR;
        PG8_WAIT_V(2); PG8_BAR;
        PG8_STAGE(PG8_SB(1, 0), cB + kstep, voffB); PG8_STAGE(PG8_SA(1, 0), cA + kstep, voffA); PG8_STAGE(PG8_SB(1, 1), cB + hstep + kstep, voffB);
        PG8_WAIT_V(6); PG8_BAR;
    } else {
        PG8_STAGE(PG8_SB(0, 0), cB, voffB); PG8_STAGE(PG8_SA(0, 0), cA, voffA); PG8_STAGE(PG8_SB(0, 1), cB + hstep, voffB); PG8_STAGE(PG8_SA(0, 1), cA + hstep, voffA);
        if (wr == 1) PG8_BAR;
        PG8_WAIT_V(4); PG8_BAR;
        PG8_STAGE(PG8_SB(1, 0), cB + kstep, voffB); PG8_STAGE(PG8_SA(1, 0), cA + kstep, voffA); PG8_STAGE(PG8_SB(1, 1), cB + hstep + kstep, voffB);
        PG8_WAIT_V(6); PG8_BAR;
    }
    for (;;) {
        const bool has_next = S.next(ui + 1, nxt);
        const char* nA = has_next ? (const char*)g.A + (size_t)nxt.pm * tstep : cA; const char* nB = has_next ? (const char*)g.Bt + (size_t)nxt.pn * tstep : cB;
        for (int t = 0; t < nt; t += 2) {
            const bool last = (t == nt - 2);
            const char* a1 = cA + (size_t)(t + 1) * kstep;
            const char* a2 = last ? nA : cA + (size_t)(t + 2) * kstep; const char* b2 = last ? nB : cB + (size_t)(t + 2) * kstep;
            const char* a3 = a2 + kstep; const char* b3 = b2 + kstep;
            if (last && has_next) S.a_ready(nxt);
            if constexpr (SP2) {
            PG8_LDB(B0, 0, 0); PG8_LDB(B1, 0, 1); PG8_SCHED; PG8_LDA(At, 0, 0); PG8_STAGE(PG8_SA(1, 1), a1 + hstep, voffA);
            PG8_WAIT_V(8); PG8_WAIT_L(0); PG8_BAR; PG8_MMA(0, 0, At, B0); PG8_MMA(0, 1, At, B1); PG8_BAR; PG8_SCHED;
            PG8_LDA(At, 0, 1); PG8_STAGE(PG8_SB(0, 0), b2, voffB); PG8_STAGE(PG8_SB(0, 1), b2 + hstep, voffB); PG8_STAGE(PG8_SA(0, 0), a2, voffA);
            PG8_WAIT_V(8); PG8_WAIT_L(0); PG8_BAR; PG8_MMA(1, 0, At, B0); PG8_MMA(1, 1, At, B1); PG8_BAR; PG8_SCHED;
            PG8_LDB(B0, 1, 0); PG8_LDB(B1, 1, 1); PG8_SCHED; PG8_LDA(At, 1, 0); PG8_STAGE(PG8_SA(0, 1), a2 + hstep, voffA);
            PG8_WAIT_V(8); PG8_WAIT_L(0); PG8_BAR; PG8_MMA(0, 0, At, B0); PG8_MMA(0, 1, At, B1); PG8_BAR; PG8_SCHED;
            PG8_LDA(At, 1, 1); PG8_STAGE(PG8_SB(1, 0), b3, voffB); PG8_STAGE(PG8_SB(1, 1), b3 + hstep, voffB); PG8_STAGE(PG8_SA(1, 0), a3, voffA);
            PG8_WAIT_V(8); PG8_WAIT_L(0); PG8_BAR; PG8_MMA(1, 0, At, B0); PG8_MMA(1, 1, At, B1); PG8_BAR; PG8_SCHED;
            } else {
            PG8_LDB(B0, 0, 0); PG8_SCHED; PG8_LDA(At, 0, 0); PG8_STAGE(PG8_SA(1, 1), a1 + hstep, voffA);
            PG8_WAIT_L(8); PG8_BAR; PG8_WAIT_L(0); PG8_MMA(0, 0, At, B0); PG8_BAR; PG8_SCHED;
            PG8_LDB(B1, 0, 1); PG8_STAGE(PG8_SB(0, 0), b2, voffB);
            PG8_BAR; PG8_WAIT_L(0); PG8_MMA(0, 1, At, B1); PG8_BAR;
            PG8_LDA(At, 0, 1); PG8_STAGE(PG8_SA(0, 0), a2, voffA);
            PG8_BAR; PG8_WAIT_L(0); PG8_MMA(1, 0, At, B0); PG8_BAR; PG8_SCHED;
            PG8_STAGE(PG8_SB(0, 1), b2 + hstep, voffB);
            PG8_WAIT_V(6); PG8_BAR; PG8_MMA(1, 1, At, B1); PG8_BAR;
            PG8_LDB(B0, 1, 0); PG8_SCHED; PG8_LDA(At, 1, 0); PG8_STAGE(PG8_SA(0, 1), a2 + hstep, voffA);
            PG8_WAIT_L(8); PG8_BAR; PG8_WAIT_L(0); PG8_MMA(0, 0, At, B0); PG8_BAR; PG8_SCHED;
            PG8_LDB(B1, 1, 1); PG8_STAGE(PG8_SB(1, 0), b3, voffB);
            PG8_BAR; PG8_WAIT_L(0); PG8_MMA(0, 1, At, B1); PG8_BAR;
            PG8_LDA(At, 1, 1); PG8_STAGE(PG8_SA(1, 0), a3, voffA);
            PG8_BAR; PG8_WAIT_L(0); PG8_MMA(1, 0, At, B0); PG8_BAR; PG8_SCHED;
            PG8_STAGE(PG8_SB(1, 1), b3 + hstep, voffB);
            PG8_WAIT_V(6); PG8_BAR; PG8_MMA(1, 1, At, B1); PG8_BAR;
            }
        }
        if constexpr (ALIGN_EPI) { if (wr == 0) PG8_BAR; }
        if constexpr (!Epi::AFTER_DRAIN) { E(acc, cur, wr, wc, fr, fq); S.done(cur); }
        if (!has_next) break;
#pragma unroll
        for (int a = 0; a < 2; ++a)
#pragma unroll
            for (int b = 0; b < 2; ++b)
#pragma unroll
                for (int m = 0; m < 4; ++m)
#pragma unroll
                    for (int n = 0; n < 2; ++n) acc[a][b][m][n] = (f32x4){0.f, 0.f, 0.f, 0.f};
        cur = nxt; cA = nA; cB = nB; ++ui;
        if constexpr (ALIGN_EPI) { if (wr == 1) PG8_BAR; }
    }
    PG8_WAIT_V(0);
    if constexpr (!ALIGN_EPI) { if (wr == 0) PG8_BAR; }
    PG8_BAR;
    if constexpr (Epi::AFTER_DRAIN) { E.fused(acc, cur, wr, wc, fr, fq, lds, wid, lane); S.done(cur); }
#undef PG8_SA
#undef PG8_SB
#undef PG8_STAGE
#undef PG8_LDA
#undef PG8_LDB
#undef PG8_MMA
#undef PG8_WAIT_V
#undef PG8_WAIT_L
#undef PG8_BAR
#undef PG8_SCHED
}
}

constexpr int NWAVES = 8, NTHREADS = 512;
constexpr int BATCH = 2, T = 8192, D = 1024, M = BATCH * T;
constexpr int SGF = 6144, SGW = 3072, SGC = 384;
constexpr int KD = 512, VD = 1024, DK = 128, DV = 256, GIN = 3088, GIN_PAD = 3328;
constexpr int FH = 2816;
constexpr int NITEM = (M / 64) * 4;
constexpr float EPS = 1e-6f;
static_assert(M == pg8::EM, "rows");

constexpr size_t MiB = 1u << 20;
constexpr size_t WS_WAIN = 1 * MiB, WS_WAOUT = 13 * MiB, WS_WGU0 = 19 * MiB, WS_WGU1 = 30 * MiB, WS_WDN0 = 41 * MiB, WS_WDN1 = 46 * MiB + MiB / 2;
constexpr size_t WS_WBIN = 52 * MiB, WS_WBOUT = 58 * MiB + MiB / 2, WS_WM = 60 * MiB + MiB / 2;
constexpr size_t WS_RU = 61 * MiB, WS_RV = 157 * MiB;
constexpr size_t WS_RSQ = 253 * MiB, WS_GZ = 253 * MiB + MiB / 2, WS_DEC = 254 * MiB + MiB / 2, WS_END = 256 * MiB;
constexpr int LDS_BYTES = 147456, RING_BYTES = 131072;

#define GAS __attribute__((address_space(1)))
#define LAS __attribute__((address_space(3)))
typedef unsigned short bf16;
typedef unsigned v4u __attribute__((ext_vector_type(4)));
typedef unsigned v2u __attribute__((ext_vector_type(2)));
typedef float f32x4 __attribute__((ext_vector_type(4)));
typedef float f32x2 __attribute__((ext_vector_type(2)));
typedef short bf16x8 __attribute__((ext_vector_type(8)));
typedef short s16x4 __attribute__((ext_vector_type(4)));
#define LDS_WAIT() asm volatile("s_waitcnt lgkmcnt(0)" ::: "memory")
__device__ __forceinline__ unsigned f2bf(float f) { unsigned u = __builtin_bit_cast(unsigned, f); return (u + 0x7fffu + ((u >> 16) & 1u)) >> 16; }
__device__ __forceinline__ unsigned pk2(float lo, float hi) { return pg8::cvt_pk_bf16(lo, hi); }
__device__ __forceinline__ float bf_lo(unsigned w) { return __builtin_bit_cast(float, w << 16); }
__device__ __forceinline__ float bf_hi(unsigned w) { return __builtin_bit_cast(float, w & 0xffff0000u); }
__device__ __forceinline__ float bf1(bf16 h) { return __builtin_bit_cast(float, (unsigned)h << 16); }
__device__ __forceinline__ float wave_sum(float v) {
#pragma unroll
    for (int o = 1; o < 64; o <<= 1) v += __shfl_xor(v, o);
    return v;
}
#ifndef USE_TR
#define USE_TR 1
#endif
__device__ __forceinline__ bf16x8 tr_frag(LAS unsigned char* tile, int pitch, int k0, int n0, int lane) {
#if USE_TR
    const int g = lane >> 4, q = (lane & 15) >> 2, p = lane & 3;
    LAS unsigned char* a0 = tile + (k0 + 8 * g + q) * pitch + (n0 + 4 * p) * 2;
    const s16x4 lo = __builtin_amdgcn_ds_read_tr16_b64_v4i16((LAS s16x4*)a0);
    const s16x4 hi = __builtin_amdgcn_ds_read_tr16_b64_v4i16((LAS s16x4*)(a0 + 4 * pitch));
    return (bf16x8){lo[0], lo[1], lo[2], lo[3], hi[0], hi[1], hi[2], hi[3]};
#else
    bf16x8 r; const int g = lane >> 4;
#pragma unroll
    for (int j = 0; j < 8; ++j) r[j] = *(LAS short*)(tile + (k0 + 8 * g + j) * pitch + (n0 + (lane & 15)) * 2);
    return r;
#endif
}
#define MFMA16(a, b, c) __builtin_amdgcn_mfma_f32_16x16x32_bf16((a), (b), (c), 0, 0, 0)

__device__ __forceinline__ void p0_transpose_item(const float* W, int K, int N, bf16* WT, int drow0, const float* gain, LAS float* scr, int k0, int n0, int lane) {
    const int n = n0 + (lane & 31); float v[32];
#pragma unroll
    for (int i = 0; i < 32; ++i) { const int kk = 2 * i + (lane >> 5); v[i] = (n < N) ? W[(size_t)(k0 + kk) * N + n] : 0.f; }
    if (gain) {
#pragma unroll
        for (int i = 0; i < 32; ++i) v[i] *= gain[k0 + 2 * i + (lane >> 5)]; }
#pragma unroll
    for (int i = 0; i < 32; ++i) scr[(2 * i + (lane >> 5)) * 33 + (lane & 31)] = v[i];
    LDS_WAIT(); asm volatile("" ::: "memory");
    const int c = lane & 7;
#pragma unroll
    for (int j = 0; j < 4; ++j) { const int nn = (lane >> 3) + 8 * j; const LAS float* s = scr + (8 * c) * 33 + nn;
        v4u o; o.x = pk2(s[0 * 33], s[1 * 33]); o.y = pk2(s[2 * 33], s[3 * 33]); o.z = pk2(s[4 * 33], s[5 * 33]); o.w = pk2(s[6 * 33], s[7 * 33]);
        *(GAS v4u*)(WT + (size_t)(drow0 + nn) * K + k0 + 8 * c) = o; }
    LDS_WAIT(); asm volatile("" ::: "memory");
}

struct Args { const float* in[18]; float* out; unsigned char* ws; int ph_lo, ph_hi; };

__device__ __forceinline__ void p0_prologue(const Args& A, LAS unsigned char* lds, int gw, int NGW, int lane, int wave, int gtid, int NGT) {
    LAS float* scr = (LAS float*)(lds + wave * 16384);
    unsigned char* ws = A.ws;
    const float* mixn = A.in[1]; const float* ffnn = A.in[13];
    constexpr int I_AIN = 16 * 192, I_AOUT = 48 * 32, I_GU = 16 * 88, I_DN = 44 * 32, I_BIN = 16 * 97, I_BOUT = 16 * 32;
    constexpr int NITEMS = I_AIN + I_AOUT + 4 * I_GU + 2 * I_DN + I_BIN + I_BOUT;
    for (int it = gw; it < NITEMS; it += NGW) {
        int r = it;
        if (r < I_AIN) { const int kb = r / 192, nb = r % 192; p0_transpose_item(A.in[2], D, SGF, (bf16*)(ws + WS_WAIN), 32 * nb, mixn, scr, 64 * kb, 32 * nb, lane); continue; } r -= I_AIN;
        if (r < I_AOUT) { const int kb = r / 32, nb = r % 32; p0_transpose_item(A.in[7], SGW, D, (bf16*)(ws + WS_WAOUT), 32 * nb, nullptr, scr, 64 * kb, 32 * nb, lane); continue; } r -= I_AOUT;
        if (r < 4 * I_GU) { const int l = r / (2 * I_GU), r2 = r % (2 * I_GU), up = r2 / I_GU, r3 = r2 % I_GU, kb = r3 / 88, nb = r3 % 88, n0 = 32 * nb;
            const float* W = (up ? A.in[15] : A.in[14]) + (size_t)l * D * FH;
            p0_transpose_item(W, D, FH, (bf16*)(ws + (l ? WS_WGU1 : WS_WGU0)), 256 * (n0 >> 7) + (n0 & 127) + 128 * up, ffnn + l * D, scr, 64 * kb, n0, lane); continue; } r -= 4 * I_GU;
        if (r < 2 * I_DN) { const int l = r / I_DN, r2 = r % I_DN, kb = r2 / 32, nb = r2 % 32;
            p0_transpose_item(A.in[16] + (size_t)l * FH * D, FH, D, (bf16*)(ws + (l ? WS_WDN1 : WS_WDN0)), 32 * nb, nullptr, scr, 64 * kb, 32 * nb, lane); continue; } r -= 2 * I_DN;
        if (r < I_BIN) { const int kb = r / 97, nb = r % 97; p0_transpose_item(A.in[8], D, GIN, (bf16*)(ws + WS_WBIN), 32 * nb, mixn + D, scr, 64 * kb, 32 * nb, lane); continue; } r -= I_BIN;
        { const int kb = r / 32, nb = r % 32; p0_transpose_item(A.in[12], D, D, (bf16*)(ws + WS_WBOUT), 32 * nb, nullptr, scr, 64 * kb, 32 * nb, lane); }
    }
    { GAS v4u* z = (GAS v4u*)(ws + WS_WBIN + (size_t)3104 * D * 2); const int nz = (GIN_PAD - 3104) * D * 2 / 16;
      for (int i = gtid; i < nz; i += NGT) z[i] = (v4u){0u, 0u, 0u, 0u}; }
    { const float* wsrc = A.in[5]; bf16* wm = (bf16*)(ws + WS_WM);
      for (int i = gtid; i < 8 * 128 * 128 / 2; i += NGT) { const int e = 2 * i, t = (e >> 7) & 127, s = e & 127; const bool keep = (t >= 64) || (s < 64);
          const f32x2 v = *(const f32x2*)(wsrc + e); ((GAS unsigned*)wm)[i] = keep ? pk2(v.x, v.y) : 0u; } }
    { const float* x = A.in[0]; bf16* xb0 = (bf16*)A.out; float* rsq = (float*)(ws + WS_RSQ);
      for (int m0 = gw; m0 < M; m0 += 4 * NGW) { f32x4 v[4][4];
#pragma unroll
          for (int r = 0; r < 4; ++r) { const int m = m0 + r * NGW; if (m < M) { const GAS f32x4* xr = (const GAS f32x4*)(x + (size_t)m * D) + lane;
#pragma unroll
              for (int j = 0; j < 4; ++j) v[r][j] = xr[64 * j]; } }
#pragma unroll
          for (int r = 0; r < 4; ++r) { const int m = m0 + r * NGW; if (m < M) { float s = 0.f;
#pragma unroll
              for (int j = 0; j < 4; ++j) s += (v[r][j].x * v[r][j].x + v[r][j].y * v[r][j].y) + (v[r][j].z * v[r][j].z + v[r][j].w * v[r][j].w);
              s = wave_sum(s);
              GAS v2u* o8 = (GAS v2u*)(xb0 + (size_t)m * D) + lane;
#pragma unroll
              for (int j = 0; j < 4; ++j) o8[64 * j] = (v2u){pk2(v[r][j].x, v[r][j].y), pk2(v[r][j].z, v[r][j].w)};
              if (lane == 0) *(f32x4*)(rsq + (size_t)m * 4) = (f32x4){s, 0.f, 0.f, 0.f}; } } } }
}

__device__ __forceinline__ void sgu_phase(LAS unsigned char* lds, const bf16* Wm, const bf16* V, bf16* UY, const f32x2* statP, const float* ln_g, const float* ln_b, const float* b_s,
                                          int G, int bid, int tid, int lane, int wid) {
    constexpr int PA = 272;
    LAS unsigned char* As = lds; LAS unsigned char* Bs = lds + 34816;
    LAS f32x2* red = (LAS f32x2*)(lds + 69632); LAS f32x2* murs = (LAS f32x2*)(lds + 69632 + 4096);
    const int wr = wid >> 2, wc = wid & 3, fr = lane & 15, fq = lane >> 4;
    for (int item = bid; item < 256; item += G) {
        const int w = item >> 1, hh = item & 1, row0 = w * 128;
        { const int r = tid & 127, part = tid >> 7; float s1 = 0.f, s2 = 0.f;
#pragma unroll
          for (int j = 0; j < 12; ++j) { const f32x2 p = statP[(size_t)(part * 12 + j) * M + row0 + r]; s1 += p.x; s2 += p.y; }
          red[part * 128 + r] = (f32x2){s1, s2}; }
        __syncthreads();
        if (tid < 128) { const f32x2 a = red[tid], b = red[128 + tid], c = red[256 + tid], d = red[384 + tid];
            const float mean = ((a.x + b.x) + (c.x + d.x)) * (1.0f / 3072.0f), ex2 = ((a.y + b.y) + (c.y + d.y)) * (1.0f / 3072.0f);
            murs[tid] = (f32x2){mean, __builtin_amdgcn_rsqf(fmaxf(ex2 - mean * mean, 0.f) + EPS)}; }
        __syncthreads();
        const int ch = tid & 15, srow = tid >> 4;
        for (int gi = 0; gi < 4; ++gi) { const int g = hh * 4 + gi;
#pragma unroll
            for (int i = 0; i < 4; ++i) { const int id = tid + 512 * i, r = id >> 4, c = id & 15; *(LAS v4u*)(As + r * PA + c * 16) = *(const GAS v4u*)(Wm + (size_t)(g * 128 + r) * 128 + c * 8); }
            for (int cb = 0; cb < 3; ++cb) { const int c0 = g * SGC + cb * 128;
                const f32x4 lg0 = *(const f32x4*)(ln_g + c0 + 8 * ch), lg1 = *(const f32x4*)(ln_g + c0 + 8 * ch + 4), lb0 = *(const f32x4*)(ln_b + c0 + 8 * ch), lb1 = *(const f32x4*)(ln_b + c0 + 8 * ch + 4);
#pragma unroll
                for (int i = 0; i < 4; ++i) { const int s = srow + 32 * i; const v4u raw = *(const GAS v4u*)(V + (size_t)(row0 + s) * SGW + c0 + 8 * ch); const f32x2 ms = murs[s];
                    const f32x4 a = (f32x4){bf_lo(raw.x), bf_hi(raw.x), bf_lo(raw.y), bf_hi(raw.y)}, b = (f32x4){bf_lo(raw.z), bf_hi(raw.z), bf_lo(raw.w), bf_hi(raw.w)};
                    const f32x4 ya = (a - ms.x) * ms.y * lg0 + lb0, yb = (b - ms.x) * ms.y * lg1 + lb1;
                    *(LAS v4u*)(Bs + s * PA + ch * 16) = (v4u){pk2(ya[0], ya[1]), pk2(ya[2], ya[3]), pk2(yb[0], yb[1]), pk2(yb[2], yb[3])}; }
                __syncthreads();
                f32x4 acc[4][2];
#pragma unroll
                for (int m = 0; m < 4; ++m) { acc[m][0] = (f32x4){0.f, 0.f, 0.f, 0.f}; acc[m][1] = (f32x4){0.f, 0.f, 0.f, 0.f}; }
#pragma unroll
                for (int ks = 0; ks < 4; ++ks) { bf16x8 bfr[4];
#pragma unroll
                    for (int m = 0; m < 4; ++m) bfr[m] = *(const LAS bf16x8*)(As + (wr * 64 + m * 16 + fr) * PA + (ks * 32 + fq * 8) * 2);
#pragma unroll
                    for (int n = 0; n < 2; ++n) { const bf16x8 afr = tr_frag(Bs, PA, ks * 32, wc * 32 + n * 16, lane);
#pragma unroll
                        for (int m = 0; m < 4; ++m) acc[m][n] = MFMA16(afr, bfr[m], acc[m][n]); } }
#pragma unroll
                for (int m = 0; m < 4; ++m) { const int t = wr * 64 + m * 16 + fr; const float bs = b_s[g * 128 + t];
#pragma unroll
                    for (int n = 0; n < 2; ++n) { GAS v2u* p = (GAS v2u*)(UY + (size_t)(row0 + t) * SGW + c0 + wc * 32 + n * 16 + 4 * fq); const v2u uu = *p; const f32x4 sv = acc[m][n] + bs;
                        *p = (v2u){pk2(bf_lo(uu.x) * sv[0], bf_hi(uu.x) * sv[1]), pk2(bf_lo(uu.y) * sv[2], bf_hi(uu.y) * sv[3])}; } }
                __syncthreads();
            }
        }
    }
}

__device__ __forceinline__ float logsig16(float z) { return (fminf(z, 0.f) - __logf(1.0f + __expf(-fabsf(z)))) * (1.0f / 16.0f); }
#define GLA_G(lds, GZ, w_g2, b_g, r0, h, tid, Gv, Glast) do { \
    LAS float* gzs_ = (LAS float*)(lds); LAS float* tot_ = (LAS float*)((lds) + 4096); \
    if ((tid) < 256) *(LAS f32x4*)(gzs_ + 4 * (tid)) = *(const GAS f32x4*)((GZ) + (size_t)(r0) * 16 + 4 * (tid)); \
    const int kk_ = (tid) & 127, seg_ = (tid) >> 7; float w2_[16]; \
    _Pragma("unroll") for (int r_ = 0; r_ < 16; ++r_) w2_[r_] = (w_g2)[r_ * KD + (h) * DK + kk_]; \
    const float bg_ = (b_g)[(h) * DK + kk_]; \
    __syncthreads(); \
    float run_ = 0.f; \
    _Pragma("unroll") for (int tt_ = 0; tt_ < 16; ++tt_) { const LAS f32x4* gr_ = (const LAS f32x4*)(gzs_ + (seg_ * 16 + tt_) * 16); float z_ = bg_; \
        _Pragma("unroll") for (int q_ = 0; q_ < 4; ++q_) { const f32x4 g4_ = gr_[q_]; z_ += g4_[0] * w2_[4 * q_] + g4_[1] * w2_[4 * q_ + 1] + g4_[2] * w2_[4 * q_ + 2] + g4_[3] * w2_[4 * q_ + 3]; } \
        run_ += logsig16(z_); Gv[tt_] = run_; } \
    tot_[seg_ * 128 + kk_] = run_; \
    __syncthreads(); \
    { const float t0_ = tot_[kk_], t1_ = tot_[128 + kk_], t2_ = tot_[256 + kk_], t3_ = tot_[384 + kk_]; \
      const float pre_ = (seg_ > 0 ? t0_ : 0.f) + (seg_ > 1 ? t1_ : 0.f) + (seg_ > 2 ? t2_ : 0.f); \
      _Pragma("unroll") for (int tt_ = 0; tt_ < 16; ++tt_) Gv[tt_] += pre_; \
      Glast = ((t0_ + t1_) + t2_) + t3_; } \
} while (0)

constexpr int G_KT = 8192, G_QT = 8192 + 17408, G_VT = 43008, G_PM = 76800, G_RED = 86016;
constexpr int PK = 272, PV = 528, PP = 144;

__device__ __forceinline__ void gla_state_phase(LAS unsigned char* lds, const bf16* Kg, const bf16* Vg, const float* GZ, const float* w_g2, const float* b_g, bf16* dS, float* dec,
                                                int G, int bid, int tid, int lane, int wid) {
    const int fr = lane & 15, fq = lane >> 4;
    for (int item = bid; item < NITEM; item += G) {
        const int h = item & 3, r0 = (item >> 2) * 64;
        float Gv[16], Glast;
        GLA_G(lds, GZ, w_g2, b_g, r0, h, tid, Gv, Glast);
        const int kk = tid & 127, seg = tid >> 7;
#pragma unroll
        for (int tt = 0; tt < 16; ++tt) { const int t = seg * 16 + tt; const float kv = bf1(Kg[(size_t)(r0 + t) * KD + h * DK + kk]);
            *(LAS bf16*)(lds + G_KT + t * PK + kk * 2) = (bf16)f2bf(kv * __expf(Glast - Gv[tt])); }
#pragma unroll
        for (int i = 0; i < 4; ++i) { const int id = tid + 512 * i, t = id >> 5, c = id & 31; *(LAS v4u*)(lds + G_VT + t * PV + c * 16) = *(const GAS v4u*)(Vg + (size_t)(r0 + t) * VD + h * DV + c * 8); }
        if (seg == 0) dec[(size_t)item * DK + kk] = __expf(Glast);
        __syncthreads();
        f32x4 acc[2][8];
#pragma unroll
        for (int d = 0; d < 2; ++d)
#pragma unroll
            for (int kt = 0; kt < 8; ++kt) acc[d][kt] = (f32x4){0.f, 0.f, 0.f, 0.f};
#pragma unroll
        for (int ks = 0; ks < 2; ++ks) { bf16x8 bfr[2];
#pragma unroll
            for (int d = 0; d < 2; ++d) bfr[d] = tr_frag(lds + G_VT, PV, ks * 32, 16 * (2 * wid + d), lane);
#pragma unroll
            for (int kt = 0; kt < 8; ++kt) { const bf16x8 afr = tr_frag(lds + G_KT, PK, ks * 32, 16 * kt, lane);
#pragma unroll
                for (int d = 0; d < 2; ++d) acc[d][kt] = MFMA16(afr, bfr[d], acc[d][kt]); } }
#pragma unroll
        for (int d = 0; d < 2; ++d) { bf16* rowp = dS + (size_t)item * (DV * DK) + (size_t)(16 * (2 * wid + d) + fr) * DK + 4 * fq;
#pragma unroll
            for (int kt = 0; kt < 8; ++kt) *(GAS v2u*)(rowp + 16 * kt) = (v2u){pk2(acc[d][kt][0], acc[d][kt][1]), pk2(acc[d][kt][2], acc[d][kt][3])}; }
        __syncthreads();
    }
}

__device__ __forceinline__ void gla_scan_phase(bf16* dS, const float* dec, int gtid, int NGT) {
    for (int e = gtid; e < 8 * DV * DK / 2; e += NGT) {
        const int bh = e >> 14, rem = e & 16383, b = bh >> 2, h = bh & 3;
        GAS unsigned* p = (GAS unsigned*)(dS + ((size_t)(b * 128) * 4 + h) * (DV * DK)) + rem;
        const GAS f32x2* dp = (const GAS f32x2*)(dec + ((size_t)(b * 128) * 4 + h) * DK) + (rem & 63);
        float s0 = 0.f, s1 = 0.f;
        for (int n0 = 0; n0 < 128; n0 += 8) { unsigned d[8]; f32x2 dc[8];
#pragma unroll
            for (int j = 0; j < 8; ++j) { d[j] = p[(size_t)(n0 + j) * (2 * DV * DK)]; dc[j] = dp[(size_t)(n0 + j) * (2 * DK)]; }
#pragma unroll
            for (int j = 0; j < 8; ++j) { p[(size_t)(n0 + j) * (2 * DV * DK)] = pk2(s0, s1); s0 = s0 * dc[j].x + bf_lo(d[j]); s1 = s1 * dc[j].y + bf_hi(d[j]); } }
    }
}

__device__ __forceinline__ void gla_out_phase(LAS unsigned char* lds, const bf16* Qg, const bf16* Kg, const bf16* Vg, bf16* SROG, const float* GZ, const float* w_g2, const float* b_g, const float* gn_g,
                                              const bf16* Sprev, int G, int bid, int tid, int lane, int wid) {
    const int fr = lane & 15, fq = lane >> 4;
    LAS float* red = (LAS float*)(lds + G_RED);
    for (int item = bid; item < NITEM; item += G) {
        const int h = item & 3, r0 = (item >> 2) * 64;
        float Gv[16], Glast;
        GLA_G(lds, GZ, w_g2, b_g, r0, h, tid, Gv, Glast);
        const int kk = tid & 127, seg = tid >> 7;
#pragma unroll
        for (int tt = 0; tt < 16; ++tt) { const int t = seg * 16 + tt; const size_t go = (size_t)(r0 + t) * KD + h * DK + kk; const float qv = bf1(Qg[go]), kv = bf1(Kg[go]);
            *(LAS bf16*)(lds + G_QT + t * PK + kk * 2) = (bf16)f2bf(qv * __expf(Gv[tt])); *(LAS bf16*)(lds + G_KT + t * PK + kk * 2) = (bf16)f2bf(kv * __expf(-Gv[tt])); }
#pragma unroll
        for (int i = 0; i < 4; ++i) { const int id = tid + 512 * i, t = id >> 5, c = id & 31; *(LAS v4u*)(lds + G_VT + t * PV + c * 16) = *(const GAS v4u*)(Vg + (size_t)(r0 + t) * VD + h * DV + c * 8); }
        __syncthreads();
        { const int it = wid >> 1;
#pragma unroll
          for (int jj = 0; jj < 2; ++jj) { const int jt = 2 * (wid & 1) + jj; f32x4 pa = (f32x4){0.f, 0.f, 0.f, 0.f};
#pragma unroll
              for (int ks = 0; ks < 4; ++ks) { const bf16x8 a = *(const LAS bf16x8*)(lds + G_KT + (16 * jt + fr) * PK + (32 * ks + 8 * fq) * 2), b = *(const LAS bf16x8*)(lds + G_QT + (16 * it + fr) * PK + (32 * ks + 8 * fq) * 2);
                  pa = MFMA16(a, b, pa); }
              const int i = 16 * it + fr, j0 = 16 * jt + 4 * fq;
              *(LAS v2u*)(lds + G_PM + i * PP + j0 * 2) = (v2u){pk2(j0 <= i ? pa[0] : 0.f, j0 + 1 <= i ? pa[1] : 0.f), pk2(j0 + 2 <= i ? pa[2] : 0.f, j0 + 3 <= i ? pa[3] : 0.f)}; } }
        __syncthreads();
        f32x4 acc[4][2];
#pragma unroll
        for (int it = 0; it < 4; ++it) { acc[it][0] = (f32x4){0.f, 0.f, 0.f, 0.f}; acc[it][1] = (f32x4){0.f, 0.f, 0.f, 0.f}; }
#pragma unroll
        for (int ks = 0; ks < 2; ++ks) { bf16x8 a[2];
#pragma unroll
            for (int d = 0; d < 2; ++d) a[d] = tr_frag(lds + G_VT, PV, ks * 32, 16 * (2 * wid + d), lane);
#pragma unroll
            for (int it = 0; it < 4; ++it) { const bf16x8 b = *(const LAS bf16x8*)(lds + G_PM + (16 * it + fr) * PP + (32 * ks + 8 * fq) * 2);
#pragma unroll
                for (int d = 0; d < 2; ++d) acc[it][d] = MFMA16(a[d], b, acc[it][d]); } }
#pragma unroll
        for (int ks = 0; ks < 4; ++ks) { bf16x8 a[2];
#pragma unroll
            for (int d = 0; d < 2; ++d) a[d] = *(const GAS bf16x8*)(Sprev + (size_t)item * (DV * DK) + (size_t)(16 * (2 * wid + d) + fr) * DK + 32 * ks + 8 * fq);
#pragma unroll
            for (int it = 0; it < 4; ++it) { const bf16x8 b = *(const LAS bf16x8*)(lds + G_QT + (16 * it + fr) * PK + (32 * ks + 8 * fq) * 2);
#pragma unroll
                for (int d = 0; d < 2; ++d) acc[it][d] = MFMA16(a[d], b, acc[it][d]); } }
#pragma unroll
        for (int it = 0; it < 4; ++it) { float ss = 0.f;
#pragma unroll
            for (int d = 0; d < 2; ++d) ss += (acc[it][d][0] * acc[it][d][0] + acc[it][d][1] * acc[it][d][1]) + (acc[it][d][2] * acc[it][d][2] + acc[it][d][3] * acc[it][d][3]);
            ss += __shfl_xor(ss, 16); ss += __shfl_xor(ss, 32);
            if (fq == 0) red[wid * 64 + 16 * it + fr] = ss; }
        __syncthreads();
#pragma unroll
        for (int it = 0; it < 4; ++it) { const int i = 16 * it + fr; float tot = 0.f;
#pragma unroll
            for (int w8 = 0; w8 < 8; ++w8) tot += red[w8 * 64 + i];
            const float rms = __builtin_amdgcn_rsqf(tot * (1.0f / 256.0f) + EPS);
#pragma unroll
            for (int d = 0; d < 2; ++d) { const int dv = 16 * (2 * wid + d) + 4 * fq; const f32x4 gn = *(const f32x4*)(gn_g + h * DV + dv);
                GAS v2u* p = (GAS v2u*)(SROG + (size_t)(r0 + i) * VD + h * DV + dv); const v2u sr = *p; const f32x4 o = acc[it][d] * rms * gn;
                *p = (v2u){pk2(o[0] * bf_lo(sr.x), o[1] * bf_hi(sr.x)), pk2(o[2] * bf_lo(sr.y), o[3] * bf_hi(sr.y))}; } }
        __syncthreads();
    }
}

constexpr int NPHASE = 14;
__global__ void __launch_bounds__(NTHREADS, 2) mk_fwd(Args args) {
    extern __shared__ __attribute__((aligned(16))) unsigned char lds_raw[];
    LAS unsigned char* lds = (LAS unsigned char*)lds_raw;
    cg::grid_group grid = cg::this_grid();
    const int tid = threadIdx.x, lane = tid & 63, wave = __builtin_amdgcn_readfirstlane(tid >> 6);
    const int G = gridDim.x, bid = blockIdx.x;
    const int vcu = (G % 8 == 0) ? (bid % 8) * (G / 8) + bid / 8 : bid;
    const int gw = vcu * NWAVES + wave, NGW = G * NWAVES, gtid = vcu * NTHREADS + tid, NGT = G * NTHREADS;
    unsigned char* ws = args.ws;
    const int lo = args.ph_lo, hi = args.ph_hi;
#define IN(k) (lo <= (k) && (k) < hi)
#define SEAM(k) do { if (IN(k) && IN((k) + 1)) grid.sync(); } while (0)
    float* X = args.out;
    float* rsq = (float*)(ws + WS_RSQ);
    bf16* XB = (bf16*)(ws + WS_RV);

    if (IN(0)) { p0_prologue(args, lds, gw, NGW, lane, wave, gtid, NGT); } SEAM(0);
    if (IN(1)) {
        pg8::Gemm g{(const bf16*)args.out, (const bf16*)(ws + WS_WAIN), M, SGF, D}; pg8::StaticOrder S; S.init(M, SGF, G, bid);
        pg8::EpiSguIn E{(bf16*)(ws + WS_RU), (bf16*)(ws + WS_RV), rsq, (pg8::f32x2*)((unsigned char*)args.out + 32 * MiB)};
        pg8::gemm_phase<pg8::EpiSguIn, pg8::StaticOrder, true, true>(lds, g, S, E);
    } SEAM(1);
    if (IN(2)) { sgu_phase(lds, (const bf16*)(ws + WS_WM), (const bf16*)(ws + WS_RV), (bf16*)(ws + WS_RU), (const f32x2*)((unsigned char*)args.out + 32 * MiB), args.in[3], args.in[4], args.in[6], G, vcu, tid, lane, wave); } SEAM(2);
    if (IN(3)) {
        pg8::Gemm g{(const bf16*)(ws + WS_RU), (const bf16*)(ws + WS_WAOUT), M, D, SGW}; pg8::StaticOrder S; S.init(M, D, G, bid);
        pg8::EpiResid<true> E{args.in[0], XB, rsq};
        pg8::gemm_phase<pg8::EpiResid<true>, pg8::StaticOrder, false, true>(lds, g, S, E);
    } SEAM(3);
    if (IN(4)) {
        pg8::Gemm g{XB, (const bf16*)(ws + WS_WGU0), M, 2 * FH, D}; pg8::StaticOrder S; S.init(M, 2 * FH, G, bid);
        pg8::EpiSwiGLU E{(bf16*)(ws + WS_RU), FH, rsq};
        pg8::gemm_phase<pg8::EpiSwiGLU, pg8::StaticOrder, true, true>(lds, g, S, E);
    } SEAM(4);
    if (IN(5)) {
        pg8::Gemm g{(const bf16*)(ws + WS_RU), (const bf16*)(ws + WS_WDN0), M, D, FH}; pg8::StaticOrder S; S.init(M, D, G, bid);
        pg8::EpiResid<false> E{XB, XB, rsq};
        pg8::gemm_phase<pg8::EpiResid<false>, pg8::StaticOrder, false, true>(lds, g, S, E);
    } SEAM(5);
    bf16* Qg = (bf16*)(ws + WS_RU); bf16* Kg = (bf16*)(ws + WS_RU + 16 * MiB); bf16* Vg = (bf16*)(ws + WS_RU + 32 * MiB); bf16* SR = (bf16*)(ws + WS_RU + 64 * MiB);
    bf16* dS = (bf16*)(ws + WS_RV + 32 * MiB); float* GZ = (float*)(ws + WS_GZ); float* dec = (float*)(ws + WS_DEC);
    if (IN(6)) {
        pg8::Gemm g{XB, (const bf16*)(ws + WS_WBIN), M, GIN_PAD, D}; pg8::StaticOrder S; S.init(M, GIN_PAD, G, bid);
        pg8::EpiGlaIn E{Qg, Kg, Vg, SR, GZ, rsq};
        pg8::gemm_phase<pg8::EpiGlaIn, pg8::StaticOrder, true, true>(lds, g, S, E);
    } SEAM(6);
    if (IN(7)) { gla_state_phase(lds, Kg, Vg, GZ, args.in[9], args.in[10], dS, dec, G, vcu, tid, lane, wave); } SEAM(7);
    if (IN(8)) { gla_scan_phase(dS, dec, gtid, NGT); } SEAM(8);
    if (IN(9)) { gla_out_phase(lds, Qg, Kg, Vg, SR, GZ, args.in[9], args.in[10], args.in[11], dS, G, vcu, tid, lane, wave); } SEAM(9);
    if (IN(10)) {
        pg8::Gemm g{SR, (const bf16*)(ws + WS_WBOUT), M, D, VD}; pg8::StaticOrder S; S.init(M, D, G, bid);
        pg8::EpiResid<false> E{XB, XB, rsq};
        pg8::gemm_phase<pg8::EpiResid<false>, pg8::StaticOrder, false, true>(lds, g, S, E);
    } SEAM(10);
    if (IN(11)) {
        pg8::Gemm g{XB, (const bf16*)(ws + WS_WGU1), M, 2 * FH, D}; pg8::StaticOrder S; S.init(M, 2 * FH, G, bid);
        pg8::EpiSwiGLU E{(bf16*)(ws + WS_RU), FH, rsq};
        pg8::gemm_phase<pg8::EpiSwiGLU, pg8::StaticOrder, true, true>(lds, g, S, E);
    } SEAM(11);
    if (IN(12)) {
        pg8::Gemm g{(const bf16*)(ws + WS_RU), (const bf16*)(ws + WS_WDN1), M, D, FH}; pg8::StaticOrder S; S.init(M, D, G, bid);
        pg8::EpiResid<false> E{XB, XB, rsq};
        pg8::gemm_phase<pg8::EpiResid<false>, pg8::StaticOrder, false, true>(lds, g, S, E);
    } SEAM(12);
    if (IN(13)) {
        const float* fg = args.in[17];
        f32x4 gv[4];
#pragma unroll
        for (int j = 0; j < 4; ++j) gv[j] = *(const f32x4*)(fg + 8 * lane + 512 * (j >> 1) + 4 * (j & 1));
        for (int m0 = gw; m0 < M; m0 += 8 * NGW) { v4u w[8][2]; float rs[8];
#pragma unroll
            for (int r = 0; r < 8; ++r) { const int m = m0 + r * NGW; if (m < M) { const GAS v4u* xr = (const GAS v4u*)(XB + (size_t)m * D) + lane; w[r][0] = xr[0]; w[r][1] = xr[64]; rs[r] = pg8::row_rs(rsq, m); } }
#pragma unroll
            for (int r = 0; r < 8; ++r) { const int m = m0 + r * NGW; if (m < M) { GAS f32x4* o = (GAS f32x4*)(X + (size_t)m * D) + 2 * lane;
#pragma unroll
                for (int hh = 0; hh < 2; ++hh) { const v4u q = w[r][hh];
                    o[128 * hh] = (f32x4){bf_lo(q.x), bf_hi(q.x), bf_lo(q.y), bf_hi(q.y)} * rs[r] * gv[2 * hh];
                    o[128 * hh + 1] = (f32x4){bf_lo(q.z), bf_hi(q.z), bf_lo(q.w), bf_hi(q.w)} * rs[r] * gv[2 * hh + 1]; } } } }
    }
#undef IN
#undef SEAM
}


__global__ void digest_k(const unsigned short* a, size_t na, const float* f, size_t nf, float* out) {
    const size_t n = (size_t)16384 * 1024;
    for (size_t i = (size_t)blockIdx.x * blockDim.x + threadIdx.x; i < n; i += (size_t)gridDim.x * blockDim.x) {
        float v = 0.f;
        for (size_t k = 0; k * n + i < na; ++k) v += __builtin_bit_cast(float, (unsigned)a[k * n + i] << 16);
        if (nf) v += f[i % nf];
        if (!(fabsf(v) < 1e30f)) v = 1e30f;
        out[i] = v;
    }
}
#ifndef MK_N_LAUNCHES
#define MK_N_LAUNCHES 1
#define DBG_NPH 14
#endif
extern "C" void kernel_launch(void* const* d_in, const int* in_sizes, int n_in, void* d_out, int out_size, void* d_ws, size_t ws_size, hipStream_t stream) {
    static int grid = 0;
    if (grid == 0) {
        if (n_in != 18 || in_sizes[0] != M * D || out_size != M * D || ws_size < WS_END) { fprintf(stderr, "kernel_launch: unexpected shapes (n_in %d, in0 %d, out %d, ws %zu); nothing launched\n", n_in, n_in > 0 ? in_sizes[0] : -1, out_size, ws_size); grid = -1; return; }
        int dev = 0, cus = 0, per_cu = 0;
        if (hipGetDevice(&dev) != hipSuccess || hipDeviceGetAttribute(&cus, hipDeviceAttributeMultiprocessorCount, dev) != hipSuccess) { grid = -1; return; }
        if (hipFuncSetAttribute((const void*)mk_fwd, hipFuncAttributeMaxDynamicSharedMemorySize, LDS_BYTES) != hipSuccess) { fprintf(stderr, "kernel_launch: hipFuncSetAttribute failed\n"); grid = -1; return; }
        if (hipOccupancyMaxActiveBlocksPerMultiprocessor(&per_cu, (const void*)mk_fwd, NTHREADS, LDS_BYTES) != hipSuccess || per_cu < 1) { fprintf(stderr, "kernel_launch: occupancy query gives %d blocks per CU\n", per_cu); (void)hipGetLastError(); grid = -1; return; }
        grid = cus;
        if (grid != 256) { fprintf(stderr, "kernel_launch: built for a 256-CU device (got %d)\n", cus); grid = -1; return; }
    }
    if (grid < 0) return;
    Args a{};
    for (int i = 0; i < 18; ++i) a.in[i] = (const float*)d_in[i];
    a.out = (float*)d_out; a.ws = (unsigned char*)d_ws;
#if MK_N_LAUNCHES == 1
    a.ph_lo = 0; a.ph_hi = NPHASE;
    void* kargs[] = {&a};
    hipError_t e = hipLaunchCooperativeKernel((const void*)mk_fwd, dim3(grid), dim3(NTHREADS), kargs, LDS_BYTES, stream);
    if (e != hipSuccess) fprintf(stderr, "kernel_launch: cooperative launch failed: %s\n", hipGetErrorString(e));
#else
    for (int p = 0; p < DBG_NPH; ++p) { a.ph_lo = p; a.ph_hi = p + 1; hipLaunchKernelGGL(mk_fwd, dim3(grid), dim3(NTHREADS), LDS_BYTES, stream, a); }
#ifdef DBG_DIG
    { unsigned char* w = (unsigned char*)d_ws; const size_t n16 = (size_t)16384 * 1024;
      const unsigned short* da = nullptr; size_t na = 0; const float* df = nullptr; size_t nf = 0;
      if (DBG_DIG == 6) { da = (const unsigned short*)(w + WS_RU); na = 3 * n16; df = (const float*)(w + WS_GZ); nf = 262144; }
      if (DBG_DIG == 7 || DBG_DIG == 8) { da = (const unsigned short*)(w + WS_RV + 32 * MiB); na = 2 * n16; df = (const float*)(w + WS_DEC); nf = 131072; }
      if (DBG_DIG == 9) { da = (const unsigned short*)(w + WS_RU + 64 * MiB); na = n16; }
      hipLaunchKernelGGL(digest_k, dim3(2048), dim3(256), 0, stream, da, na, df, nf, (float*)d_out); }
#endif
#endif
}
```

```cpp
#include <hip/hip_runtime.h>
#include <hip/hip_cooperative_groups.h>
#include <cstdio>
#include <cstdint>
namespace cg = cooperative_groups;
namespace pg8 {
#define PG8_LAS __attribute__((address_space(3)))
typedef unsigned short bf16_t;
typedef short bf16x8 __attribute__((ext_vector_type(8)));
typedef float f32x4 __attribute__((ext_vector_type(4)));
typedef unsigned u32x4 __attribute__((ext_vector_type(4)));
constexpr int BM = 256, BK = 64, HALF = 128, HTB = HALF * BK * 2  , STAGE_BYTES = 8 * HTB, NXCD = 8, WGM = 8;

__host__ __device__ __forceinline__ int lds_byte(int r, int c) { const int st = (r >> 4) * 2 + (c >> 5), rr = r & 15, cc = c & 31, ob = rr * 64 + cc * 2; return st * 1024 + (ob ^ (((ob >> 9) & 1) << 5)); }
__host__ __device__ __forceinline__ void stage_rc(int b, int& R, int& C) { const int st = b / 1024, sb = b % 1024, swz = sb ^ (((sb >> 9) & 1) << 5); R = (st >> 1) * 16 + swz / 64; C = (st & 1) * 32 + (swz % 64) / 2; }
__host__ __device__ __forceinline__ int perm32(int rho) { const int n = rho >> 4, i = rho & 15; return 8 * (i >> 2) + 4 * n + (i & 3); }

struct Unit { int pm, pn; };
struct Gemm { const bf16_t* A; const bf16_t* Bt; int M, N, K; };

struct StaticOrder {
    int nM, nN, nwg, G, c;
    __host__ __device__ void init(int M, int N, int G_, int c_) { nM = M / BM; nN = N / BM; nwg = nM * nN; G = G_; c = c_; }
    __host__ __device__ bool next(int i, Unit& u) const {
        const long L = (long)i * G + c; if (L >= nwg) return false;
        int wgid = (int)L; { const int q = nwg / NXCD, r = nwg % NXCD, xcd = wgid % NXCD, off = wgid / NXCD; wgid = (xcd < r ? xcd * (q + 1) : r * (q + 1) + (xcd - r) * q) + off; }
        const int nig = WGM * nN, gid = wgid / nig, fm = gid * WGM, gsz = (nM - fm) < WGM ? (nM - fm) : WGM;
        u.pm = fm + ((wgid % nig) % gsz); u.pn = (wgid % nig) / gsz; return true;
    }
    __device__ __forceinline__ void a_ready(const Unit&) const {}
    __device__ __forceinline__ void done(const Unit&) const {}
};

typedef float f32x2 __attribute__((ext_vector_type(2)));
typedef __bf16 bf16x2v __attribute__((ext_vector_type(2)));
__device__ __forceinline__ unsigned cvt_pk_bf16(float lo, float hi) { const bf16x2v r = __builtin_convertvector((f32x2){lo, hi}, bf16x2v); return __builtin_bit_cast(unsigned, r); }
__device__ __forceinline__ f32x2 gelu_pk(f32x2 v) {
    const f32x2 av = __builtin_elementwise_abs(v), d = av * 0.2316418882f + 1.0f;
    f32x2 t; t.x = __builtin_amdgcn_rcpf(d.x); t.y = __builtin_amdgcn_rcpf(d.y);
    f32x2 q = t * 0.5307027145f + (-0.7265760135f); q = q * t + 0.7107068705f; q = q * t + (-0.142248368f); q = q * t + 0.127414796f; q = q * t;
    const f32x2 s = (v * v) * (-0.72134752044f);
    f32x2 e; e.x = __builtin_amdgcn_exp2f(s.x); e.y = __builtin_amdgcn_exp2f(s.y);
    const f32x2 m = v * (q * e), r = v - m;
    f32x2 o; o.x = v.x < 0.f ? m.x : r.x; o.y = v.y < 0.f ? m.y : r.y; return o;
}

constexpr int EM = 16384;
constexpr float EEPS = 1e-6f;
__device__ __forceinline__ float row_rs(const float* rsq, int row) {
    const f32x4 p = *(const f32x4*)(rsq + (size_t)row * 4);
    return __builtin_amdgcn_rsqf(((p[0] + p[1]) + (p[2] + p[3])) * (1.0f / 1024.0f) + EEPS);
}
__device__ __forceinline__ float silu_f(float v) { return v * __builtin_amdgcn_rcpf(1.0f + __expf(-v)); }

struct EpiSguIn {
    static constexpr bool PERM = true, AFTER_DRAIN = false;
    bf16_t* U; bf16_t* V; const float* rsq; f32x2* statP;
    __device__ __forceinline__ void operator()(const f32x4 (&acc)[2][2][4][2], const Unit& u, int wr, int wc, int fr, int fq) const {
        const bool isv = u.pn >= 12;
        bf16_t* base = isv ? V : U; const int colt = (isv ? u.pn - 12 : u.pn) * BM + wc * 32 + 8 * fq;
        const int row0 = u.pm * BM + wr * 64 + fr;
#pragma unroll
        for (int ai = 0; ai < 2; ++ai)
#pragma unroll
            for (int m = 0; m < 4; ++m) { const int row = row0 + ai * HALF + m * 16; const float rs = row_rs(rsq, row);
                bf16_t* rowp = base + (size_t)row * 3072 + colt; float s1 = 0.f, s2 = 0.f;
#pragma unroll
                for (int bj = 0; bj < 2; ++bj) { const f32x4 v0 = acc[ai][bj][m][0] * rs, v1 = acc[ai][bj][m][1] * rs;
                    const f32x2 a = gelu_pk((f32x2){v0[0], v0[1]}), b = gelu_pk((f32x2){v0[2], v0[3]}), c = gelu_pk((f32x2){v1[0], v1[1]}), d = gelu_pk((f32x2){v1[2], v1[3]});
                    s1 += ((a.x + a.y) + (b.x + b.y)) + ((c.x + c.y) + (d.x + d.y));
                    s2 += ((a.x * a.x + a.y * a.y) + (b.x * b.x + b.y * b.y)) + ((c.x * c.x + c.y * c.y) + (d.x * d.x + d.y * d.y));
                    u32x4 w; w.x = cvt_pk_bf16(a.x, a.y); w.y = cvt_pk_bf16(b.x, b.y); w.z = cvt_pk_bf16(c.x, c.y); w.w = cvt_pk_bf16(d.x, d.y);
                    *(u32x4*)(rowp + bj * HALF) = w; }
                if (isv) { s1 += __shfl_xor(s1, 16); s1 += __shfl_xor(s1, 32); s2 += __shfl_xor(s2, 16); s2 += __shfl_xor(s2, 32);
                    if (fq == 0) statP[(size_t)((u.pn - 12) * 4 + wc) * EM + row] = (f32x2){s1, s2}; } }
    }
};
struct EpiSwiGLU {
    static constexpr bool PERM = true, AFTER_DRAIN = false;
    bf16_t* Hd; int ldh; const float* rsq;
    __device__ __forceinline__ void operator()(const f32x4 (&acc)[2][2][4][2], const Unit& u, int wr, int wc, int fr, int fq) const {
        const int row0 = u.pm * BM + wr * 64 + fr, col0 = u.pn * HALF + wc * 32 + 8 * fq;
#pragma unroll
        for (int ai = 0; ai < 2; ++ai)
#pragma unroll
            for (int m = 0; m < 4; ++m) { const int row = row0 + ai * HALF + m * 16; const float rs = row_rs(rsq, row);
                const f32x4 g0 = acc[ai][0][m][0] * rs, g1 = acc[ai][0][m][1] * rs, u0 = acc[ai][1][m][0] * rs, u1 = acc[ai][1][m][1] * rs;
                u32x4 w; w.x = cvt_pk_bf16(silu_f(g0[0]) * u0[0], silu_f(g0[1]) * u0[1]); w.y = cvt_pk_bf16(silu_f(g0[2]) * u0[2], silu_f(g0[3]) * u0[3]);
                w.z = cvt_pk_bf16(silu_f(g1[0]) * u1[0], silu_f(g1[1]) * u1[1]); w.w = cvt_pk_bf16(silu_f(g1[2]) * u1[2], silu_f(g1[3]) * u1[3]);
                *(u32x4*)(Hd + (size_t)row * ldh + col0) = w; }
    }
};
struct EpiGlaIn {
    static constexpr bool PERM = true, AFTER_DRAIN = false;
    bf16_t* Q; bf16_t* Kk; bf16_t* Vv; bf16_t* SR; float* GZ; const float* rsq;
    __device__ __forceinline__ void operator()(const f32x4 (&acc)[2][2][4][2], const Unit& u, int wr, int wc, int fr, int fq) const {
        const int row0 = u.pm * BM + wr * 64 + fr, pn = u.pn;
        if (pn == 12) {
            if (wc == 0 && fq < 2) {
#pragma unroll
                for (int ai = 0; ai < 2; ++ai)
#pragma unroll
                    for (int m = 0; m < 4; ++m) { const int row = row0 + ai * HALF + m * 16; const float rs = row_rs(rsq, row);
                        float* p = GZ + (size_t)row * 16 + 8 * fq; *(f32x4*)p = acc[ai][0][m][0] * rs; *(f32x4*)(p + 4) = acc[ai][0][m][1] * rs; }
            }
            return;
        }
        bf16_t* base; int ld, colt; float sc = 1.f; const bool act = pn >= 8;
        if (pn < 2) { base = Q; ld = 512; colt = pn * BM; sc = 0.08838834764831845f; } else if (pn < 4) { base = Kk; ld = 512; colt = (pn - 2) * BM; }
        else if (pn < 8) { base = Vv; ld = 1024; colt = (pn - 4) * BM; } else { base = SR; ld = 1024; colt = (pn - 8) * BM; }
        colt += wc * 32 + 8 * fq;
#pragma unroll
        for (int ai = 0; ai < 2; ++ai)
#pragma unroll
            for (int m = 0; m < 4; ++m) { const int row = row0 + ai * HALF + m * 16; const float rs = row_rs(rsq, row) * sc;
                bf16_t* rowp = base + (size_t)row * ld + colt;
#pragma unroll
                for (int bj = 0; bj < 2; ++bj) { f32x4 v0 = acc[ai][bj][m][0] * rs, v1 = acc[ai][bj][m][1] * rs;
                    if (act) { v0 = (f32x4){silu_f(v0[0]), silu_f(v0[1]), silu_f(v0[2]), silu_f(v0[3])}; v1 = (f32x4){silu_f(v1[0]), silu_f(v1[1]), silu_f(v1[2]), silu_f(v1[3])}; }
                    u32x4 w; w.x = cvt_pk_bf16(v0[0], v0[1]); w.y = cvt_pk_bf16(v0[2], v0[3]); w.z = cvt_pk_bf16(v1[0], v1[1]); w.w = cvt_pk_bf16(v1[2], v1[3]);
                    *(u32x4*)(rowp + bj * HALF) = w; } }
    }
};
template <bool F32BASE> struct EpiResid {
    static constexpr bool PERM = true, AFTER_DRAIN = true;
    const void* base; bf16_t* xb; float* rsq;
    __device__ __forceinline__ void fused(f32x4 (&acc)[2][2][4][2], const Unit& u, int wr, int wc, int fr, int fq, PG8_LAS unsigned char* lds, int wid, int lane) const {
        PG8_LAS float* P = (PG8_LAS float*)lds;
        const int col0 = u.pn * BM + wc * 32 + 8 * fq;
#pragma unroll
        for (int ai = 0; ai < 2; ++ai)
#pragma unroll
            for (int m = 0; m < 4; ++m) { const int r = ai * HALF + wr * 64 + m * 16 + fr; const size_t off = (size_t)(u.pm * BM + r) * 1024 + col0; float ss = 0.f;
#pragma unroll
                for (int bj = 0; bj < 2; ++bj) { f32x4 b0, b1;
                    if (F32BASE) { const float* bp = (const float*)base + off + bj * HALF; b0 = *(const f32x4*)bp; b1 = *(const f32x4*)(bp + 4); }
                    else { const u32x4 w = *(const u32x4*)((const bf16_t*)base + off + bj * HALF);
                        b0 = (f32x4){__builtin_bit_cast(float, w.x << 16), __builtin_bit_cast(float, w.x & 0xffff0000u), __builtin_bit_cast(float, w.y << 16), __builtin_bit_cast(float, w.y & 0xffff0000u)};
                        b1 = (f32x4){__builtin_bit_cast(float, w.z << 16), __builtin_bit_cast(float, w.z & 0xffff0000u), __builtin_bit_cast(float, w.w << 16), __builtin_bit_cast(float, w.w & 0xffff0000u)}; }
                    const f32x4 o0 = b0 + acc[ai][bj][m][0], o1 = b1 + acc[ai][bj][m][1];
                    u32x4 w; w.x = cvt_pk_bf16(o0[0], o0[1]); w.y = cvt_pk_bf16(o0[2], o0[3]); w.z = cvt_pk_bf16(o1[0], o1[1]); w.w = cvt_pk_bf16(o1[2], o1[3]);
                    *(u32x4*)(xb + off + bj * HALF) = w;
                    ss += ((o0[0] * o0[0] + o0[1] * o0[1]) + (o0[2] * o0[2] + o0[3] * o0[3])) + ((o1[0] * o1[0] + o1[1] * o1[1]) + (o1[2] * o1[2] + o1[3] * o1[3])); }
                ss += __shfl_xor(ss, 16); ss += __shfl_xor(ss, 32);
                if (fq == 0) P[r * 4 + wc] = ss;
                if (m & 1) asm volatile("" ::: "memory"); }
        asm volatile("s_waitcnt lgkmcnt(0)" ::: "memory"); __builtin_amdgcn_s_barrier(); asm volatile("" ::: "memory");
        const int t = wid * 64 + lane;
        if (t < 256) { const f32x4 p = *(const PG8_LAS f32x4*)(P + t * 4); rsq[(size_t)(u.pm * BM + t) * 4 + u.pn] = (p[0] + p[1]) + (p[2] + p[3]); }
    }
};
template <class Epi, class Sched, bool ALIGN_EPI = false, bool SP2 = false>
__device__ __forceinline__ void gemm_phase(PG8_LAS unsigned char* lds, const Gemm g, const Sched& S, const Epi& E) {
    const int tid = threadIdx.x, wid = __builtin_amdgcn_readfirstlane(tid >> 6), lane = tid & 63, wr = wid >> 2, wc = wid & 3, fr = lane & 15, fq = lane >> 4;
    const int K = g.K, nt = K / BK;
    unsigned voffA[2], voffB[2];
#pragma unroll
    for (int i = 0; i < 2; ++i) { int R, C; stage_rc(tid * 16 + i * 8192, R, C); const int Rb = Epi::PERM ? ((R & ~31) + perm32(R & 31)) : R;
        voffA[i] = (unsigned)(R * K + C) * 2u; voffB[i] = (unsigned)(Rb * K + C) * 2u; }
    const size_t kstep = (size_t)(BK * 2);
    const size_t hstep = (size_t)HALF * K * 2;
    const size_t tstep = 2 * hstep;
    const unsigned ldsw = (unsigned)wid * 1024u;
    const int aoff = lds_byte(wr * 64 + fr, fq * 8), boff = lds_byte(wc * 32 + fr, fq * 8);
#define PG8_SA(b, h) (((b) * 2 + (h)) * HTB)
#define PG8_SB(b, h) ((4 + (b) * 2 + (h)) * HTB)
#define PG8_STAGE(bufoff, gbase, voff) do { _Pragma("unroll") for (int _i = 0; _i < 2; ++_i) \
        __builtin_amdgcn_global_load_lds((const unsigned*)((const char*)(gbase) + (voff)[_i]), (PG8_LAS unsigned*)(lds + (bufoff) + ldsw + _i * 8192), 16, 0, 0); } while (0)
#define PG8_LDA(dst, b, h) do { _Pragma("unroll") for (int m = 0; m < 4; ++m) _Pragma("unroll") for (int k = 0; k < 2; ++k) dst[m][k] = *(const PG8_LAS bf16x8*)(lds + PG8_SA(b, h) + aoff + m * 2048 + k * 1024); } while (0)
#define PG8_LDB(dst, b, h) do { _Pragma("unroll") for (int n = 0; n < 2; ++n) _Pragma("unroll") for (int k = 0; k < 2; ++k) dst[n][k] = *(const PG8_LAS bf16x8*)(lds + PG8_SB(b, h) + boff + n * 2048 + k * 1024); } while (0)
#define PG8_MMA(ai, bj, At, Bt) do { __builtin_amdgcn_s_setprio(1); _Pragma("unroll") for (int m = 0; m < 4; ++m) _Pragma("unroll") for (int n = 0; n < 2; ++n) _Pragma("unroll") for (int k = 0; k < 2; ++k) \
        acc[ai][bj][m][n] = __builtin_amdgcn_mfma_f32_16x16x32_bf16(Bt[n][k], At[m][k], acc[ai][bj][m][n], 0, 0, 0); __builtin_amdgcn_s_setprio(0); } while (0)
#define PG8_WAIT_V(n) asm volatile("s_waitcnt vmcnt(" #n ")" ::: "memory")
#define PG8_WAIT_L(n) asm volatile("s_waitcnt lgkmcnt(" #n ")" ::: "memory")
#define PG8_BAR __builtin_amdgcn_s_barrier()
#define PG8_SCHED __builtin_amdgcn_sched_barrier(0)
    Unit cur, nxt; int ui = 0;
    if (!S.next(0, cur)) return;
    f32x4 acc[2][2][4][2];
#pragma unroll
    for (int a = 0; a < 2; ++a)
#pragma unroll
        for (int b = 0; b < 2; ++b)
#pragma unroll
            for (int m = 0; m < 4; ++m)
#pragma unroll
                for (int n = 0; n < 2; ++n) acc[a][b][m][n] = (f32x4){0.f, 0.f, 0.f, 0.f};
    bf16x8 At[4][2], B0[2][2], B1[2][2];
    const char* cA = (const char*)g.A + (size_t)cur.pm * tstep; const char* cB = (const char*)g.Bt + (size_t)cur.pn * tstep;
    S.a_ready(cur);
    if constexpr (SP2) {
        PG8_STAGE(PG8_SB(0, 0), cB, voffB); PG8_STAGE(PG8_SB(0, 1), cB + hstep, voffB); PG8_STAGE(PG8_SA(0, 0), cA, voffA); PG8_STAGE(PG8_SA(0, 1), cA + hstep, voffA);
        if (wr == 1) PG8_BAR;
        PG8_WAIT_V(2); PG8_BAR;
        PG8_STAGE(PG8_SB(1, 0), cB + kstep, voffB); PG8_STAGE(PG8_SA(1, 0), cA + kstep, voffA); PG8_STAGE(PG8_SB(1, 1), cB + hstep + kstep, voffB);
        PG8_WAIT_V(6); PG8_BAR;
    } else {
        PG8_STAGE(PG8_SB(0, 0), cB, voffB); PG8_STAGE(PG8_SA(0, 0), cA, voffA); PG8_STAGE(PG8_SB(0, 1), cB + hstep, voffB); PG8_STAGE(PG8_SA(0, 1), cA + hstep, voffA);
        if (wr == 1) PG8_BAR;
        PG8_WAIT_V(4); PG8_BAR;
        PG8_STAGE(PG8_SB(1, 0), cB + kstep, voffB); PG8_STAGE(PG8_SA(1, 0), cA + kstep, voffA); PG8_STAGE(PG8_SB(1, 1), cB + hstep + kstep, voffB);
        PG8_WAIT_V(6); PG8_BAR;
    }
    for (;;) {
        const bool has_next = S.next(ui + 1, nxt);
        const char* nA = has_next ? (const char*)g.A + (size_t)nxt.pm * tstep : cA; const char* nB = has_next ? (const char*)g.Bt + (size_t)nxt.pn * tstep : cB;
        for (int t = 0; t < nt; t += 2) {
            const bool last = (t == nt - 2);
            const char* a1 = cA + (size_t)(t + 1) * kstep;
            const char* a2 = last ? nA : cA + (size_t)(t + 2) * kstep; const char* b2 = last ? nB : cB + (size_t)(t + 2) * kstep;
            const char* a3 = a2 + kstep; const char* b3 = b2 + kstep;
            if (last && has_next) S.a_ready(nxt);
            if constexpr (SP2) {
            PG8_LDB(B0, 0, 0); PG8_LDB(B1, 0, 1); PG8_SCHED; PG8_LDA(At, 0, 0); PG8_STAGE(PG8_SA(1, 1), a1 + hstep, voffA);
            PG8_WAIT_V(8); PG8_WAIT_L(0); PG8_BAR; PG8_MMA(0, 0, At, B0); PG8_MMA(0, 1, At, B1); PG8_BAR; PG8_SCHED;
            PG8_LDA(At, 0, 1); PG8_STAGE(PG8_SB(0, 0), b2, voffB); PG8_STAGE(PG8_SB(0, 1), b2 + hstep, voffB); PG8_STAGE(PG8_SA(0, 0), a2, voffA);
            PG8_WAIT_V(8); PG8_WAIT_L(0); PG8_BAR; PG8_MMA(1, 0, At, B0); PG8_MMA(1, 1, At, B1); PG8_BAR; PG8_SCHED;
            PG8_LDB(B0, 1, 0); PG8_LDB(B1, 1, 1); PG8_SCHED; PG8_LDA(At, 1, 0); PG8_STAGE(PG8_SA(0, 1), a2 + hstep, voffA);
            PG8_WAIT_V(8); PG8_WAIT_L(0); PG8_BAR; PG8_MMA(0, 0, At, B0); PG8_MMA(0, 1, At, B1); PG8_BAR; PG8_SCHED;
            PG8_LDA(At, 1, 1); PG8_STAGE(PG8_SB(1, 0), b3, voffB); PG8_STAGE(PG8_SB(1, 1), b3 + hstep, voffB); PG8_STAGE(PG8_SA(1, 0), a3, voffA);
            PG8_WAIT_V(8); PG8_WAIT_L(0); PG8_BAR; PG8_MMA(1, 0, At, B0); PG8_MMA(1, 1, At, B1); PG8_BAR; PG8_SCHED;
            } else {
            PG8_LDB(B0, 0, 0); PG8_SCHED; PG8_LDA(At, 0, 0); PG8_STAGE(PG8_SA(1, 1), a1 + hstep, voffA);
            PG8_WAIT_L(8); PG8_BAR; PG8_WAIT_L(0); PG8_MMA(0, 0, At, B0); PG8_BAR; PG8_SCHED;
            PG8_LDB(B1, 0, 1); PG8_STAGE(PG8_SB(0, 0), b2, voffB);
            PG8_BAR; PG8_WAIT_L(0); PG8_MMA(0, 1, At, B1); PG8_BAR;
            PG8_LDA(At, 0, 1); PG8_STAGE(PG8_SA(0, 0), a2, voffA);
            PG8_BAR; PG8_WAIT_L(0); PG8_MMA(1, 0, At, B0); PG8_BAR; PG8_SCHED;
            PG8_STAGE(PG8_SB(0, 1), b2 + hstep, voffB);
            PG8_WAIT_V(6); PG8_BAR; PG8_MMA(1, 1, At, B1); PG8_BAR;
            PG8_LDB(B0, 1, 0); PG8_SCHED; PG8_LDA(At, 1, 0); PG8_STAGE(PG8_SA(0, 1), a2 + hstep, voffA);
            PG8_WAIT_L(8); PG8_BAR; PG8_WAIT_L(0); PG8_MMA(0, 0, At, B0); PG8_BAR; PG8_SCHED;
            PG8_LDB(B1, 1, 1); PG8_STAGE(PG8_SB(1, 0), b3, voffB);
            PG8_BAR; PG8_WAIT_L(0); PG8_MMA(0, 1, At, B1); PG8_BAR;
            PG8_LDA(At, 1, 1); PG8_STAGE(PG8_SA(1, 0), a3, voffA);
            PG8_BAR; PG8_WAIT_L(0); PG8_MMA(1, 0, At, B0); PG8_BAR; PG8_SCHED;
            PG8_STAGE(PG8_SB(1, 1), b3 + hstep, voffB);
            PG8_WAIT_V(6); PG8_BAR; PG8_MMA(1, 1, At, B1); PG8_BAR;
            }
        }
        if constexpr (ALIGN_EPI) { if (wr == 0) PG8_BAR; }
        if constexpr (!Epi::AFTER_DRAIN) { E(acc, cur, wr, wc, fr, fq); S.done(cur); }
        if (!has_next) break;
#pragma unroll
        for (int a = 0; a < 2; ++a)
#pragma unroll
            for (int b = 0; b < 2; ++b)
#pragma unroll
                for (int m = 0; m < 4; ++m)
#pragma unroll
                    for (int n = 0; n < 2; ++n) acc[a][b][m][n] = (f32x4){0.f, 0.f, 0.f, 0.f};
        cur = nxt; cA = nA; cB = nB; ++ui;
        if constexpr (ALIGN_EPI) { if (wr == 1) PG8_BAR; }
    }
    PG8_WAIT_V(0);
    if constexpr (!ALIGN_EPI) { if (wr == 0) PG8_BAR; }
    PG8_BAR;
    if constexpr (Epi::AFTER_DRAIN) { E.fused(acc, cur, wr, wc, fr, fq, lds, wid, lane); S.done(cur); }
#undef PG8_SA
#undef PG8_SB
#undef PG8_STAGE
#undef PG8_LDA
#undef PG8_LDB
#undef PG8_MMA
#undef PG8_WAIT_V
#undef PG8_WAIT_L
#undef PG8_BAR
#undef PG8_SCHED
}
}

constexpr int NWAVES = 8, NTHREADS = 512;
constexpr int BATCH = 2, T = 8192, D = 1024, M = BATCH * T;
constexpr int SGF = 6144, SGW = 3072, SGC = 384;
constexpr int KD = 512, VD = 1024, DK = 128, DV = 256, GIN = 3088, GIN_PAD = 3328;
constexpr int FH = 2816;
constexpr int NITEM = (M / 64) * 4;
constexpr float EPS = 1e-6f;
static_assert(M == pg8::EM, "rows");

constexpr size_t MiB = 1u << 20;
constexpr size_t WS_WAIN = 1 * MiB, WS_WAOUT = 13 * MiB, WS_WGU0 = 19 * MiB, WS_WGU1 = 30 * MiB, WS_WDN0 = 41 * MiB, WS_WDN1 = 46 * MiB + MiB / 2;
constexpr size_t WS_WBIN = 52 * MiB, WS_WBOUT = 58 * MiB + MiB / 2, WS_WM = 60 * MiB + MiB / 2;
constexpr size_t WS_RU = 61 * MiB, WS_RV = 157 * MiB;
constexpr size_t WS_RSQ = 253 * MiB, WS_GZ = 253 * MiB + MiB / 2, WS_DEC = 254 * MiB + MiB / 2, WS_END = 256 * MiB;
constexpr int LDS_BYTES = 147456, RING_BYTES = 131072;

#define GAS __attribute__((address_space(1)))
#define LAS __attribute__((address_space(3)))
typedef unsigned short bf16;
typedef unsigned v4u __attribute__((ext_vector_type(4)));
typedef unsigned v2u __attribute__((ext_vector_type(2)));
typedef float f32x4 __attribute__((ext_vector_type(4)));
typedef float f32x2 __attribute__((ext_vector_type(2)));
typedef short bf16x8 __attribute__((ext_vector_type(8)));
typedef short s16x4 __attribute__((ext_vector_type(4)));
#define LDS_WAIT() asm volatile("s_waitcnt lgkmcnt(0)" ::: "memory")
__device__ __forceinline__ unsigned f2bf(float f) { unsigned u = __builtin_bit_cast(unsigned, f); return (u + 0x7fffu + ((u >> 16) & 1u)) >> 16; }
__device__ __forceinline__ unsigned pk2(float lo, float hi) { return pg8::cvt_pk_bf16(lo, hi); }
__device__ __forceinline__ float bf_lo(unsigned w) { return __builtin_bit_cast(float, w << 16); }
__device__ __forceinline__ float bf_hi(unsigned w) { return __builtin_bit_cast(float, w & 0xffff0000u); }
__device__ __forceinline__ float bf1(bf16 h) { return __builtin_bit_cast(float, (unsigned)h << 16); }
__device__ __forceinline__ float wave_sum(float v) {
#pragma unroll
    for (int o = 1; o < 64; o <<= 1) v += __shfl_xor(v, o);
    return v;
}
#ifndef USE_TR
#define USE_TR 1
#endif
__device__ __forceinline__ bf16x8 tr_frag(LAS unsigned char* tile, int pitch, int k0, int n0, int lane) {
#if USE_TR
    const int g = lane >> 4, q = (lane & 15) >> 2, p = lane & 3;
    LAS unsigned char* a0 = tile + (k0 + 8 * g + q) * pitch + (n0 + 4 * p) * 2;
    const s16x4 lo = __builtin_amdgcn_ds_read_tr16_b64_v4i16((LAS s16x4*)a0);
    const s16x4 hi = __builtin_amdgcn_ds_read_tr16_b64_v4i16((LAS s16x4*)(a0 + 4 * pitch));
    return (bf16x8){lo[0], lo[1], lo[2], lo[3], hi[0], hi[1], hi[2], hi[3]};
#else
    bf16x8 r; const int g = lane >> 4;
#pragma unroll
    for (int j = 0; j < 8; ++j) r[j] = *(LAS short*)(tile + (k0 + 8 * g + j) * pitch + (n0 + (lane & 15)) * 2);
    return r;
#endif
}
#define MFMA16(a, b, c) __builtin_amdgcn_mfma_f32_16x16x32_bf16((a), (b), (c), 0, 0, 0)

__device__ __forceinline__ void p0_transpose_item(const float* W, int K, int N, bf16* WT, int drow0, const float* gain, LAS float* scr, int k0, int n0, int lane) {
    const int n = n0 + (lane & 31); float v[32];
#pragma unroll
    for (int i = 0; i < 32; ++i) { const int kk = 2 * i + (lane >> 5); v[i] = (n < N) ? W[(size_t)(k0 + kk) * N + n] : 0.f; }
    if (gain) {
#pragma unroll
        for (int i = 0; i < 32; ++i) v[i] *= gain[k0 + 2 * i + (lane >> 5)]; }
#pragma unroll
    for (int i = 0; i < 32; ++i) scr[(2 * i + (lane >> 5)) * 33 + (lane & 31)] = v[i];
    LDS_WAIT(); asm volatile("" ::: "memory");
    const int c = lane & 7;
#pragma unroll
    for (int j = 0; j < 4; ++j) { const int nn = (lane >> 3) + 8 * j; const LAS float* s = scr + (8 * c) * 33 + nn;
        v4u o; o.x = pk2(s[0 * 33], s[1 * 33]); o.y = pk2(s[2 * 33], s[3 * 33]); o.z = pk2(s[4 * 33], s[5 * 33]); o.w = pk2(s[6 * 33], s[7 * 33]);
        *(GAS v4u*)(WT + (size_t)(drow0 + nn) * K + k0 + 8 * c) = o; }
    LDS_WAIT(); asm volatile("" ::: "memory");
}

struct Args { const float* in[18]; float* out; unsigned char* ws; int ph_lo, ph_hi; };

__device__ __forceinline__ void p0_prologue(const Args& A, LAS unsigned char* lds, int gw, int NGW, int lane, int wave, int gtid, int NGT) {
    LAS float* scr = (LAS float*)(lds + wave * 16384);
    unsigned char* ws = A.ws;
    const float* mixn = A.in[1]; const float* ffnn = A.in[13];
    constexpr int I_AIN = 16 * 192, I_AOUT = 48 * 32, I_GU = 16 * 88, I_DN = 44 * 32, I_BIN = 16 * 97, I_BOUT = 16 * 32;
    constexpr int NITEMS = I_AIN + I_AOUT + 4 * I_GU + 2 * I_DN + I_BIN + I_BOUT;
    for (int it = gw; it < NITEMS; it += NGW) {
        int r = it;
        if (r < I_AIN) { const int kb = r / 192, nb = r % 192; p0_transpose_item(A.in[2], D, SGF, (bf16*)(ws + WS_WAIN), 32 * nb, mixn, scr, 64 * kb, 32 * nb, lane); continue; } r -= I_AIN;
        if (r < I_AOUT) { const int kb = r / 32, nb = r % 32; p0_transpose_item(A.in[7], SGW, D, (bf16*)(ws + WS_WAOUT), 32 * nb, nullptr, scr, 64 * kb, 32 * nb, lane); continue; } r -= I_AOUT;
        if (r < 4 * I_GU) { const int l = r / (2 * I_GU), r2 = r % (2 * I_GU), up = r2 / I_GU, r3 = r2 % I_GU, kb = r3 / 88, nb = r3 % 88, n0 = 32 * nb;
            const float* W = (up ? A.in[15] : A.in[14]) + (size_t)l * D * FH;
            p0_transpose_item(W, D, FH, (bf16*)(ws + (l ? WS_WGU1 : WS_WGU0)), 256 * (n0 >> 7) + (n0 & 127) + 128 * up, ffnn + l * D, scr, 64 * kb, n0, lane); continue; } r -= 4 * I_GU;
        if (r < 2 * I_DN) { const int l = r / I_DN, r2 = r % I_DN, kb = r2 / 32, nb = r2 % 32;
            p0_transpose_item(A.in[16] + (size_t)l * FH * D, FH, D, (bf16*)(ws + (l ? WS_WDN1 : WS_WDN0)), 32 * nb, nullptr, scr, 64 * kb, 32 * nb, lane); continue; } r -= 2 * I_DN;
        if (r < I_BIN) { const int kb = r / 97, nb = r % 97; p0_transpose_item(A.in[8], D, GIN, (bf16*)(ws + WS_WBIN), 32 * nb, mixn + D, scr, 64 * kb, 32 * nb, lane); continue; } r -= I_BIN;
        { const int kb = r / 32, nb = r % 32; p0_transpose_item(A.in[12], D, D, (bf16*)(ws + WS_WBOUT), 32 * nb, nullptr, scr, 64 * kb, 32 * nb, lane); }
    }
    { GAS v4u* z = (GAS v4u*)(ws + WS_WBIN + (size_t)3104 * D * 2); const int nz = (GIN_PAD - 3104) * D * 2 / 16;
      for (int i = gtid; i < nz; i += NGT) z[i] = (v4u){0u, 0u, 0u, 0u}; }
    { const float* wsrc = A.in[5]; bf16* wm = (bf16*)(ws + WS_WM);
      for (int i = gtid; i < 8 * 128 * 128 / 2; i += NGT) { const int e = 2 * i, t = (e >> 7) & 127, s = e & 127; const bool keep = (t >= 64) || (s < 64);
          const f32x2 v = *(const f32x2*)(wsrc + e); ((GAS unsigned*)wm)[i] = keep ? pk2(v.x, v.y) : 0u; } }
    { const float* x = A.in[0]; bf16* xb0 = (bf16*)A.out; float* rsq = (float*)(ws + WS_RSQ);
      for (int m0 = gw; m0 < M; m0 += 4 * NGW) { f32x4 v[4][4];
#pragma unroll
          for (int r = 0; r < 4; ++r) { const int m = m0 + r * NGW; if (m < M) { const GAS f32x4* xr = (const GAS f32x4*)(x + (size_t)m * D) + lane;
#pragma unroll
              for (int j = 0; j < 4; ++j) v[r][j] = xr[64 * j]; } }
#pragma unroll
          for (int r = 0; r < 4; ++r) { const int m = m0 + r * NGW; if (m < M) { float s = 0.f;
#pragma unroll
              for (int j = 0; j < 4; ++j) s += (v[r][j].x * v[r][j].x + v[r][j].y * v[r][j].y) + (v[r][j].z * v[r][j].z + v[r][j].w * v[r][j].w);
              s = wave_sum(s);
              GAS v2u* o8 = (GAS v2u*)(xb0 + (size_t)m * D) + lane;
#pragma unroll
              for (int j = 0; j < 4; ++j) o8[64 * j] = (v2u){pk2(v[r][j].x, v[r][j].y), pk2(v[r][j].z, v[r][j].w)};
              if (lane == 0) *(f32x4*)(rsq + (size_t)m * 4) = (f32x4){s, 0.f, 0.f, 0.f}; } } } }
}

__device__ __forceinline__ void sgu_phase(LAS unsigned char* lds, const bf16* Wm, const bf16* V, bf16* UY, const f32x2* statP, const float* ln_g, const float* ln_b, const float* b_s,
                                          int G, int bid, int tid, int lane, int wid) {
    constexpr int PA = 272;
    LAS unsigned char* As = lds; LAS unsigned char* Bs = lds + 34816;
    LAS f32x2* red = (LAS f32x2*)(lds + 69632); LAS f32x2* murs = (LAS f32x2*)(lds + 69632 + 4096);
    const int wr = wid >> 2, wc = wid & 3, fr = lane & 15, fq = lane >> 4;
    for (int item = bid; item < 256; item += G) {
        const int w = item >> 1, hh = item & 1, row0 = w * 128;
        { const int r = tid & 127, part = tid >> 7; float s1 = 0.f, s2 = 0.f;
#pragma unroll
          for (int j = 0; j < 12; ++j) { const f32x2 p = statP[(size_t)(part * 12 + j) * M + row0 + r]; s1 += p.x; s2 += p.y; }
          red[part * 128 + r] = (f32x2){s1, s2}; }
        __syncthreads();
        if (tid < 128) { const f32x2 a = red[tid], b = red[128 + tid], c = red[256 + tid], d = red[384 + tid];
            const float mean = ((a.x + b.x) + (c.x + d.x)) * (1.0f / 3072.0f), ex2 = ((a.y + b.y) + (c.y + d.y)) * (1.0f / 3072.0f);
            murs[tid] = (f32x2){mean, __builtin_amdgcn_rsqf(fmaxf(ex2 - mean * mean, 0.f) + EPS)}; }
        __syncthreads();
        const int ch = tid & 15, srow = tid >> 4;
        for (int gi = 0; gi < 4; ++gi) { const int g = hh * 4 + gi;
#pragma unroll
            for (int i = 0; i < 4; ++i) { const int id = tid + 512 * i, r = id >> 4, c = id & 15; *(LAS v4u*)(As + r * PA + c * 16) = *(const GAS v4u*)(Wm + (size_t)(g * 128 + r) * 128 + c * 8); }
            for (int cb = 0; cb < 3; ++cb) { const int c0 = g * SGC + cb * 128;
                const f32x4 lg0 = *(const f32x4*)(ln_g + c0 + 8 * ch), lg1 = *(const f32x4*)(ln_g + c0 + 8 * ch + 4), lb0 = *(const f32x4*)(ln_b + c0 + 8 * ch), lb1 = *(const f32x4*)(ln_b + c0 + 8 * ch + 4);
#pragma unroll
                for (int i = 0; i < 4; ++i) { const int s = srow + 32 * i; const v4u raw = *(const GAS v4u*)(V + (size_t)(row0 + s) * SGW + c0 + 8 * ch); const f32x2 ms = murs[s];
                    const f32x4 a = (f32x4){bf_lo(raw.x), bf_hi(raw.x), bf_lo(raw.y), bf_hi(raw.y)}, b = (f32x4){bf_lo(raw.z), bf_hi(raw.z), bf_lo(raw.w), bf_hi(raw.w)};
                    const f32x4 ya = (a - ms.x) * ms.y * lg0 + lb0, yb = (b - ms.x) * ms.y * lg1 + lb1;
                    *(LAS v4u*)(Bs + s * PA + ch * 16) = (v4u){pk2(ya[0], ya[1]), pk2(ya[2], ya[3]), pk2(yb[0], yb[1]), pk2(yb[2], yb[3])}; }
                __syncthreads();
                f32x4 acc[4][2];
#pragma unroll
                for (int m = 0; m < 4; ++m) { acc[m][0] = (f32x4){0.f, 0.f, 0.f, 0.f}; acc[m][1] = (f32x4){0.f, 0.f, 0.f, 0.f}; }
#pragma unroll
                for (int ks = 0; ks < 4; ++ks) { bf16x8 bfr[4];
#pragma unroll
                    for (int m = 0; m < 4; ++m) bfr[m] = *(const LAS bf16x8*)(As + (wr * 64 + m * 16 + fr) * PA + (ks * 32 + fq * 8) * 2);
#pragma unroll
                    for (int n = 0; n < 2; ++n) { const bf16x8 afr = tr_frag(Bs, PA, ks * 32, wc * 32 + n * 16, lane);
#pragma unroll
                        for (int m = 0; m < 4; ++m) acc[m][n] = MFMA16(afr, bfr[m], acc[m][n]); } }
#pragma unroll
                for (int m = 0; m < 4; ++m) { const int t = wr * 64 + m * 16 + fr; const float bs = b_s[g * 128 + t];
#pragma unroll
                    for (int n = 0; n < 2; ++n) { GAS v2u* p = (GAS v2u*)(UY + (size_t)(row0 + t) * SGW + c0 + wc * 32 + n * 16 + 4 * fq); const v2u uu = *p; const f32x4 sv = acc[m][n] + bs;
                        *p = (v2u){pk2(bf_lo(uu.x) * sv[0], bf_hi(uu.x) * sv[1]), pk2(bf_lo(uu.y) * sv[2], bf_hi(uu.y) * sv[3])}; } }
                __syncthreads();
            }
        }
    }
}

__device__ __forceinline__ float logsig16(float z) { return (fminf(z, 0.f) - __logf(1.0f + __expf(-fabsf(z)))) * (1.0f / 16.0f); }
#define GLA_G(lds, GZ, w_g2, b_g, r0, h, tid, Gv, Glast) do { \
    LAS float* gzs_ = (LAS float*)(lds); LAS float* tot_ = (LAS float*)((lds) + 4096); \
    if ((tid) < 256) *(LAS f32x4*)(gzs_ + 4 * (tid)) = *(const GAS f32x4*)((GZ) + (size_t)(r0) * 16 + 4 * (tid)); \
    const int kk_ = (tid) & 127, seg_ = (tid) >> 7; float w2_[16]; \
    _Pragma("unroll") for (int r_ = 0; r_ < 16; ++r_) w2_[r_] = (w_g2)[r_ * KD + (h) * DK + kk_]; \
    const float bg_ = (b_g)[(h) * DK + kk_]; \
    __syncthreads(); \
    float run_ = 0.f; \
    _Pragma("unroll") for (int tt_ = 0; tt_ < 16; ++tt_) { const LAS f32x4* gr_ = (const LAS f32x4*)(gzs_ + (seg_ * 16 + tt_) * 16); float z_ = bg_; \
        _Pragma("unroll") for (int q_ = 0; q_ < 4; ++q_) { const f32x4 g4_ = gr_[q_]; z_ += g4_[0] * w2_[4 * q_] + g4_[1] * w2_[4 * q_ + 1] + g4_[2] * w2_[4 * q_ + 2] + g4_[3] * w2_[4 * q_ + 3]; } \
        run_ += logsig16(z_); Gv[tt_] = run_; } \
    tot_[seg_ * 128 + kk_] = run_; \
    __syncthreads(); \
    { const float t0_ = tot_[kk_], t1_ = tot_[128 + kk_], t2_ = tot_[256 + kk_], t3_ = tot_[384 + kk_]; \
      const float pre_ = (seg_ > 0 ? t0_ : 0.f) + (seg_ > 1 ? t1_ : 0.f) + (seg_ > 2 ? t2_ : 0.f); \
      _Pragma("unroll") for (int tt_ = 0; tt_ < 16; ++tt_) Gv[tt_] += pre_; \
      Glast = ((t0_ + t1_) + t2_) + t3_; } \
} while (0)

constexpr int G_KT = 8192, G_QT = 8192 + 17408, G_VT = 43008, G_PM = 76800, G_RED = 86016;
constexpr int PK = 272, PV = 528, PP = 144;

__device__ __forceinline__ void gla_state_phase(LAS unsigned char* lds, const bf16* Kg, const bf16* Vg, const float* GZ, const float* w_g2, const float* b_g, bf16* dS, float* dec,
                                                int G, int bid, int tid, int lane, int wid) {
    const int fr = lane & 15, fq = lane >> 4;
    for (int item = bid; item < NITEM; item += G) {
        const int h = item & 3, r0 = (item >> 2) * 64;
        float Gv[16], Glast;
        GLA_G(lds, GZ, w_g2, b_g, r0, h, tid, Gv, Glast);
        const int kk = tid & 127, seg = tid >> 7;
#pragma unroll
        for (int tt = 0; tt < 16; ++tt) { const int t = seg * 16 + tt; const float kv = bf1(Kg[(size_t)(r0 + t) * KD + h * DK + kk]);
            *(LAS bf16*)(lds + G_KT + t * PK + kk * 2) = (bf16)f2bf(kv * __expf(Glast - Gv[tt])); }
#pragma unroll
        for (int i = 0; i < 4; ++i) { const int id = tid + 512 * i, t = id >> 5, c = id & 31; *(LAS v4u*)(lds + G_VT + t * PV + c * 16) = *(const GAS v4u*)(Vg + (size_t)(r0 + t) * VD + h * DV + c * 8); }
        if (seg == 0) dec[(size_t)item * DK + kk] = __expf(Glast);
        __syncthreads();
        f32x4 acc[2][8];
#pragma unroll
        for (int d = 0; d < 2; ++d)
#pragma unroll
            for (int kt = 0; kt < 8; ++kt) acc[d][kt] = (f32x4){0.f, 0.f, 0.f, 0.f};
#pragma unroll
        for (int ks = 0; ks < 2; ++ks) { bf16x8 bfr[2];
#pragma unroll
            for (int d = 0; d < 2; ++d) bfr[d] = tr_frag(lds + G_VT, PV, ks * 32, 16 * (2 * wid + d), lane);
#pragma unroll
            for (int kt = 0; kt < 8; ++kt) { const bf16x8 afr = tr_frag(lds + G_KT, PK, ks * 32, 16 * kt, lane);
#pragma unroll
                for (int d = 0; d < 2; ++d) acc[d][kt] = MFMA16(afr, bfr[d], acc[d][kt]); } }
#pragma unroll
        for (int d = 0; d < 2; ++d) { bf16* rowp = dS + (size_t)item * (DV * DK) + (size_t)(16 * (2 * wid + d) + fr) * DK + 4 * fq;
#pragma unroll
            for (int kt = 0; kt < 8; ++kt) *(GAS v2u*)(rowp + 16 * kt) = (v2u){pk2(acc[d][kt][0], acc[d][kt][1]), pk2(acc[d][kt][2], acc[d][kt][3])}; }
        __syncthreads();
    }
}

__device__ __forceinline__ void gla_scan_phase(bf16* dS, const float* dec, int gtid, int NGT) {
    for (int e = gtid; e < 8 * DV * DK / 2; e += NGT) {
        const int bh = e >> 14, rem = e & 16383, b = bh >> 2, h = bh & 3;
        GAS unsigned* p = (GAS unsigned*)(dS + ((size_t)(b * 128) * 4 + h) * (DV * DK)) + rem;
        const GAS f32x2* dp = (const GAS f32x2*)(dec + ((size_t)(b * 128) * 4 + h) * DK) + (rem & 63);
        float s0 = 0.f, s1 = 0.f;
        for (int n0 = 0; n0 < 128; n0 += 8) { unsigned d[8]; f32x2 dc[8];
#pragma unroll
            for (int j = 0; j < 8; ++j) { d[j] = p[(size_t)(n0 + j) * (2 * DV * DK)]; dc[j] = dp[(size_t)(n0 + j) * (2 * DK)]; }
#pragma unroll
            for (int j = 0; j < 8; ++j) { p[(size_t)(n0 + j) * (2 * DV * DK)] = pk2(s0, s1); s0 = s0 * dc[j].x + bf_lo(d[j]); s1 = s1 * dc[j].y + bf_hi(d[j]); } }
    }
}

__device__ __forceinline__ void gla_out_phase(LAS unsigned char* lds, const bf16* Qg, const bf16* Kg, const bf16* Vg, bf16* SROG, const float* GZ, const float* w_g2, const float* b_g, const float* gn_g,
                                              const bf16* Sprev, int G, int bid, int tid, int lane, int wid) {
    const int fr = lane & 15, fq = lane >> 4;
    LAS float* red = (LAS float*)(lds + G_RED);
    for (int item = bid; item < NITEM; item += G) {
        const int h = item & 3, r0 = (item >> 2) * 64;
        float Gv[16], Glast;
        GLA_G(lds, GZ, w_g2, b_g, r0, h, tid, Gv, Glast);
        const int kk = tid & 127, seg = tid >> 7;
#pragma unroll
        for (int tt = 0; tt < 16; ++tt) { const int t = seg * 16 + tt; const size_t go = (size_t)(r0 + t) * KD + h * DK + kk; const float qv = bf1(Qg[go]), kv = bf1(Kg[go]);
            *(LAS bf16*)(lds + G_QT + t * PK + kk * 2) = (bf16)f2bf(qv * __expf(Gv[tt])); *(LAS bf16*)(lds + G_KT + t * PK + kk * 2) = (bf16)f2bf(kv * __expf(-Gv[tt])); }
#pragma unroll
        for (int i = 0; i < 4; ++i) { const int id = tid + 512 * i, t = id >> 5, c = id & 31; *(LAS v4u*)(lds + G_VT + t * PV + c * 16) = *(const GAS v4u*)(Vg + (size_t)(r0 + t) * VD + h * DV + c * 8); }
        __syncthreads();
        { const int it = wid >> 1;
#pragma unroll
          for (int jj = 0; jj < 2; ++jj) { const int jt = 2 * (wid & 1) + jj; f32x4 pa = (f32x4){0.f, 0.f, 0.f, 0.f};
#pragma unroll
              for (int ks = 0; ks < 4; ++ks) { const bf16x8 a = *(const LAS bf16x8*)(lds + G_KT + (16 * jt + fr) * PK + (32 * ks + 8 * fq) * 2), b = *(const LAS bf16x8*)(lds + G_QT + (16 * it + fr) * PK + (32 * ks + 8 * fq) * 2);
                  pa = MFMA16(a, b, pa); }
              const int i = 16 * it + fr, j0 = 16 * jt + 4 * fq;
              *(LAS v2u*)(lds + G_PM + i * PP + j0 * 2) = (v2u){pk2(j0 <= i ? pa[0] : 0.f, j0 + 1 <= i ? pa[1] : 0.f), pk2(j0 + 2 <= i ? pa[2] : 0.f, j0 + 3 <= i ? pa[3] : 0.f)}; } }
        __syncthreads();
        f32x4 acc[4][2];
#pragma unroll
        for (int it = 0; it < 4; ++it) { acc[it][0] = (f32x4){0.f, 0.f, 0.f, 0.f}; acc[it][1] = (f32x4){0.f, 0.f, 0.f, 0.f}; }
#pragma unroll
        for (int ks = 0; ks < 2; ++ks) { bf16x8 a[2];
#pragma unroll
            for (int d = 0; d < 2; ++d) a[d] = tr_frag(lds + G_VT, PV, ks * 32, 16 * (2 * wid + d), lane);
#pragma unroll
            for (int it = 0; it < 4; ++it) { const bf16x8 b = *(const LAS bf16x8*)(lds + G_PM + (16 * it + fr) * PP + (32 * ks + 8 * fq) * 2);
#pragma unroll
                for (int d = 0; d < 2; ++d) acc[it][d] = MFMA16(a[d], b, acc[it][d]); } }
#pragma unroll
        for (int ks = 0; ks < 4; ++ks) { bf16x8 a[2];
#pragma unroll
            for (int d = 0; d < 2; ++d) a[d] = *(const GAS bf16x8*)(Sprev + (size_t)item * (DV * DK) + (size_t)(16 * (2 * wid + d) + fr) * DK + 32 * ks + 8 * fq);
#pragma unroll
            for (int it = 0; it < 4; ++it) { const bf16x8 b = *(const LAS bf16x8*)(lds + G_QT + (16 * it + fr) * PK + (32 * ks + 8 * fq) * 2);
#pragma unroll
                for (int d = 0; d < 2; ++d) acc[it][d] = MFMA16(a[d], b, acc[it][d]); } }
#pragma unroll
        for (int it = 0; it < 4; ++it) { float ss = 0.f;
#pragma unroll
            for (int d = 0; d < 2; ++d) ss += (acc[it][d][0] * acc[it][d][0] + acc[it][d][1] * acc[it][d][1]) + (acc[it][d][2] * acc[it][d][2] + acc[it][d][3] * acc[it][d][3]);
            ss += __shfl_xor(ss, 16); ss += __shfl_xor(ss, 32);
            if (fq == 0) red[wid * 64 + 16 * it + fr] = ss; }
        __syncthreads();
#pragma unroll
        for (int it = 0; it < 4; ++it) { const int i = 16 * it + fr; float tot = 0.f;
#pragma unroll
            for (int w8 = 0; w8 < 8; ++w8) tot += red[w8 * 64 + i];
            const float rms = __builtin_amdgcn_rsqf(tot * (1.0f / 256.0f) + EPS);
#pragma unroll
            for (int d = 0; d < 2; ++d) { const int dv = 16 * (2 * wid + d) + 4 * fq; const f32x4 gn = *(const f32x4*)(gn_g + h * DV + dv);
                GAS v2u* p = (GAS v2u*)(SROG + (size_t)(r0 + i) * VD + h * DV + dv); const v2u sr = *p; const f32x4 o = acc[it][d] * rms * gn;
                *p = (v2u){pk2(o[0] * bf_lo(sr.x), o[1] * bf_hi(sr.x)), pk2(o[2] * bf_lo(sr.y), o[3] * bf_hi(sr.y))}; } }
        __syncthreads();
    }
}

#define XB_TMO      128
#define XB_XCNT(j)  (256  + 64 * (j))
#define XB_XSUB(j)  (1280 + 64 * (j))
#define XB_XGEN(j)  (2304 + 64 * (j))
#define XB_TOP      3328
#define XB_TOPGEN   3392
#define XCD_BAR_WORDS 3456
#define XB_SPIN_CAP (1u << 18)

__device__ __forceinline__ unsigned xb_ld(unsigned* p)              { return __hip_atomic_load(p, __ATOMIC_RELAXED, __HIP_MEMORY_SCOPE_AGENT); }
__device__ __forceinline__ unsigned xb_add(unsigned* p, unsigned v) { return __hip_atomic_fetch_add(p, v, __ATOMIC_RELAXED, __HIP_MEMORY_SCOPE_AGENT); }
__device__ __forceinline__ unsigned xb_xcc_id() { return (unsigned)__builtin_amdgcn_s_getreg((3 << 11) | 20) & 0xFu; }
#define XB_SPIN(cond, bar) do { unsigned _sp = 0; while (cond) { __builtin_amdgcn_s_sleep(1); \
    if ((++_sp & 255u) == 0u) { if (xb_ld(&(bar)[XB_TMO])) break; if (_sp > XB_SPIN_CAP) { atomicAdd(&(bar)[XB_TMO], 1u); break; } } } } while (0)

struct XcdBarrier {
    unsigned* bar; unsigned x;
    volatile LAS unsigned* st;
};

__device__ __forceinline__ XcdBarrier xcd_barrier_post(unsigned* bar, volatile LAS unsigned* st) {
    XcdBarrier b; b.bar = bar; b.x = xb_xcc_id(); b.st = st;
    if (threadIdx.x == 0) (void)xb_add(&bar[XB_XCNT(b.x)], 1u);
    return b;
}
__device__ __forceinline__ void xcd_barrier_complete(unsigned* bar, unsigned x, unsigned& nloc, unsigned& nx) {
    const unsigned G = gridDim.x * gridDim.y * gridDim.z;
    unsigned sum, cnt, mine, sp = 0u;
    for (;;) {
        sum = 0u; cnt = 0u; mine = 0u;
#pragma unroll
        for (unsigned j = 0; j < 16; ++j) { const unsigned c = xb_ld(&bar[XB_XCNT(j)]); sum += c; cnt += (c > 0u) ? 1u : 0u; mine = (j == x) ? c : mine; }
        if (sum == G) break;
        __builtin_amdgcn_s_sleep(1);
        if ((++sp & 255u) == 0u) { if (xb_ld(&bar[XB_TMO])) break; if (sp > XB_SPIN_CAP) { atomicAdd(&bar[XB_TMO], 1u); break; } }
    }
    nloc = mine > 0u ? mine : 1u; nx = cnt > 0u ? cnt : 1u;
}

__device__ __forceinline__ void xcd_barrier(const XcdBarrier& b) {
    asm volatile("s_waitcnt vmcnt(0)" ::: "memory");
    __syncthreads();
    if (threadIdx.x == 0) {
        unsigned* bar = b.bar;
        __builtin_amdgcn_s_waitcnt(0);
        unsigned nloc = b.st[0], nx = b.st[1];
        if (nloc == 0u) { xcd_barrier_complete(bar, b.x, nloc, nx); b.st[0] = nloc; b.st[1] = nx; }
        const unsigned old = xb_add(&bar[XB_XSUB(b.x)], 1u);
        const unsigned gen = old / nloc;
        if (old + 1u == (gen + 1u) * nloc) {
            __builtin_amdgcn_fence(__ATOMIC_RELEASE, "agent");
            asm volatile("s_waitcnt vmcnt(0)" ::: "memory");
            const unsigned og = xb_add(&bar[XB_TOP], 1u);
            const unsigned tg = og / nx;
            if (og + 1u == (tg + 1u) * nx) xb_add(&bar[XB_TOPGEN], 1u);
            else XB_SPIN(xb_ld(&bar[XB_TOPGEN]) == tg, bar);
            __builtin_amdgcn_fence(__ATOMIC_ACQUIRE, "agent");
            xb_add(&bar[XB_XGEN(b.x)], 1u);
            asm volatile("s_waitcnt vmcnt(0)" ::: "memory");
        } else {
            XB_SPIN(xb_ld(&bar[XB_XGEN(b.x)]) == gen, bar);
            __builtin_amdgcn_fence(__ATOMIC_ACQUIRE, "agent");
            asm volatile("s_waitcnt vmcnt(0)" ::: "memory");
        }
    }
    __syncthreads();
}

constexpr int NPHASE = 14;
__global__ void __launch_bounds__(NTHREADS, 2) mk_fwd(Args args) {
    extern __shared__ __attribute__((aligned(16))) unsigned char lds_raw[];
    LAS unsigned char* lds = (LAS unsigned char*)lds_raw;
    cg::grid_group grid = cg::this_grid();
    const int tid = threadIdx.x, lane = tid & 63, wave = __builtin_amdgcn_readfirstlane(tid >> 6);
    const int G = gridDim.x, bid = blockIdx.x;
    const int vcu = (G % 8 == 0) ? (bid % 8) * (G / 8) + bid / 8 : bid;
    const int gw = vcu * NWAVES + wave, NGW = G * NWAVES, gtid = vcu * NTHREADS + tid, NGT = G * NTHREADS;
    unsigned char* ws = args.ws;
    const int lo = args.ph_lo, hi = args.ph_hi;
#define IN(k) (lo <= (k) && (k) < hi)
    if (tid < 64) ((LAS unsigned*)(lds + RING_BYTES))[tid] = 0u;
    __syncthreads();
    XcdBarrier bar; bar.bar = (unsigned*)ws; bar.x = 0; bar.st = nullptr;
    if (hi - lo > 1) bar = xcd_barrier_post((unsigned*)ws, (volatile LAS unsigned*)(lds + RING_BYTES) + 8);
#define SEAM(k) do { if (IN(k) && IN((k) + 1)) { if ((k) == 0) grid.sync(); else xcd_barrier(bar); } } while (0)
    float* X = args.out;
    float* rsq = (float*)(ws + WS_RSQ);
    bf16* XB = (bf16*)(ws + WS_RV);

    if (IN(0)) { p0_prologue(args, lds, gw, NGW, lane, wave, gtid, NGT); } SEAM(0);
    if (IN(1)) {
        pg8::Gemm g{(const bf16*)args.out, (const bf16*)(ws + WS_WAIN), M, SGF, D}; pg8::StaticOrder S; S.init(M, SGF, G, bid);
        pg8::EpiSguIn E{(bf16*)(ws + WS_RU), (bf16*)(ws + WS_RV), rsq, (pg8::f32x2*)((unsigned char*)args.out + 32 * MiB)};
        pg8::gemm_phase<pg8::EpiSguIn, pg8::StaticOrder, true, true>(lds, g, S, E);
    } SEAM(1);
    if (IN(2)) { sgu_phase(lds, (const bf16*)(ws + WS_WM), (const bf16*)(ws + WS_RV), (bf16*)(ws + WS_RU), (const f32x2*)((unsigned char*)args.out + 32 * MiB), args.in[3], args.in[4], args.in[6], G, vcu, tid, lane, wave); } SEAM(2);
    if (IN(3)) {
        pg8::Gemm g{(const bf16*)(ws + WS_RU), (const bf16*)(ws + WS_WAOUT), M, D, SGW}; pg8::StaticOrder S; S.init(M, D, G, bid);
        pg8::EpiResid<true> E{args.in[0], XB, rsq};
        pg8::gemm_phase<pg8::EpiResid<true>, pg8::StaticOrder, false, true>(lds, g, S, E);
    } SEAM(3);
    if (IN(4)) {
        pg8::Gemm g{XB, (const bf16*)(ws + WS_WGU0), M, 2 * FH, D}; pg8::StaticOrder S; S.init(M, 2 * FH, G, bid);
        pg8::EpiSwiGLU E{(bf16*)(ws + WS_RU), FH, rsq};
        pg8::gemm_phase<pg8::EpiSwiGLU, pg8::StaticOrder, true, true>(lds, g, S, E);
    } SEAM(4);
    if (IN(5)) {
        pg8::Gemm g{(const bf16*)(ws + WS_RU), (const bf16*)(ws + WS_WDN0), M, D, FH}; pg8::StaticOrder S; S.init(M, D, G, bid);
        pg8::EpiResid<false> E{XB, XB, rsq};
        pg8::gemm_phase<pg8::EpiResid<false>, pg8::StaticOrder, false, true>(lds, g, S, E);
    } SEAM(5);
    bf16* Qg = (bf16*)(ws + WS_RU); bf16* Kg = (bf16*)(ws + WS_RU + 16 * MiB); bf16* Vg = (bf16*)(ws + WS_RU + 32 * MiB); bf16* SR = (bf16*)(ws + WS_RU + 64 * MiB);
    bf16* dS = (bf16*)(ws + WS_RV + 32 * MiB); float* GZ = (float*)(ws + WS_GZ); float* dec = (float*)(ws + WS_DEC);
    if (IN(6)) {
        pg8::Gemm g{XB, (const bf16*)(ws + WS_WBIN), M, GIN_PAD, D}; pg8::StaticOrder S; S.init(M, GIN_PAD, G, bid);
        pg8::EpiGlaIn E{Qg, Kg, Vg, SR, GZ, rsq};
        pg8::gemm_phase<pg8::EpiGlaIn, pg8::StaticOrder, true, true>(lds, g, S, E);
    } SEAM(6);
    if (IN(7)) { gla_state_phase(lds, Kg, Vg, GZ, args.in[9], args.in[10], dS, dec, G, vcu, tid, lane, wave); } SEAM(7);
    if (IN(8)) { gla_scan_phase(dS, dec, gtid, NGT); } SEAM(8);
    if (IN(9)) { gla_out_phase(lds, Qg, Kg, Vg, SR, GZ, args.in[9], args.in[10], args.in[11], dS, G, vcu, tid, lane, wave); } SEAM(9);
    if (IN(10)) {
        pg8::Gemm g{SR, (const bf16*)(ws + WS_WBOUT), M, D, VD}; pg8::StaticOrder S; S.init(M, D, G, bid);
        pg8::EpiResid<false> E{XB, XB, rsq};
        pg8::gemm_phase<pg8::EpiResid<false>, pg8::StaticOrder, false, true>(lds, g, S, E);
    } SEAM(10);
    if (IN(11)) {
        pg8::Gemm g{XB, (const bf16*)(ws + WS_WGU1), M, 2 * FH, D}; pg8::StaticOrder S; S.init(M, 2 * FH, G, bid);
        pg8::EpiSwiGLU E{(bf16*)(ws + WS_RU), FH, rsq};
        pg8::gemm_phase<pg8::EpiSwiGLU, pg8::StaticOrder, true, true>(lds, g, S, E);
    } SEAM(11);
    if (IN(12)) {
        pg8::Gemm g{(const bf16*)(ws + WS_RU), (const bf16*)(ws + WS_WDN1), M, D, FH}; pg8::StaticOrder S; S.init(M, D, G, bid);
        pg8::EpiResid<false> E{XB, XB, rsq};
        pg8::gemm_phase<pg8::EpiResid<false>, pg8::StaticOrder, false, true>(lds, g, S, E);
    } SEAM(12);
    if (IN(13)) {
        const float* fg = args.in[17];
        f32x4 gv[4];
#pragma unroll
        for (int j = 0; j < 4; ++j) gv[j] = *(const f32x4*)(fg + 8 * lane + 512 * (j >> 1) + 4 * (j & 1));
        for (int m0 = gw; m0 < M; m0 += 8 * NGW) { v4u w[8][2]; float rs[8];
#pragma unroll
            for (int r = 0; r < 8; ++r) { const int m = m0 + r * NGW; if (m < M) { const GAS v4u* xr = (const GAS v4u*)(XB + (size_t)m * D) + lane; w[r][0] = xr[0]; w[r][1] = xr[64]; rs[r] = pg8::row_rs(rsq, m); } }
#pragma unroll
            for (int r = 0; r < 8; ++r) { const int m = m0 + r * NGW; if (m < M) { GAS f32x4* o = (GAS f32x4*)(X + (size_t)m * D) + 2 * lane;
#pragma unroll
                for (int hh = 0; hh < 2; ++hh) { const v4u q = w[r][hh];
                    o[128 * hh] = (f32x4){bf_lo(q.x), bf_hi(q.x), bf_lo(q.y), bf_hi(q.y)} * rs[r] * gv[2 * hh];
                    o[128 * hh + 1] = (f32x4){bf_lo(q.z), bf_hi(q.z), bf_lo(q.w), bf_hi(q.w)} * rs[r] * gv[2 * hh + 1]; } } } }
    }
#undef IN
#undef SEAM
}


__global__ void digest_k(const unsigned short* a, size_t na, const float* f, size_t nf, float* out) {
    const size_t n = (size_t)16384 * 1024;
    for (size_t i = (size_t)blockIdx.x * blockDim.x + threadIdx.x; i < n; i += (size_t)gridDim.x * blockDim.x) {
        float v = 0.f;
        for (size_t k = 0; k * n + i < na; ++k) v += __builtin_bit_cast(float, (unsigned)a[k * n + i] << 16);
        if (nf) v += f[i % nf];
        if (!(fabsf(v) < 1e30f)) v = 1e30f;
        out[i] = v;
    }
}
#ifndef MK_N_LAUNCHES
#define MK_N_LAUNCHES 1
#define DBG_NPH 14
#endif
extern "C" void kernel_launch(void* const* d_in, const int* in_sizes, int n_in, void* d_out, int out_size, void* d_ws, size_t ws_size, hipStream_t stream) {
    static int grid = 0;
    if (grid == 0) {
        if (n_in != 18 || in_sizes[0] != M * D || out_size != M * D || ws_size < WS_END) { fprintf(stderr, "kernel_launch: unexpected shapes (n_in %d, in0 %d, out %d, ws %zu); nothing launched\n", n_in, n_in > 0 ? in_sizes[0] : -1, out_size, ws_size); grid = -1; return; }
        int dev = 0, cus = 0, per_cu = 0;
        if (hipGetDevice(&dev) != hipSuccess || hipDeviceGetAttribute(&cus, hipDeviceAttributeMultiprocessorCount, dev) != hipSuccess) { grid = -1; return; }
        if (hipFuncSetAttribute((const void*)mk_fwd, hipFuncAttributeMaxDynamicSharedMemorySize, LDS_BYTES) != hipSuccess) { fprintf(stderr, "kernel_launch: hipFuncSetAttribute failed\n"); grid = -1; return; }
        if (hipOccupancyMaxActiveBlocksPerMultiprocessor(&per_cu, (const void*)mk_fwd, NTHREADS, LDS_BYTES) != hipSuccess || per_cu < 1) { fprintf(stderr, "kernel_launch: occupancy query gives %d blocks per CU\n", per_cu); (void)hipGetLastError(); grid = -1; return; }
        grid = cus;
        if (grid != 256) { fprintf(stderr, "kernel_launch: built for a 256-CU device (got %d)\n", cus); grid = -1; return; }
    }
    if (grid < 0) return;
    Args a{};
    for (int i = 0; i < 18; ++i) a.in[i] = (const float*)d_in[i];
    a.out = (float*)d_out; a.ws = (unsigned char*)d_ws;
#if MK_N_LAUNCHES == 1
    if (hipMemsetAsync(d_ws, 0, 16384, stream) != hipSuccess) { fprintf(stderr, "kernel_launch: memset of the barrier words failed\n"); return; }
    a.ph_lo = 0; a.ph_hi = NPHASE;
    void* kargs[] = {&a};
    hipError_t e = hipLaunchCooperativeKernel((const void*)mk_fwd, dim3(grid), dim3(NTHREADS), kargs, LDS_BYTES, stream);
    if (e != hipSuccess) fprintf(stderr, "kernel_launch: cooperative launch failed: %s\n", hipGetErrorString(e));
#else
    for (int p = 0; p < DBG_NPH; ++p) { a.ph_lo = p; a.ph_hi = p + 1; hipLaunchKernelGGL(mk_fwd, dim3(grid), dim3(NTHREADS), LDS_BYTES, stream, a); }
#ifdef DBG_DIG
    { unsigned char* w = (unsigned char*)d_ws; const size_t n16 = (size_t)16384 * 1024;
      const unsigned short* da = nullptr; size_t na = 0; const float* df = nullptr; size_t nf = 0;
      if (DBG_DIG == 6) { da = (const unsigned short*)(w + WS_RU); na = 3 * n16; df = (const float*)(w + WS_GZ); nf = 262144; }
      if (DBG_DIG == 7 || DBG_DIG == 8) { da = (const unsigned short*)(w + WS_RV + 32 * MiB); na = 2 * n16; df = (const float*)(w + WS_DEC); nf = 131072; }
      if (DBG_DIG == 9) { da = (const unsigned short*)(w + WS_RU + 64 * MiB); na = n16; }
      hipLaunchKernelGGL(digest_k, dim3(2048), dim3(256), 0, stream, da, na, df, nf, (float*)d_out); }
#endif
#endif
}
```

```cpp
#include <hip/hip_runtime.h>
#include <hip/hip_cooperative_groups.h>
#include <cstdio>
#include <cstdint>
namespace cg = cooperative_groups;
namespace pg8 {
#define PG8_LAS __attribute__((address_space(3)))
typedef unsigned short bf16_t;
typedef short bf16x8 __attribute__((ext_vector_type(8)));
typedef float f32x4 __attribute__((ext_vector_type(4)));
typedef unsigned u32x4 __attribute__((ext_vector_type(4)));
constexpr int BM = 256, BK = 64, HALF = 128, HTB = HALF * BK * 2  , STAGE_BYTES = 8 * HTB, NXCD = 8, WGM = 8;

__host__ __device__ __forceinline__ int lds_byte(int r, int c) { const int st = (r >> 4) * 2 + (c >> 5), rr = r & 15, cc = c & 31, ob = rr * 64 + cc * 2; return st * 1024 + (ob ^ (((ob >> 9) & 1) << 5)); }
__host__ __device__ __forceinline__ void stage_rc(int b, int& R, int& C) { const int st = b / 1024, sb = b % 1024, swz = sb ^ (((sb >> 9) & 1) << 5); R = (st >> 1) * 16 + swz / 64; C = (st & 1) * 32 + (swz % 64) / 2; }
__host__ __device__ __forceinline__ int perm32(int rho) { const int n = rho >> 4, i = rho & 15; return 8 * (i >> 2) + 4 * n + (i & 3); }

struct Unit { int pm, pn; };
struct Gemm { const bf16_t* A; const bf16_t* Bt; int M, N, K; };

struct StaticOrder {
    int nM, nN, nwg, G, c;
    __host__ __device__ void init(int M, int N, int G_, int c_) { nM = M / BM; nN = N / BM; nwg = nM * nN; G = G_; c = c_; }
    __host__ __device__ bool next(int i, Unit& u) const {
        const long L = (long)i * G + c; if (L >= nwg) return false;
        int wgid = (int)L; { const int q = nwg / NXCD, r = nwg % NXCD, xcd = wgid % NXCD, off = wgid / NXCD; wgid = (xcd < r ? xcd * (q + 1) : r * (q + 1) + (xcd - r) * q) + off; }
        const int nig = WGM * nN, gid = wgid / nig, fm = gid * WGM, gsz = (nM - fm) < WGM ? (nM - fm) : WGM;
        u.pm = fm + ((wgid % nig) % gsz); u.pn = (wgid % nig) / gsz; return true;
    }
    __device__ __forceinline__ void a_ready(const Unit&) const {}
    __device__ __forceinline__ void done(const Unit&) const {}
};

typedef float f32x2 __attribute__((ext_vector_type(2)));
typedef __bf16 bf16x2v __attribute__((ext_vector_type(2)));
__device__ __forceinline__ unsigned cvt_pk_bf16(float lo, float hi) { const bf16x2v r = __builtin_convertvector((f32x2){lo, hi}, bf16x2v); return __builtin_bit_cast(unsigned, r); }
__device__ __forceinline__ f32x2 gelu_pk(f32x2 v) {
    const f32x2 av = __builtin_elementwise_abs(v), d = av * 0.2316418882f + 1.0f;
    f32x2 t; t.x = __builtin_amdgcn_rcpf(d.x); t.y = __builtin_amdgcn_rcpf(d.y);
    f32x2 q = t * 0.5307027145f + (-0.7265760135f); q = q * t + 0.7107068705f; q = q * t + (-0.142248368f); q = q * t + 0.127414796f; q = q * t;
    const f32x2 s = (v * v) * (-0.72134752044f);
    f32x2 e; e.x = __builtin_amdgcn_exp2f(s.x); e.y = __builtin_amdgcn_exp2f(s.y);
    const f32x2 m = v * (q * e), r = v - m;
    f32x2 o; o.x = v.x < 0.f ? m.x : r.x; o.y = v.y < 0.f ? m.y : r.y; return o;
}

constexpr int EM = 16384;
constexpr float EEPS = 1e-6f;
__device__ __forceinline__ float row_rs(const float* rsq, int row) {
    const f32x4 p = *(const f32x4*)(rsq + (size_t)row * 4);
    return __builtin_amdgcn_rsqf(((p[0] + p[1]) + (p[2] + p[3])) * (1.0f / 1024.0f) + EEPS);
}
__device__ __forceinline__ float silu_f(float v) { return v * __builtin_amdgcn_rcpf(1.0f + __expf(-v)); }

struct EpiSguIn {
    static constexpr bool PERM = true, AFTER_DRAIN = false;
    bf16_t* U; bf16_t* V; const float* rsq; f32x2* statP;
    __device__ __forceinline__ void operator()(const f32x4 (&acc)[2][2][4][2], const Unit& u, int wr, int wc, int fr, int fq) const {
        const bool isv = u.pn >= 12;
        bf16_t* base = isv ? V : U; const int colt = (isv ? u.pn - 12 : u.pn) * BM + wc * 32 + 8 * fq;
        const int row0 = u.pm * BM + wr * 64 + fr;
#pragma unroll
        for (int ai = 0; ai < 2; ++ai)
#pragma unroll
            for (int m = 0; m < 4; ++m) { const int row = row0 + ai * HALF + m * 16; const float rs = row_rs(rsq, row);
                bf16_t* rowp = base + (size_t)row * 3072 + colt; float s1 = 0.f, s2 = 0.f;
#pragma unroll
                for (int bj = 0; bj < 2; ++bj) { const f32x4 v0 = acc[ai][bj][m][0] * rs, v1 = acc[ai][bj][m][1] * rs;
                    const f32x2 a = gelu_pk((f32x2){v0[0], v0[1]}), b = gelu_pk((f32x2){v0[2], v0[3]}), c = gelu_pk((f32x2){v1[0], v1[1]}), d = gelu_pk((f32x2){v1[2], v1[3]});
                    s1 += ((a.x + a.y) + (b.x + b.y)) + ((c.x + c.y) + (d.x + d.y));
                    s2 += ((a.x * a.x + a.y * a.y) + (b.x * b.x + b.y * b.y)) + ((c.x * c.x + c.y * c.y) + (d.x * d.x + d.y * d.y));
                    u32x4 w; w.x = cvt_pk_bf16(a.x, a.y); w.y = cvt_pk_bf16(b.x, b.y); w.z = cvt_pk_bf16(c.x, c.y); w.w = cvt_pk_bf16(d.x, d.y);
                    *(u32x4*)(rowp + bj * HALF) = w; }
                if (isv) { s1 += __shfl_xor(s1, 16); s1 += __shfl_xor(s1, 32); s2 += __shfl_xor(s2, 16); s2 += __shfl_xor(s2, 32);
                    if (fq == 0) statP[(size_t)((u.pn - 12) * 4 + wc) * EM + row] = (f32x2){s1, s2}; } }
    }
};
struct EpiSwiGLU {
    static constexpr bool PERM = true, AFTER_DRAIN = false;
    bf16_t* Hd; int ldh; const float* rsq;
    __device__ __forceinline__ void operator()(const f32x4 (&acc)[2][2][4][2], const Unit& u, int wr, int wc, int fr, int fq) const {
        const int row0 = u.pm * BM + wr * 64 + fr, col0 = u.pn * HALF + wc * 32 + 8 * fq;
#pragma unroll
        for (int ai = 0; ai < 2; ++ai)
#pragma unroll
            for (int m = 0; m < 4; ++m) { const int row = row0 + ai * HALF + m * 16; const float rs = row_rs(rsq, row);
                const f32x4 g0 = acc[ai][0][m][0] * rs, g1 = acc[ai][0][m][1] * rs, u0 = acc[ai][1][m][0] * rs, u1 = acc[ai][1][m][1] * rs;
                u32x4 w; w.x = cvt_pk_bf16(silu_f(g0[0]) * u0[0], silu_f(g0[1]) * u0[1]); w.y = cvt_pk_bf16(silu_f(g0[2]) * u0[2], silu_f(g0[3]) * u0[3]);
                w.z = cvt_pk_bf16(silu_f(g1[0]) * u1[0], silu_f(g1[1]) * u1[1]); w.w = cvt_pk_bf16(silu_f(g1[2]) * u1[2], silu_f(g1[3]) * u1[3]);
                *(u32x4*)(Hd + (size_t)row * ldh + col0) = w; }
    }
};
struct EpiGlaIn {
    static constexpr bool PERM = true, AFTER_DRAIN = false;
    bf16_t* Q; bf16_t* Kk; bf16_t* Vv; bf16_t* SR; float* GZ; const float* rsq;
    __device__ __forceinline__ void operator()(const f32x4 (&acc)[2][2][4][2], const Unit& u, int wr, int wc, int fr, int fq) const {
        const int row0 = u.pm * BM + wr * 64 + fr, pn = u.pn;
        if (pn == 12) {
            if (wc == 0 && fq < 2) {
#pragma unroll
                for (int ai = 0; ai < 2; ++ai)
#pragma unroll
                    for (int m = 0; m < 4; ++m) { const int row = row0 + ai * HALF + m * 16; const float rs = row_rs(rsq, row);
                        float* p = GZ + (size_t)row * 16 + 8 * fq; *(f32x4*)p = acc[ai][0][m][0] * rs; *(f32x4*)(p + 4) = acc[ai][0][m][1] * rs; }
            }
            return;
        }
        bf16_t* base; int ld, colt; float sc = 1.f; const bool act = pn >= 8;
        if (pn < 2) { base = Q; ld = 512; colt = pn * BM; sc = 0.08838834764831845f; } else if (pn < 4) { base = Kk; ld = 512; colt = (pn - 2) * BM; }
        else if (pn < 8) { base = Vv; ld = 1024; colt = (pn - 4) * BM; } else { base = SR; ld = 1024; colt = (pn - 8) * BM; }
        colt += wc * 32 + 8 * fq;
#pragma unroll
        for (int ai = 0; ai < 2; ++ai)
#pragma unroll
            for (int m = 0; m < 4; ++m) { const int row = row0 + ai * HALF + m * 16; const float rs = row_rs(rsq, row) * sc;
                bf16_t* rowp = base + (size_t)row * ld + colt;
#pragma unroll
                for (int bj = 0; bj < 2; ++bj) { f32x4 v0 = acc[ai][bj][m][0] * rs, v1 = acc[ai][bj][m][1] * rs;
                    if (act) { v0 = (f32x4){silu_f(v0[0]), silu_f(v0[1]), silu_f(v0[2]), silu_f(v0[3])}; v1 = (f32x4){silu_f(v1[0]), silu_f(v1[1]), silu_f(v1[2]), silu_f(v1[3])}; }
                    u32x4 w; w.x = cvt_pk_bf16(v0[0], v0[1]); w.y = cvt_pk_bf16(v0[2], v0[3]); w.z = cvt_pk_bf16(v1[0], v1[1]); w.w = cvt_pk_bf16(v1[2], v1[3]);
                    *(u32x4*)(rowp + bj * HALF) = w; } }
    }
};
template <bool F32BASE> struct EpiResid {
    static constexpr bool PERM = true, AFTER_DRAIN = true;
    const void* base; bf16_t* xb; float* rsq;
    __device__ __forceinline__ void fused(f32x4 (&acc)[2][2][4][2], const Unit& u, int wr, int wc, int fr, int fq, PG8_LAS unsigned char* lds, int wid, int lane) const {
        PG8_LAS float* P = (PG8_LAS float*)lds;
        const int col0 = u.pn * BM + wc * 32 + 8 * fq;
#pragma unroll
        for (int ai = 0; ai < 2; ++ai)
#pragma unroll
            for (int m = 0; m < 4; ++m) { const int r = ai * HALF + wr * 64 + m * 16 + fr; const size_t off = (size_t)(u.pm * BM + r) * 1024 + col0; float ss = 0.f;
#pragma unroll
                for (int bj = 0; bj < 2; ++bj) { f32x4 b0, b1;
                    if (F32BASE) { const float* bp = (const float*)base + off + bj * HALF; b0 = *(const f32x4*)bp; b1 = *(const f32x4*)(bp + 4); }
                    else { const u32x4 w = *(const u32x4*)((const bf16_t*)base + off + bj * HALF);
                        b0 = (f32x4){__builtin_bit_cast(float, w.x << 16), __builtin_bit_cast(float, w.x & 0xffff0000u), __builtin_bit_cast(float, w.y << 16), __builtin_bit_cast(float, w.y & 0xffff0000u)};
                        b1 = (f32x4){__builtin_bit_cast(float, w.z << 16), __builtin_bit_cast(float, w.z & 0xffff0000u), __builtin_bit_cast(float, w.w << 16), __builtin_bit_cast(float, w.w & 0xffff0000u)}; }
                    const f32x4 o0 = b0 + acc[ai][bj][m][0], o1 = b1 + acc[ai][bj][m][1];
                    u32x4 w; w.x = cvt_pk_bf16(o0[0], o0[1]); w.y = cvt_pk_bf16(o0[2], o0[3]); w.z = cvt_pk_bf16(o1[0], o1[1]); w.w = cvt_pk_bf16(o1[2], o1[3]);
                    *(u32x4*)(xb + off + bj * HALF) = w;
                    ss += ((o0[0] * o0[0] + o0[1] * o0[1]) + (o0[2] * o0[2] + o0[3] * o0[3])) + ((o1[0] * o1[0] + o1[1] * o1[1]) + (o1[2] * o1[2] + o1[3] * o1[3])); }
                ss += __shfl_xor(ss, 16); ss += __shfl_xor(ss, 32);
                if (fq == 0) P[r * 4 + wc] = ss;
                if (m & 1) asm volatile("" ::: "memory"); }
        asm volatile("s_waitcnt lgkmcnt(0)" ::: "memory"); __builtin_amdgcn_s_barrier(); asm volatile("" ::: "memory");
        const int t = wid * 64 + lane;
        if (t < 256) { const f32x4 p = *(const PG8_LAS f32x4*)(P + t * 4); rsq[(size_t)(u.pm * BM + t) * 4 + u.pn] = (p[0] + p[1]) + (p[2] + p[3]); }
    }
};
template <class Epi, class Sched, bool ALIGN_EPI = false, bool SP2 = false>
__device__ __forceinline__ void gemm_phase(PG8_LAS unsigned char* lds, const Gemm g, const Sched& S, const Epi& E) {
    const int tid = threadIdx.x, wid = __builtin_amdgcn_readfirstlane(tid >> 6), lane = tid & 63, wr = wid >> 2, wc = wid & 3, fr = lane & 15, fq = lane >> 4;
    const int K = g.K, nt = K / BK;
    unsigned voffA[2], voffB[2];
#pragma unroll
    for (int i = 0; i < 2; ++i) { int R, C; stage_rc(tid * 16 + i * 8192, R, C); const int Rb = Epi::PERM ? ((R & ~31) + perm32(R & 31)) : R;
        voffA[i] = (unsigned)(R * K + C) * 2u; voffB[i] = (unsigned)(Rb * K + C) * 2u; }
    const size_t kstep = (size_t)(BK * 2);
    const size_t hstep = (size_t)HALF * K * 2;
    const size_t tstep = 2 * hstep;
    const unsigned ldsw = (unsigned)wid * 1024u;
    const int aoff = lds_byte(wr * 64 + fr, fq * 8), boff = lds_byte(wc * 32 + fr, fq * 8);
#define PG8_SA(b, h) (((b) * 2 + (h)) * HTB)
#define PG8_SB(b, h) ((4 + (b) * 2 + (h)) * HTB)
#define PG8_STAGE(bufoff, gbase, voff) do { _Pragma("unroll") for (int _i = 0; _i < 2; ++_i) \
        __builtin_amdgcn_global_load_lds((const unsigned*)((const char*)(gbase) + (voff)[_i]), (PG8_LAS unsigned*)(lds + (bufoff) + ldsw + _i * 8192), 16, 0, 0); } while (0)
#define PG8_LDA(dst, b, h) do { _Pragma("unroll") for (int m = 0; m < 4; ++m) _Pragma("unroll") for (int k = 0; k < 2; ++k) dst[m][k] = *(const PG8_LAS bf16x8*)(lds + PG8_SA(b, h) + aoff + m * 2048 + k * 1024); } while (0)
#define PG8_LDB(dst, b, h) do { _Pragma("unroll") for (int n = 0; n < 2; ++n) _Pragma("unroll") for (int k = 0; k < 2; ++k) dst[n][k] = *(const PG8_LAS bf16x8*)(lds + PG8_SB(b, h) + boff + n * 2048 + k * 1024); } while (0)
#define PG8_MMA(ai, bj, At, Bt) do { __builtin_amdgcn_s_setprio(1); _Pragma("unroll") for (int m = 0; m < 4; ++m) _Pragma("unroll") for (int n = 0; n < 2; ++n) _Pragma("unroll") for (int k = 0; k < 2; ++k) \
        acc[ai][bj][m][n] = __builtin_amdgcn_mfma_f32_16x16x32_bf16(Bt[n][k], At[m][k], acc[ai][bj][m][n], 0, 0, 0); __builtin_amdgcn_s_setprio(0); } while (0)
#define PG8_WAIT_V(n) asm volatile("s_waitcnt vmcnt(" #n ")" ::: "memory")
#define PG8_WAIT_L(n) asm volatile("s_waitcnt lgkmcnt(" #n ")" ::: "memory")
#define PG8_BAR __builtin_amdgcn_s_barrier()
#define PG8_SCHED __builtin_amdgcn_sched_barrier(0)
    Unit cur, nxt; int ui = 0;
    if (!S.next(0, cur)) return;
    f32x4 acc[2][2][4][2];
#pragma unroll
    for (int a = 0; a < 2; ++a)
#pragma unroll
        for (int b = 0; b < 2; ++b)
#pragma unroll
            for (int m = 0; m < 4; ++m)
#pragma unroll
                for (int n = 0; n < 2; ++n) acc[a][b][m][n] = (f32x4){0.f, 0.f, 0.f, 0.f};
    bf16x8 At[4][2], B0[2][2], B1[2][2];
    const char* cA = (const char*)g.A + (size_t)cur.pm * tstep; const char* cB = (const char*)g.Bt + (size_t)cur.pn * tstep;
    S.a_ready(cur);
    if constexpr (SP2) {
        PG8_STAGE(PG8_SB(0, 0), cB, voffB); PG8_STAGE(PG8_SB(0, 1), cB + hstep, voffB); PG8_STAGE(PG8_SA(0, 0), cA, voffA); PG8_STAGE(PG8_SA(0, 1), cA + hstep, voffA);
        if (wr == 1) PG8_BAR;
        PG8_WAIT_V(2); PG8_BAR;
        PG8_STAGE(PG8_SB(1, 0), cB + kstep, voffB); PG8_STAGE(PG8_SA(1, 0), cA + kstep, voffA); PG8_STAGE(PG8_SB(1, 1), cB + hstep + kstep, voffB);
        PG8_WAIT_V(6); PG8_BAR;
    } else {
        PG8_STAGE(PG8_SB(0, 0), cB, voffB); PG8_STAGE(PG8_SA(0, 0), cA, voffA); PG8_STAGE(PG8_SB(0, 1), cB + hstep, voffB); PG8_STAGE(PG8_SA(0, 1), cA + hstep, voffA);
        if (wr == 1) PG8_BAR;
        PG8_WAIT_V(4); PG8_BAR;
        PG8_STAGE(PG8_SB(1, 0), cB + kstep, voffB); PG8_STAGE(PG8_SA(1, 0), cA + kstep, voffA); PG8_STAGE(PG8_SB(1, 1), cB + hstep + kstep, voffB);
        PG8_WAIT_V(6); PG8_BAR;
    }
    for (;;) {
        const bool has_next = S.next(ui + 1, nxt);
        const char* nA = has_next ? (const char*)g.A + (size_t)nxt.pm * tstep : cA; const char* nB = has_next ? (const char*)g.Bt + (size_t)nxt.pn * tstep : cB;
        for (int t = 0; t < nt; t += 2) {
            const bool last = (t == nt - 2);
            const char* a1 = cA + (size_t)(t + 1) * kstep;
            const char* a2 = last ? nA : cA + (size_t)(t + 2) * kstep; const char* b2 = last ? nB : cB + (size_t)(t + 2) * kstep;
            const char* a3 = a2 + kstep; const char* b3 = b2 + kstep;
            if (last && has_next) S.a_ready(nxt);
            if constexpr (SP2) {
            PG8_LDB(B0, 0, 0); PG8_LDB(B1, 0, 1); PG8_SCHED; PG8_LDA(At, 0, 0); PG8_STAGE(PG8_SA(1, 1), a1 + hstep, voffA);
            PG8_WAIT_V(8); PG8_WAIT_L(0); PG8_BAR; PG8_MMA(0, 0, At, B0); PG8_MMA(0, 1, At, B1); PG8_BAR; PG8_SCHED;
            PG8_LDA(At, 0, 1); PG8_STAGE(PG8_SB(0, 0), b2, voffB); PG8_STAGE(PG8_SB(0, 1), b2 + hstep, voffB); PG8_STAGE(PG8_SA(0, 0), a2, voffA);
            PG8_WAIT_V(8); PG8_WAIT_L(0); PG8_BAR; PG8_MMA(1, 0, At, B0); PG8_MMA(1, 1, At, B1); PG8_BAR; PG8_SCHED;
            PG8_LDB(B0, 1, 0); PG8_LDB(B1, 1, 1); PG8_SCHED; PG8_LDA(At, 1, 0); PG8_STAGE(PG8_SA(0, 1), a2 + hstep, voffA);
            PG8_WAIT_V(8); PG8_WAIT_L(0); PG8_BAR; PG8_MMA(0, 0, At, B0); PG8_MMA(0, 1, At, B1); PG8_BAR; PG8_SCHED;
            PG8_LDA(At, 1, 1); PG8_STAGE(PG8_SB(1, 0), b3, voffB); PG8_STAGE(PG8_SB(1, 1), b3 + hstep, voffB); PG8_STAGE(PG8_SA(1, 0), a3, voffA);
            PG8_WAIT_V(8); PG8_WAIT_L(0); PG8_BAR; PG8_MMA(1, 0, At, B0); PG8_MMA(1, 1, At, B1); PG8_BAR; PG8_SCHED;
            } else {
            PG8_LDB(B0, 0, 0); PG8_SCHED; PG8_LDA(At, 0, 0); PG8_STAGE(PG8_SA(1, 1), a1 + hstep, voffA);
            PG8_WAIT_L(8); PG8_BAR; PG8_WAIT_L(0); PG8_MMA(0, 0, At, B0); PG8_BAR; PG8_SCHED;
            PG8_LDB(B1, 0, 1); PG8_STAGE(PG8_SB(0, 0), b2, voffB);
            PG8_BAR; PG8_WAIT_L(0); PG8_MMA(0, 1, At, B1); PG8_BAR;
            PG8_LDA(At, 0, 1); PG8_STAGE(PG8_SA(0, 0), a2, voffA);
            PG8_BAR; PG8_WAIT_L(0); PG8_MMA(1, 0, At, B0); PG8_BAR; PG8_SCHED;
            PG8_STAGE(PG8_SB(0, 1), b2 + hstep, voffB);
            PG8_WAIT_V(6); PG8_BAR; PG8_MMA(1, 1, At, B1); PG8_BAR;
            PG8_LDB(B0, 1, 0); PG8_SCHED; PG8_LDA(At, 1, 0); PG8_STAGE(PG8_SA(0, 1), a2 + hstep, voffA);
            PG8_WAIT_L(8); PG8_BAR; PG8_WAIT_L(0); PG8_MMA(0, 0, At, B0); PG8_BAR; PG8_SCHED;
            PG8_LDB(B1, 1, 1); PG8_STAGE(PG8_SB(1, 0), b3, voffB);
            PG8_BAR; PG8_WAIT_L(0); PG8_MMA(0, 1, At, B1); PG8_BAR;
            PG8_LDA(At, 1, 1); PG8_STAGE(PG8_SA(1, 0), a3, voffA);
            PG8_BAR; PG8_WAIT_L(0); PG8_MMA(1, 0, At, B0); PG8_BAR; PG8_SCHED;
            PG8_STAGE(PG8_SB(1, 1), b3 + hstep, voffB);
            PG8_WAIT_V(6); PG8_BAR; PG8_MMA(1, 1, At, B1); PG8_BAR;
            }
        }
        if constexpr (ALIGN_EPI) { if (wr == 0) PG8_BAR; }
        if constexpr (!Epi::AFTER_DRAIN) { E(acc, cur, wr, wc, fr, fq); S.done(cur); }
        if (!has_next) break;
#pragma unroll
        for (int a = 0; a < 2; ++a)
#pragma unroll
            for (int b = 0; b < 2; ++b)
#pragma unroll
                for (int m = 0; m < 4; ++m)
#pragma unroll
                    for (int n = 0; n < 2; ++n) acc[a][b][m][n] = (f32x4){0.f, 0.f, 0.f, 0.f};
        cur = nxt; cA = nA; cB = nB; ++ui;
        if constexpr (ALIGN_EPI) { if (wr == 1) PG8_BAR; }
    }
    PG8_WAIT_V(0);
    if constexpr (!ALIGN_EPI) { if (wr == 0) PG8_BAR; }
    PG8_BAR;
    if constexpr (Epi::AFTER_DRAIN) { E.fused(acc, cur, wr, wc, fr, fq, lds, wid, lane); S.done(cur); }
#undef PG8_SA
#undef PG8_SB
#undef PG8_STAGE
#undef PG8_LDA
#undef PG8_LDB
#undef PG8_MMA
#undef PG8_WAIT_V
#undef PG8_WAIT_L
#undef PG8_BAR
#undef PG8_SCHED
}
}

constexpr int NWAVES = 8, NTHREADS = 512;
constexpr int BATCH = 2, T = 8192, D = 1024, M = BATCH * T;
constexpr int SGF = 6144, SGW = 3072, SGC = 384;
constexpr int KD = 512, VD = 1024, DK = 128, DV = 256, GIN = 3088, GIN_PAD = 3328;
constexpr int FH = 2816;
constexpr int NITEM = (M / 64) * 4;
constexpr float EPS = 1e-6f;
static_assert(M == pg8::EM, "rows");

constexpr size_t MiB = 1u << 20;
constexpr size_t WS_WAIN = 1 * MiB, WS_WAOUT = 13 * MiB, WS_WGU0 = 19 * MiB, WS_WGU1 = 30 * MiB, WS_WDN0 = 41 * MiB, WS_WDN1 = 46 * MiB + MiB / 2;
constexpr size_t WS_WBIN = 52 * MiB, WS_WBOUT = 58 * MiB + MiB / 2, WS_WM = 60 * MiB + MiB / 2;
constexpr size_t WS_RU = 61 * MiB, WS_RV = 157 * MiB;
constexpr size_t WS_RSQ = 253 * MiB, WS_GZ = 253 * MiB + MiB / 2, WS_DEC = 254 * MiB + MiB / 2, WS_END = 256 * MiB;
constexpr int LDS_BYTES = 147456, RING_BYTES = 131072;

#define GAS __attribute__((address_space(1)))
#define LAS __attribute__((address_space(3)))
typedef unsigned short bf16;
typedef unsigned v4u __attribute__((ext_vector_type(4)));
typedef unsigned v2u __attribute__((ext_vector_type(2)));
typedef float f32x4 __attribute__((ext_vector_type(4)));
typedef float f32x2 __attribute__((ext_vector_type(2)));
typedef short bf16x8 __attribute__((ext_vector_type(8)));
typedef short s16x4 __attribute__((ext_vector_type(4)));
#define LDS_WAIT() asm volatile("s_waitcnt lgkmcnt(0)" ::: "memory")
__device__ __forceinline__ unsigned f2bf(float f) { unsigned u = __builtin_bit_cast(unsigned, f); return (u + 0x7fffu + ((u >> 16) & 1u)) >> 16; }
__device__ __forceinline__ unsigned pk2(float lo, float hi) { return pg8::cvt_pk_bf16(lo, hi); }
__device__ __forceinline__ float bf_lo(unsigned w) { return __builtin_bit_cast(float, w << 16); }
__device__ __forceinline__ float bf_hi(unsigned w) { return __builtin_bit_cast(float, w & 0xffff0000u); }
__device__ __forceinline__ float bf1(bf16 h) { return __builtin_bit_cast(float, (unsigned)h << 16); }
__device__ __forceinline__ float wave_sum(float v) {
#pragma unroll
    for (int o = 1; o < 64; o <<= 1) v += __shfl_xor(v, o);
    return v;
}
#ifndef USE_TR
#define USE_TR 1
#endif
__device__ __forceinline__ bf16x8 tr_frag(LAS unsigned char* tile, int pitch, int k0, int n0, int lane) {
#if USE_TR
    const int g = lane >> 4, q = (lane & 15) >> 2, p = lane & 3;
    LAS unsigned char* a0 = tile + (k0 + 8 * g + q) * pitch + (n0 + 4 * p) * 2;
    const s16x4 lo = __builtin_amdgcn_ds_read_tr16_b64_v4i16((LAS s16x4*)a0);
    const s16x4 hi = __builtin_amdgcn_ds_read_tr16_b64_v4i16((LAS s16x4*)(a0 + 4 * pitch));
    return (bf16x8){lo[0], lo[1], lo[2], lo[3], hi[0], hi[1], hi[2], hi[3]};
#else
    bf16x8 r; const int g = lane >> 4;
#pragma unroll
    for (int j = 0; j < 8; ++j) r[j] = *(LAS short*)(tile + (k0 + 8 * g + j) * pitch + (n0 + (lane & 15)) * 2);
    return r;
#endif
}
#define MFMA16(a, b, c) __builtin_amdgcn_mfma_f32_16x16x32_bf16((a), (b), (c), 0, 0, 0)

__device__ __forceinline__ void p0_transpose_item(const float* W, int K, int N, bf16* WT, int drow0, const float* gain, LAS float* scr, int k0, int n0, int lane) {
    const int n = n0 + (lane & 31); float v[32];
#pragma unroll
    for (int i = 0; i < 32; ++i) { const int kk = 2 * i + (lane >> 5); v[i] = (n < N) ? W[(size_t)(k0 + kk) * N + n] : 0.f; }
    if (gain) {
#pragma unroll
        for (int i = 0; i < 32; ++i) v[i] *= gain[k0 + 2 * i + (lane >> 5)]; }
#pragma unroll
    for (int i = 0; i < 32; ++i) scr[(2 * i + (lane >> 5)) * 33 + (lane & 31)] = v[i];
    LDS_WAIT(); asm volatile("" ::: "memory");
    const int c = lane & 7;
#pragma unroll
    for (int j = 0; j < 4; ++j) { const int nn = (lane >> 3) + 8 * j; const LAS float* s = scr + (8 * c) * 33 + nn;
        v4u o; o.x = pk2(s[0 * 33], s[1 * 33]); o.y = pk2(s[2 * 33], s[3 * 33]); o.z = pk2(s[4 * 33], s[5 * 33]); o.w = pk2(s[6 * 33], s[7 * 33]);
        *(GAS v4u*)(WT + (size_t)(drow0 + nn) * K + k0 + 8 * c) = o; }
    LDS_WAIT(); asm volatile("" ::: "memory");
}

struct Args { const float* in[18]; float* out; unsigned char* ws; int ph_lo, ph_hi; };

__device__ __forceinline__ void p0_prologue(const Args& A, LAS unsigned char* lds, int gw, int NGW, int lane, int wave, int gtid, int NGT) {
    LAS float* scr = (LAS float*)(lds + wave * 16384);
    unsigned char* ws = A.ws;
    const float* mixn = A.in[1]; const float* ffnn = A.in[13];
    constexpr int I_AIN = 16 * 192, I_AOUT = 48 * 32, I_GU = 16 * 88, I_DN = 44 * 32, I_BIN = 16 * 97, I_BOUT = 16 * 32;
    constexpr int NITEMS = I_AIN + I_AOUT + 4 * I_GU + 2 * I_DN + I_BIN + I_BOUT;
    for (int it = gw; it < NITEMS; it += NGW) {
        int r = it;
        if (r < I_AIN) { const int kb = r / 192, nb = r % 192; p0_transpose_item(A.in[2], D, SGF, (bf16*)(ws + WS_WAIN), 32 * nb, mixn, scr, 64 * kb, 32 * nb, lane); continue; } r -= I_AIN;
        if (r < I_AOUT) { const int kb = r / 32, nb = r % 32; p0_transpose_item(A.in[7], SGW, D, (bf16*)(ws + WS_WAOUT), 32 * nb, nullptr, scr, 64 * kb, 32 * nb, lane); continue; } r -= I_AOUT;
        if (r < 4 * I_GU) { const int l = r / (2 * I_GU), r2 = r % (2 * I_GU), up = r2 / I_GU, r3 = r2 % I_GU, kb = r3 / 88, nb = r3 % 88, n0 = 32 * nb;
            const float* W = (up ? A.in[15] : A.in[14]) + (size_t)l * D * FH;
            p0_transpose_item(W, D, FH, (bf16*)(ws + (l ? WS_WGU1 : WS_WGU0)), 256 * (n0 >> 7) + (n0 & 127) + 128 * up, ffnn + l * D, scr, 64 * kb, n0, lane); continue; } r -= 4 * I_GU;
        if (r < 2 * I_DN) { const int l = r / I_DN, r2 = r % I_DN, kb = r2 / 32, nb = r2 % 32;
            p0_transpose_item(A.in[16] + (size_t)l * FH * D, FH, D, (bf16*)(ws + (l ? WS_WDN1 : WS_WDN0)), 32 * nb, nullptr, scr, 64 * kb, 32 * nb, lane); continue; } r -= 2 * I_DN;
        if (r < I_BIN) { const int kb = r / 97, nb = r % 97; p0_transpose_item(A.in[8], D, GIN, (bf16*)(ws + WS_WBIN), 32 * nb, mixn + D, scr, 64 * kb, 32 * nb, lane); continue; } r -= I_BIN;
        { const int kb = r / 32, nb = r % 32; p0_transpose_item(A.in[12], D, D, (bf16*)(ws + WS_WBOUT), 32 * nb, nullptr, scr, 64 * kb, 32 * nb, lane); }
    }
    { GAS v4u* z = (GAS v4u*)(ws + WS_WBIN + (size_t)3104 * D * 2); const int nz = (GIN_PAD - 3104) * D * 2 / 16;
      for (int i = gtid; i < nz; i += NGT) z[i] = (v4u){0u, 0u, 0u, 0u}; }
    { const float* wsrc = A.in[5]; bf16* wm = (bf16*)(ws + WS_WM);
      for (int i = gtid; i < 8 * 128 * 128 / 2; i += NGT) { const int e = 2 * i, t = (e >> 7) & 127, s = e & 127; const bool keep = (t >= 64) || (s < 64);
          const f32x2 v = *(const f32x2*)(wsrc + e); ((GAS unsigned*)wm)[i] = keep ? pk2(v.x, v.y) : 0u; } }
    { const float* x = A.in[0]; bf16* xb0 = (bf16*)A.out; float* rsq = (float*)(ws + WS_RSQ);
      for (int m0 = gw; m0 < M; m0 += 4 * NGW) { f32x4 v[4][4];
#pragma unroll
          for (int r = 0; r < 4; ++r) { const int m = m0 + r * NGW; if (m < M) { const GAS f32x4* xr = (const GAS f32x4*)(x + (size_t)m * D) + lane;
#pragma unroll
              for (int j = 0; j < 4; ++j) v[r][j] = xr[64 * j]; } }
#pragma unroll
          for (int r = 0; r < 4; ++r) { const int m = m0 + r * NGW; if (m < M) { float s = 0.f;
#pragma unroll
              for (int j = 0; j < 4; ++j) s += (v[r][j].x * v[r][j].x + v[r][j].y * v[r][j].y) + (v[r][j].z * v[r][j].z + v[r][j].w * v[r][j].w);
              s = wave_sum(s);
              GAS v2u* o8 = (GAS v2u*)(xb0 + (size_t)m * D) + lane;
#pragma unroll
              for (int j = 0; j < 4; ++j) o8[64 * j] = (v2u){pk2(v[r][j].x, v[r][j].y), pk2(v[r][j].z, v[r][j].w)};
              if (lane == 0) *(f32x4*)(rsq + (size_t)m * 4) = (f32x4){s, 0.f, 0.f, 0.f}; } } } }
}

__device__ __forceinline__ void sgu_phase(LAS unsigned char* lds, const bf16* Wm, const bf16* V, bf16* UY, const f32x2* statP, const float* ln_g, const float* ln_b, const float* b_s,
                                          int G, int bid, int tid, int lane, int wid) {
    constexpr int PA = 272;
    LAS unsigned char* As = lds; LAS unsigned char* Bs = lds + 34816;
    LAS f32x2* red = (LAS f32x2*)(lds + 69632); LAS f32x2* murs = (LAS f32x2*)(lds + 69632 + 4096);
    const int wr = wid >> 2, wc = wid & 3, fr = lane & 15, fq = lane >> 4;
    for (int item = bid; item < 256; item += G) {
        const int w = item >> 1, hh = item & 1, row0 = w * 128;
        { const int r = tid & 127, part = tid >> 7; float s1 = 0.f, s2 = 0.f;
#pragma unroll
          for (int j = 0; j < 12; ++j) { const f32x2 p = statP[(size_t)(part * 12 + j) * M + row0 + r]; s1 += p.x; s2 += p.y; }
          red[part * 128 + r] = (f32x2){s1, s2}; }
        __syncthreads();
        if (tid < 128) { const f32x2 a = red[tid], b = red[128 + tid], c = red[256 + tid], d = red[384 + tid];
            const float mean = ((a.x + b.x) + (c.x + d.x)) * (1.0f / 3072.0f), ex2 = ((a.y + b.y) + (c.y + d.y)) * (1.0f / 3072.0f);
            murs[tid] = (f32x2){mean, __builtin_amdgcn_rsqf(fmaxf(ex2 - mean * mean, 0.f) + EPS)}; }
        __syncthreads();
        const int ch = tid & 15, srow = tid >> 4;
        for (int gi = 0; gi < 4; ++gi) { const int g = hh * 4 + gi;
#pragma unroll
            for (int i = 0; i < 4; ++i) { const int id = tid + 512 * i, r = id >> 4, c = id & 15; *(LAS v4u*)(As + r * PA + c * 16) = *(const GAS v4u*)(Wm + (size_t)(g * 128 + r) * 128 + c * 8); }
            for (int cb = 0; cb < 3; ++cb) { const int c0 = g * SGC + cb * 128;
                const f32x4 lg0 = *(const f32x4*)(ln_g + c0 + 8 * ch), lg1 = *(const f32x4*)(ln_g + c0 + 8 * ch + 4), lb0 = *(const f32x4*)(ln_b + c0 + 8 * ch), lb1 = *(const f32x4*)(ln_b + c0 + 8 * ch + 4);
#pragma unroll
                for (int i = 0; i < 4; ++i) { const int s = srow + 32 * i; const v4u raw = *(const GAS v4u*)(V + (size_t)(row0 + s) * SGW + c0 + 8 * ch); const f32x2 ms = murs[s];
                    const f32x4 a = (f32x4){bf_lo(raw.x), bf_hi(raw.x), bf_lo(raw.y), bf_hi(raw.y)}, b = (f32x4){bf_lo(raw.z), bf_hi(raw.z), bf_lo(raw.w), bf_hi(raw.w)};
                    const f32x4 ya = (a - ms.x) * ms.y * lg0 + lb0, yb = (b - ms.x) * ms.y * lg1 + lb1;
                    *(LAS v4u*)(Bs + s * PA + ch * 16) = (v4u){pk2(ya[0], ya[1]), pk2(ya[2], ya[3]), pk2(yb[0], yb[1]), pk2(yb[2], yb[3])}; }
                __syncthreads();
                f32x4 acc[4][2];
#pragma unroll
                for (int m = 0; m < 4; ++m) { acc[m][0] = (f32x4){0.f, 0.f, 0.f, 0.f}; acc[m][1] = (f32x4){0.f, 0.f, 0.f, 0.f}; }
#pragma unroll
                for (int ks = 0; ks < 4; ++ks) { bf16x8 bfr[4];
#pragma unroll
                    for (int m = 0; m < 4; ++m) bfr[m] = *(const LAS bf16x8*)(As + (wr * 64 + m * 16 + fr) * PA + (ks * 32 + fq * 8) * 2);
#pragma unroll
                    for (int n = 0; n < 2; ++n) { const bf16x8 afr = tr_frag(Bs, PA, ks * 32, wc * 32 + n * 16, lane);
#pragma unroll
                        for (int m = 0; m < 4; ++m) acc[m][n] = MFMA16(afr, bfr[m], acc[m][n]); } }
#pragma unroll
                for (int m = 0; m < 4; ++m) { const int t = wr * 64 + m * 16 + fr; const float bs = b_s[g * 128 + t];
#pragma unroll
                    for (int n = 0; n < 2; ++n) { GAS v2u* p = (GAS v2u*)(UY + (size_t)(row0 + t) * SGW + c0 + wc * 32 + n * 16 + 4 * fq); const v2u uu = *p; const f32x4 sv = acc[m][n] + bs;
                        *p = (v2u){pk2(bf_lo(uu.x) * sv[0], bf_hi(uu.x) * sv[1]), pk2(bf_lo(uu.y) * sv[2], bf_hi(uu.y) * sv[3])}; } }
                __syncthreads();
            }
        }
    }
}

__device__ __forceinline__ float logsig16(float z) { return (fminf(z, 0.f) - __logf(1.0f + __expf(-fabsf(z)))) * (1.0f / 16.0f); }
#define GLA_G(lds, GZ, w_g2, b_g, r0, h, tid, Gv, Glast) do { \
    LAS float* gzs_ = (LAS float*)(lds); LAS float* tot_ = (LAS float*)((lds) + 4096); \
    if ((tid) < 256) *(LAS f32x4*)(gzs_ + 4 * (tid)) = *(const GAS f32x4*)((GZ) + (size_t)(r0) * 16 + 4 * (tid)); \
    const int kk_ = (tid) & 127, seg_ = (tid) >> 7; float w2_[16]; \
    _Pragma("unroll") for (int r_ = 0; r_ < 16; ++r_) w2_[r_] = (w_g2)[r_ * KD + (h) * DK + kk_]; \
    const float bg_ = (b_g)[(h) * DK + kk_]; \
    __syncthreads(); \
    float run_ = 0.f; \
    _Pragma("unroll") for (int tt_ = 0; tt_ < 16; ++tt_) { const LAS f32x4* gr_ = (const LAS f32x4*)(gzs_ + (seg_ * 16 + tt_) * 16); float z_ = bg_; \
        _Pragma("unroll") for (int q_ = 0; q_ < 4; ++q_) { const f32x4 g4_ = gr_[q_]; z_ += g4_[0] * w2_[4 * q_] + g4_[1] * w2_[4 * q_ + 1] + g4_[2] * w2_[4 * q_ + 2] + g4_[3] * w2_[4 * q_ + 3]; } \
        run_ += logsig16(z_); Gv[tt_] = run_; } \
    tot_[seg_ * 128 + kk_] = run_; \
    __syncthreads(); \
    { const float t0_ = tot_[kk_], t1_ = tot_[128 + kk_], t2_ = tot_[256 + kk_], t3_ = tot_[384 + kk_]; \
      const float pre_ = (seg_ > 0 ? t0_ : 0.f) + (seg_ > 1 ? t1_ : 0.f) + (seg_ > 2 ? t2_ : 0.f); \
      _Pragma("unroll") for (int tt_ = 0; tt_ < 16; ++tt_) Gv[tt_] += pre_; \
      Glast = ((t0_ + t1_) + t2_) + t3_; } \
} while (0)

constexpr int G_KT = 8192, G_QT = 8192 + 17408, G_VT = 43008, G_PM = 76800, G_RED = 86016;
constexpr int PK = 272, PV = 528, PP = 144;

__device__ __forceinline__ void gla_state_phase(LAS unsigned char* lds, const bf16* Kg, const bf16* Vg, const float* GZ, const float* w_g2, const float* b_g, bf16* dS, float* dec,
                                                int G, int bid, int tid, int lane, int wid) {
    const int fr = lane & 15, fq = lane >> 4;
    for (int item = bid; item < NITEM; item += G) {
        const int h = item & 3, r0 = (item >> 2) * 64;
        float Gv[16], Glast;
        GLA_G(lds, GZ, w_g2, b_g, r0, h, tid, Gv, Glast);
        const int kk = tid & 127, seg = tid >> 7;
#pragma unroll
        for (int tt = 0; tt < 16; ++tt) { const int t = seg * 16 + tt; const float kv = bf1(Kg[(size_t)(r0 + t) * KD + h * DK + kk]);
            *(LAS bf16*)(lds + G_KT + t * PK + kk * 2) = (bf16)f2bf(kv * __expf(Glast - Gv[tt])); }
#pragma unroll
        for (int i = 0; i < 4; ++i) { const int id = tid + 512 * i, t = id >> 5, c = id & 31; *(LAS v4u*)(lds + G_VT + t * PV + c * 16) = *(const GAS v4u*)(Vg + (size_t)(r0 + t) * VD + h * DV + c * 8); }
        if (seg == 0) dec[(size_t)item * DK + kk] = __expf(Glast);
        __syncthreads();
        f32x4 acc[2][8];
#pragma unroll
        for (int d = 0; d < 2; ++d)
#pragma unroll
            for (int kt = 0; kt < 8; ++kt) acc[d][kt] = (f32x4){0.f, 0.f, 0.f, 0.f};
#pragma unroll
        for (int ks = 0; ks < 2; ++ks) { bf16x8 bfr[2];
#pragma unroll
            for (int d = 0; d < 2; ++d) bfr[d] = tr_frag(lds + G_VT, PV, ks * 32, 16 * (2 * wid + d), lane);
#pragma unroll
            for (int kt = 0; kt < 8; ++kt) { const bf16x8 afr = tr_frag(lds + G_KT, PK, ks * 32, 16 * kt, lane);
#pragma unroll
                for (int d = 0; d < 2; ++d) acc[d][kt] = MFMA16(afr, bfr[d], acc[d][kt]); } }
#pragma unroll
        for (int d = 0; d < 2; ++d) { bf16* rowp = dS + (size_t)item * (DV * DK) + (size_t)(16 * (2 * wid + d) + fr) * DK + 4 * fq;
#pragma unroll
            for (int kt = 0; kt < 8; ++kt) *(GAS v2u*)(rowp + 16 * kt) = (v2u){pk2(acc[d][kt][0], acc[d][kt][1]), pk2(acc[d][kt][2], acc[d][kt][3])}; }
        __syncthreads();
    }
}

__device__ __forceinline__ void gla_scan_phase(bf16* dS, const float* dec, int gtid, int NGT) {
    for (int e = gtid; e < 8 * DV * DK / 2; e += NGT) {
        const int bh = e >> 14, rem = e & 16383, b = bh >> 2, h = bh & 3;
        GAS unsigned* p = (GAS unsigned*)(dS + ((size_t)(b * 128) * 4 + h) * (DV * DK)) + rem;
        const GAS f32x2* dp = (const GAS f32x2*)(dec + ((size_t)(b * 128) * 4 + h) * DK) + (rem & 63);
        float s0 = 0.f, s1 = 0.f;
        for (int n0 = 0; n0 < 128; n0 += 8) { unsigned d[8]; f32x2 dc[8];
#pragma unroll
            for (int j = 0; j < 8; ++j) { d[j] = p[(size_t)(n0 + j) * (2 * DV * DK)]; dc[j] = dp[(size_t)(n0 + j) * (2 * DK)]; }
#pragma unroll
            for (int j = 0; j < 8; ++j) { p[(size_t)(n0 + j) * (2 * DV * DK)] = pk2(s0, s1); s0 = s0 * dc[j].x + bf_lo(d[j]); s1 = s1 * dc[j].y + bf_hi(d[j]); } }
    }
}

__device__ __forceinline__ void gla_out_phase(LAS unsigned char* lds, const bf16* Qg, const bf16* Kg, const bf16* Vg, bf16* SROG, const float* GZ, const float* w_g2, const float* b_g, const float* gn_g,
                                              const bf16* Sprev, int G, int bid, int tid, int lane, int wid) {
    const int fr = lane & 15, fq = lane >> 4;
    LAS float* red = (LAS float*)(lds + G_RED);
    for (int item = bid; item < NITEM; item += G) {
        const int h = item & 3, r0 = (item >> 2) * 64;
        float Gv[16], Glast;
        GLA_G(lds, GZ, w_g2, b_g, r0, h, tid, Gv, Glast);
        const int kk = tid & 127, seg = tid >> 7;
#pragma unroll
        for (int tt = 0; tt < 16; ++tt) { const int t = seg * 16 + tt; const size_t go = (size_t)(r0 + t) * KD + h * DK + kk; const float qv = bf1(Qg[go]), kv = bf1(Kg[go]);
            *(LAS bf16*)(lds + G_QT + t * PK + kk * 2) = (bf16)f2bf(qv * __expf(Gv[tt])); *(LAS bf16*)(lds + G_KT + t * PK + kk * 2) = (bf16)f2bf(kv * __expf(-Gv[tt])); }
#pragma unroll
        for (int i = 0; i < 4; ++i) { const int id = tid + 512 * i, t = id >> 5, c = id & 31; *(LAS v4u*)(lds + G_VT + t * PV + c * 16) = *(const GAS v4u*)(Vg + (size_t)(r0 + t) * VD + h * DV + c * 8); }
        __syncthreads();
        { const int it = wid >> 1;
#pragma unroll
          for (int jj = 0; jj < 2; ++jj) { const int jt = 2 * (wid & 1) + jj; f32x4 pa = (f32x4){0.f, 0.f, 0.f, 0.f};
#pragma unroll
              for (int ks = 0; ks < 4; ++ks) { const bf16x8 a = *(const LAS bf16x8*)(lds + G_KT + (16 * jt + fr) * PK + (32 * ks + 8 * fq) * 2), b = *(const LAS bf16x8*)(lds + G_QT + (16 * it + fr) * PK + (32 * ks + 8 * fq) * 2);
                  pa = MFMA16(a, b, pa); }
              const int i = 16 * it + fr, j0 = 16 * jt + 4 * fq;
              *(LAS v2u*)(lds + G_PM + i * PP + j0 * 2) = (v2u){pk2(j0 <= i ? pa[0] : 0.f, j0 + 1 <= i ? pa[1] : 0.f), pk2(j0 + 2 <= i ? pa[2] : 0.f, j0 + 3 <= i ? pa[3] : 0.f)}; } }
        __syncthreads();
        f32x4 acc[4][2];
#pragma unroll
        for (int it = 0; it < 4; ++it) { acc[it][0] = (f32x4){0.f, 0.f, 0.f, 0.f}; acc[it][1] = (f32x4){0.f, 0.f, 0.f, 0.f}; }
#pragma unroll
        for (int ks = 0; ks < 2; ++ks) { bf16x8 a[2];
#pragma unroll
            for (int d = 0; d < 2; ++d) a[d] = tr_frag(lds + G_VT, PV, ks * 32, 16 * (2 * wid + d), lane);
#pragma unroll
            for (int it = 0; it < 4; ++it) { const bf16x8 b = *(const LAS bf16x8*)(lds + G_PM + (16 * it + fr) * PP + (32 * ks + 8 * fq) * 2);
#pragma unroll
                for (int d = 0; d < 2; ++d) acc[it][d] = MFMA16(a[d], b, acc[it][d]); } }
#pragma unroll
        for (int ks = 0; ks < 4; ++ks) { bf16x8 a[2];
#pragma unroll
            for (int d = 0; d < 2; ++d) a[d] = *(const GAS bf16x8*)(Sprev + (size_t)item * (DV * DK) + (size_t)(16 * (2 * wid + d) + fr) * DK + 32 * ks + 8 * fq);
#pragma unroll
            for (int it = 0; it < 4; ++it) { const bf16x8 b = *(const LAS bf16x8*)(lds + G_QT + (16 * it + fr) * PK + (32 * ks + 8 * fq) * 2);
#pragma unroll
                for (int d = 0; d < 2; ++d) acc[it][d] = MFMA16(a[d], b, acc[it][d]); } }
#pragma unroll
        for (int it = 0; it < 4; ++it) { float ss = 0.f;
#pragma unroll
            for (int d = 0; d < 2; ++d) ss += (acc[it][d][0] * acc[it][d][0] + acc[it][d][1] * acc[it][d][1]) + (acc[it][d][2] * acc[it][d][2] + acc[it][d][3] * acc[it][d][3]);
            ss += __shfl_xor(ss, 16); ss += __shfl_xor(ss, 32);
            if (fq == 0) red[wid * 64 + 16 * it + fr] = ss; }
        __syncthreads();
#pragma unroll
        for (int it = 0; it < 4; ++it) { const int i = 16 * it + fr; float tot = 0.f;
#pragma unroll
            for (int w8 = 0; w8 < 8; ++w8) tot += red[w8 * 64 + i];
            const float rms = __builtin_amdgcn_rsqf(tot * (1.0f / 256.0f) + EPS);
#pragma unroll
            for (int d = 0; d < 2; ++d) { const int dv = 16 * (2 * wid + d) + 4 * fq; const f32x4 gn = *(const f32x4*)(gn_g + h * DV + dv);
                GAS v2u* p = (GAS v2u*)(SROG + (size_t)(r0 + i) * VD + h * DV + dv); const v2u sr = *p; const f32x4 o = acc[it][d] * rms * gn;
                *p = (v2u){pk2(o[0] * bf_lo(sr.x), o[1] * bf_hi(sr.x)), pk2(o[2] * bf_lo(sr.y), o[3] * bf_hi(sr.y))}; } }
        __syncthreads();
    }
}

#define XB_TMO      128
#define XB_XCNT(j)  (256  + 64 * (j))
#define XB_XSUB(j)  (1280 + 64 * (j))
#define XB_XGEN(j)  (2304 + 64 * (j))
#define XB_TOP      3328
#define XB_TOPGEN   3392
#define XCD_BAR_WORDS 3456
#define XB_SPIN_CAP (1u << 18)

__device__ __forceinline__ unsigned xb_ld(unsigned* p)              { return __hip_atomic_load(p, __ATOMIC_RELAXED, __HIP_MEMORY_SCOPE_AGENT); }
__device__ __forceinline__ unsigned xb_add(unsigned* p, unsigned v) { return __hip_atomic_fetch_add(p, v, __ATOMIC_RELAXED, __HIP_MEMORY_SCOPE_AGENT); }
__device__ __forceinline__ unsigned xb_xcc_id() { return (unsigned)__builtin_amdgcn_s_getreg((3 << 11) | 20) & 0xFu; }
#define XB_SPIN(cond, bar) do { unsigned _sp = 0; while (cond) { __builtin_amdgcn_s_sleep(1); \
    if ((++_sp & 255u) == 0u) { if (xb_ld(&(bar)[XB_TMO])) break; if (_sp > XB_SPIN_CAP) { atomicAdd(&(bar)[XB_TMO], 1u); break; } } } } while (0)

struct XcdBarrier {
    unsigned* bar; unsigned x;
    volatile LAS unsigned* st;
};

__device__ __forceinline__ XcdBarrier xcd_barrier_post(unsigned* bar, volatile LAS unsigned* st) {
    XcdBarrier b; b.bar = bar; b.x = xb_xcc_id(); b.st = st;
    if (threadIdx.x == 0) (void)xb_add(&bar[XB_XCNT(b.x)], 1u);
    return b;
}
__device__ __forceinline__ void xcd_barrier_complete(unsigned* bar, unsigned x, unsigned& nloc, unsigned& nx) {
    const unsigned G = gridDim.x * gridDim.y * gridDim.z;
    unsigned sum, cnt, mine, sp = 0u;
    for (;;) {
        sum = 0u; cnt = 0u; mine = 0u;
#pragma unroll
        for (unsigned j = 0; j < 16; ++j) { const unsigned c = xb_ld(&bar[XB_XCNT(j)]); sum += c; cnt += (c > 0u) ? 1u : 0u; mine = (j == x) ? c : mine; }
        if (sum == G) break;
        __builtin_amdgcn_s_sleep(1);
        if ((++sp & 255u) == 0u) { if (xb_ld(&bar[XB_TMO])) break; if (sp > XB_SPIN_CAP) { atomicAdd(&bar[XB_TMO], 1u); break; } }
    }
    nloc = mine > 0u ? mine : 1u; nx = cnt > 0u ? cnt : 1u;
}

__device__ __forceinline__ void xcd_barrier(const XcdBarrier& b) {
    asm volatile("s_waitcnt vmcnt(0)" ::: "memory");
    __syncthreads();
    if (threadIdx.x == 0) {
        unsigned* bar = b.bar;
        __builtin_amdgcn_s_waitcnt(0);
        unsigned nloc = b.st[0], nx = b.st[1];
        if (nloc == 0u) { xcd_barrier_complete(bar, b.x, nloc, nx); b.st[0] = nloc; b.st[1] = nx; }
        const unsigned old = xb_add(&bar[XB_XSUB(b.x)], 1u);
        const unsigned gen = old / nloc;
        if (old + 1u == (gen + 1u) * nloc) {
            __builtin_amdgcn_fence(__ATOMIC_RELEASE, "agent");
            asm volatile("s_waitcnt vmcnt(0)" ::: "memory");
            const unsigned og = xb_add(&bar[XB_TOP], 1u);
            const unsigned tg = og / nx;
            if (og + 1u == (tg + 1u) * nx) xb_add(&bar[XB_TOPGEN], 1u);
            else XB_SPIN(xb_ld(&bar[XB_TOPGEN]) == tg, bar);
            __builtin_amdgcn_fence(__ATOMIC_ACQUIRE, "agent");
            xb_add(&bar[XB_XGEN(b.x)], 1u);
            asm volatile("s_waitcnt vmcnt(0)" ::: "memory");
        } else {
            XB_SPIN(xb_ld(&bar[XB_XGEN(b.x)]) == gen, bar);
            __builtin_amdgcn_fence(__ATOMIC_ACQUIRE, "agent");
            asm volatile("s_waitcnt vmcnt(0)" ::: "memory");
        }
    }
    __syncthreads();
}

constexpr int NPHASE = 14;
__global__ void __launch_bounds__(NTHREADS, 2) mk_fwd(Args args) {
    extern __shared__ __attribute__((aligned(16))) unsigned char lds_raw[];
    LAS unsigned char* lds = (LAS unsigned char*)lds_raw;
    cg::grid_group grid = cg::this_grid();
    const int tid = threadIdx.x, lane = tid & 63, wave = __builtin_amdgcn_readfirstlane(tid >> 6);
    const int G = gridDim.x, bid = blockIdx.x;
    const int vcu = (G % 8 == 0) ? (bid % 8) * (G / 8) + bid / 8 : bid;
    const int gw = vcu * NWAVES + wave, NGW = G * NWAVES, gtid = vcu * NTHREADS + tid, NGT = G * NTHREADS;
    unsigned char* ws = args.ws;
    const int lo = args.ph_lo, hi = args.ph_hi;
#define IN(k) (lo <= (k) && (k) < hi)
    if (tid < 64) ((LAS unsigned*)(lds + RING_BYTES))[tid] = 0u;
    __syncthreads();
    XcdBarrier bar; bar.bar = (unsigned*)ws; bar.x = 0; bar.st = nullptr;
    if (hi - lo > 1) bar = xcd_barrier_post((unsigned*)ws, (volatile LAS unsigned*)(lds + RING_BYTES) + 8);
#define SEAM(k) do { if (IN(k) && IN((k) + 1)) xcd_barrier(bar); } while (0)
    if (hi > 1000) grid.sync();
    float* X = args.out;
    float* rsq = (float*)(ws + WS_RSQ);
    bf16* XB = (bf16*)(ws + WS_RV);

    if (IN(0)) { p0_prologue(args, lds, gw, NGW, lane, wave, gtid, NGT); } SEAM(0);
    if (IN(1)) {
        pg8::Gemm g{(const bf16*)args.out, (const bf16*)(ws + WS_WAIN), M, SGF, D}; pg8::StaticOrder S; S.init(M, SGF, G, bid);
        pg8::EpiSguIn E{(bf16*)(ws + WS_RU), (bf16*)(ws + WS_RV), rsq, (pg8::f32x2*)((unsigned char*)args.out + 32 * MiB)};
        pg8::gemm_phase<pg8::EpiSguIn, pg8::StaticOrder, true, true>(lds, g, S, E);
    } SEAM(1);
    if (IN(2)) { sgu_phase(lds, (const bf16*)(ws + WS_WM), (const bf16*)(ws + WS_RV), (bf16*)(ws + WS_RU), (const f32x2*)((unsigned char*)args.out + 32 * MiB), args.in[3], args.in[4], args.in[6], G, vcu, tid, lane, wave); } SEAM(2);
    if (IN(3)) {
        pg8::Gemm g{(const bf16*)(ws + WS_RU), (const bf16*)(ws + WS_WAOUT), M, D, SGW}; pg8::StaticOrder S; S.init(M, D, G, bid);
        pg8::EpiResid<true> E{args.in[0], XB, rsq};
        pg8::gemm_phase<pg8::EpiResid<true>, pg8::StaticOrder, false, true>(lds, g, S, E);
    } SEAM(3);
    if (IN(4)) {
        pg8::Gemm g{XB, (const bf16*)(ws + WS_WGU0), M, 2 * FH, D}; pg8::StaticOrder S; S.init(M, 2 * FH, G, bid);
        pg8::EpiSwiGLU E{(bf16*)(ws + WS_RU), FH, rsq};
        pg8::gemm_phase<pg8::EpiSwiGLU, pg8::StaticOrder, true, true>(lds, g, S, E);
    } SEAM(4);
    if (IN(5)) {
        pg8::Gemm g{(const bf16*)(ws + WS_RU), (const bf16*)(ws + WS_WDN0), M, D, FH}; pg8::StaticOrder S; S.init(M, D, G, bid);
        pg8::EpiResid<false> E{XB, XB, rsq};
        pg8::gemm_phase<pg8::EpiResid<false>, pg8::StaticOrder, false, true>(lds, g, S, E);
    } SEAM(5);
    bf16* Qg = (bf16*)(ws + WS_RU); bf16* Kg = (bf16*)(ws + WS_RU + 16 * MiB); bf16* Vg = (bf16*)(ws + WS_RU + 32 * MiB); bf16* SR = (bf16*)(ws + WS_RU + 64 * MiB);
    bf16* dS = (bf16*)(ws + WS_RV + 32 * MiB); float* GZ = (float*)(ws + WS_GZ); float* dec = (float*)(ws + WS_DEC);
    if (IN(6)) {
        for (int rt = gw; rt < M / 16; rt += NGW) { const int fr = lane & 15, fq = lane >> 4;
            const bf16* ap = XB + (size_t)(rt * 16 + fr) * D + 8 * fq; const bf16* bp = (const bf16*)(ws + WS_WBIN) + (size_t)(3072 + fr) * D + 8 * fq;
            f32x4 c0 = (f32x4){0.f, 0.f, 0.f, 0.f}, c1 = c0;
#pragma unroll 4
            for (int ks = 0; ks < 32; ks += 2) { const bf16x8 a0 = *(const GAS bf16x8*)(bp + 32 * ks), b0 = *(const GAS bf16x8*)(ap + 32 * ks), a1 = *(const GAS bf16x8*)(bp + 32 * ks + 32), b1 = *(const GAS bf16x8*)(ap + 32 * ks + 32);
                c0 = MFMA16(a0, b0, c0); c1 = MFMA16(a1, b1, c1); }
            *(GAS f32x4*)(GZ + (size_t)(rt * 16 + fr) * 16 + 4 * fq) = (c0 + c1) * pg8::row_rs(rsq, rt * 16 + fr); }
        pg8::Gemm g{XB, (const bf16*)(ws + WS_WBIN), M, 3072, D}; pg8::StaticOrder S; S.init(M, 3072, G, bid);
        pg8::EpiGlaIn E{Qg, Kg, Vg, SR, GZ, rsq};
        pg8::gemm_phase<pg8::EpiGlaIn, pg8::StaticOrder, true, true>(lds, g, S, E);
    } SEAM(6);
    if (IN(7)) { gla_state_phase(lds, Kg, Vg, GZ, args.in[9], args.in[10], dS, dec, G, vcu, tid, lane, wave); } SEAM(7);
    if (IN(8)) { gla_scan_phase(dS, dec, gtid, NGT); } SEAM(8);
    if (IN(9)) { gla_out_phase(lds, Qg, Kg, Vg, SR, GZ, args.in[9], args.in[10], args.in[11], dS, G, vcu, tid, lane, wave); } SEAM(9);
    if (IN(10)) {
        pg8::Gemm g{SR, (const bf16*)(ws + WS_WBOUT), M, D, VD}; pg8::StaticOrder S; S.init(M, D, G, bid);
        pg8::EpiResid<false> E{XB, XB, rsq};
        pg8::gemm_phase<pg8::EpiResid<false>, pg8::StaticOrder, false, true>(lds, g, S, E);
    } SEAM(10);
    if (IN(11)) {
        pg8::Gemm g{XB, (const bf16*)(ws + WS_WGU1), M, 2 * FH, D}; pg8::StaticOrder S; S.init(M, 2 * FH, G, bid);
        pg8::EpiSwiGLU E{(bf16*)(ws + WS_RU), FH, rsq};
        pg8::gemm_phase<pg8::EpiSwiGLU, pg8::StaticOrder, true, true>(lds, g, S, E);
    } SEAM(11);
    if (IN(12)) {
        pg8::Gemm g{(const bf16*)(ws + WS_RU), (const bf16*)(ws + WS_WDN1), M, D, FH}; pg8::StaticOrder S; S.init(M, D, G, bid);
        pg8::EpiResid<false> E{XB, XB, rsq};
        pg8::gemm_phase<pg8::EpiResid<false>, pg8::StaticOrder, false, true>(lds, g, S, E);
    } SEAM(12);
    if (IN(13)) {
        const float* fg = args.in[17];
        f32x4 gv[4];
#pragma unroll
        for (int j = 0; j < 4; ++j) gv[j] = *(const f32x4*)(fg + 8 * lane + 512 * (j >> 1) + 4 * (j & 1));
        for (int m0 = gw; m0 < M; m0 += 8 * NGW) { v4u w[8][2]; float rs[8];
#pragma unroll
            for (int r = 0; r < 8; ++r) { const int m = m0 + r * NGW; if (m < M) { const GAS v4u* xr = (const GAS v4u*)(XB + (size_t)m * D) + lane; w[r][0] = xr[0]; w[r][1] = xr[64]; rs[r] = pg8::row_rs(rsq, m); } }
#pragma unroll
            for (int r = 0; r < 8; ++r) { const int m = m0 + r * NGW; if (m < M) { GAS f32x4* o = (GAS f32x4*)(X + (size_t)m * D) + 2 * lane;
#pragma unroll
                for (int hh = 0; hh < 2; ++hh) { const v4u q = w[r][hh];
                    o[128 * hh] = (f32x4){bf_lo(q.x), bf_hi(q.x), bf_lo(q.y), bf_hi(q.y)} * rs[r] * gv[2 * hh];
                    o[128 * hh + 1] = (f32x4){bf_lo(q.z), bf_hi(q.z), bf_lo(q.w), bf_hi(q.w)} * rs[r] * gv[2 * hh + 1]; } } } }
    }
#undef IN
#undef SEAM
}


__global__ void digest_k(const unsigned short* a, size_t na, const float* f, size_t nf, float* out) {
    const size_t n = (size_t)16384 * 1024;
    for (size_t i = (size_t)blockIdx.x * blockDim.x + threadIdx.x; i < n; i += (size_t)gridDim.x * blockDim.x) {
        float v = 0.f;
        for (size_t k = 0; k * n + i < na; ++k) v += __builtin_bit_cast(float, (unsigned)a[k * n + i] << 16);
        if (nf) v += f[i % nf];
        if (!(fabsf(v) < 1e30f)) v = 1e30f;
        out[i] = v;
    }
}
#ifndef MK_N_LAUNCHES
#define MK_N_LAUNCHES 1
#define DBG_NPH 14
#endif
extern "C" void kernel_launch(void* const* d_in, const int* in_sizes, int n_in, void* d_out, int out_size, void* d_ws, size_t ws_size, hipStream_t stream) {
    static int grid = 0;
    if (grid == 0) {
        if (n_in != 18 || in_sizes[0] != M * D || out_size != M * D || ws_size < WS_END) { fprintf(stderr, "kernel_launch: unexpected shapes (n_in %d, in0 %d, out %d, ws %zu); nothing launched\n", n_in, n_in > 0 ? in_sizes[0] : -1, out_size, ws_size); grid = -1; return; }
        int dev = 0, cus = 0, per_cu = 0;
        if (hipGetDevice(&dev) != hipSuccess || hipDeviceGetAttribute(&cus, hipDeviceAttributeMultiprocessorCount, dev) != hipSuccess) { grid = -1; return; }
        if (hipFuncSetAttribute((const void*)mk_fwd, hipFuncAttributeMaxDynamicSharedMemorySize, LDS_BYTES) != hipSuccess) { fprintf(stderr, "kernel_launch: hipFuncSetAttribute failed\n"); grid = -1; return; }
        if (hipOccupancyMaxActiveBlocksPerMultiprocessor(&per_cu, (const void*)mk_fwd, NTHREADS, LDS_BYTES) != hipSuccess || per_cu < 1) { fprintf(stderr, "kernel_launch: occupancy query gives %d blocks per CU\n", per_cu); (void)hipGetLastError(); grid = -1; return; }
        grid = cus;
        if (grid != 256) { fprintf(stderr, "kernel_launch: built for a 256-CU device (got %d)\n", cus); grid = -1; return; }
    }
    if (grid < 0) return;
    Args a{};
    for (int i = 0; i < 18; ++i) a.in[i] = (const float*)d_in[i];
    a.out = (float*)d_out; a.ws = (unsigned char*)d_ws;
#if MK_N_LAUNCHES == 1
    if (hipMemsetAsync(d_ws, 0, 16384, stream) != hipSuccess) { fprintf(stderr, "kernel_launch: memset of the barrier words failed\n"); return; }
    a.ph_lo = 0; a.ph_hi = NPHASE;
    void* kargs[] = {&a};
    hipError_t e = hipLaunchCooperativeKernel((const void*)mk_fwd, dim3(grid), dim3(NTHREADS), kargs, LDS_BYTES, stream);
    if (e != hipSuccess) fprintf(stderr, "kernel_launch: cooperative launch failed: %s\n", hipGetErrorString(e));
#else
    for (int p = 0; p < DBG_NPH; ++p) { a.ph_lo = p; a.ph_hi = p + 1; hipLaunchKernelGGL(mk_fwd, dim3(grid), dim3(NTHREADS), LDS_BYTES, stream, a); }
#ifdef DBG_DIG
    { unsigned char* w = (unsigned char*)d_ws; const size_t n16 = (size_t)16384 * 1024;
      const unsigned short* da = nullptr; size_t na = 0; const float* df = nullptr; size_t nf = 0;
      if (DBG_DIG == 6) { da = (const unsigned short*)(w + WS_RU); na = 3 * n16; df = (const float*)(w + WS_GZ); nf = 262144; }
      if (DBG_DIG == 7 || DBG_DIG == 8) { da = (const unsigned short*)(w + WS_RV + 32 * MiB); na = 2 * n16; df = (const float*)(w + WS_DEC); nf = 131072; }
      if (DBG_DIG == 9) { da = (const unsigned short*)(w + WS_RU + 64 * MiB); na = n16; }
      hipLaunchKernelGGL(digest_k, dim3(2048), dim3(256), 0, stream, da, na, df, nf, (float*)d_out); }
#endif
#endif
}
```

```cpp
#include <hip/hip_runtime.h>
#include <hip/hip_cooperative_groups.h>
#include <cstdio>
#include <cstdint>
namespace cg = cooperative_groups;
namespace pg8 {
#define PG8_LAS __attribute__((address_space(3)))
typedef unsigned short bf16_t;
typedef short bf16x8 __attribute__((ext_vector_type(8)));
typedef float f32x4 __attribute__((ext_vector_type(4)));
typedef unsigned u32x4 __attribute__((ext_vector_type(4)));
constexpr int BM = 256, BK = 64, HALF = 128, HTB = HALF * BK * 2  , STAGE_BYTES = 8 * HTB, NXCD = 8, WGM = 8;

__host__ __device__ __forceinline__ int lds_byte(int r, int c) { const int st = (r >> 4) * 2 + (c >> 5), rr = r & 15, cc = c & 31, ob = rr * 64 + cc * 2; return st * 1024 + (ob ^ (((ob >> 9) & 1) << 5)); }
__host__ __device__ __forceinline__ void stage_rc(int b, int& R, int& C) { const int st = b / 1024, sb = b % 1024, swz = sb ^ (((sb >> 9) & 1) << 5); R = (st >> 1) * 16 + swz / 64; C = (st & 1) * 32 + (swz % 64) / 2; }
__host__ __device__ __forceinline__ int perm32(int rho) { const int n = rho >> 4, i = rho & 15; return 8 * (i >> 2) + 4 * n + (i & 3); }

struct Unit { int pm, pn; };
struct Gemm { const bf16_t* A; const bf16_t* Bt; int M, N, K; };

struct StaticOrder {
    int nM, nN, nwg, G, c;
    __host__ __device__ void init(int M, int N, int G_, int c_) { nM = M / BM; nN = N / BM; nwg = nM * nN; G = G_; c = c_; }
    __host__ __device__ bool next(int i, Unit& u) const {
        const long L = (long)i * G + c; if (L >= nwg) return false;
        int wgid = (int)L; { const int q = nwg / NXCD, r = nwg % NXCD, xcd = wgid % NXCD, off = wgid / NXCD; wgid = (xcd < r ? xcd * (q + 1) : r * (q + 1) + (xcd - r) * q) + off; }
        const int nig = WGM * nN, gid = wgid / nig, fm = gid * WGM, gsz = (nM - fm) < WGM ? (nM - fm) : WGM;
        u.pm = fm + ((wgid % nig) % gsz); u.pn = (wgid % nig) / gsz; return true;
    }
    __device__ __forceinline__ void a_ready(const Unit&) const {}
    __device__ __forceinline__ void done(const Unit&) const {}
};

typedef float f32x2 __attribute__((ext_vector_type(2)));
typedef __bf16 bf16x2v __attribute__((ext_vector_type(2)));
__device__ __forceinline__ unsigned cvt_pk_bf16(float lo, float hi) { const bf16x2v r = __builtin_convertvector((f32x2){lo, hi}, bf16x2v); return __builtin_bit_cast(unsigned, r); }
__device__ __forceinline__ f32x2 gelu_pk(f32x2 v) {
    f32x2 a = __builtin_elementwise_abs(v); a.x = fminf(a.x, 6.0f); a.y = fminf(a.y, 6.0f);
    f32x2 p = a * 2.339709687609881e-05f + (-0.0006192482003406358f); p = p * a + 0.0072583738289044054f; p = p * a + (-0.051417680994680484f); p = p * a + (-0.46085568318627523f); p = p * a + (-1.1504893945481205f);
    p = p * a + (-1.0f);
    f32x2 t; t.x = __builtin_amdgcn_exp2f(p.x); t.y = __builtin_amdgcn_exp2f(p.y);
    const f32x2 m = v * t, r = v - m;
    f32x2 o; o.x = v.x < 0.f ? m.x : r.x; o.y = v.y < 0.f ? m.y : r.y; return o;
}

constexpr int EM = 16384;
constexpr float EEPS = 1e-6f;
__device__ __forceinline__ float row_rs(const float* rsq, int row) {
    const f32x4 p = *(const f32x4*)(rsq + (size_t)row * 4);
    return __builtin_amdgcn_rsqf(((p[0] + p[1]) + (p[2] + p[3])) * (1.0f / 1024.0f) + EEPS);
}
__device__ __forceinline__ float silu_f(float v) { return v * __builtin_amdgcn_rcpf(1.0f + __expf(-v)); }

struct EpiSguIn {
    static constexpr bool PERM = true, AFTER_DRAIN = false;
    bf16_t* U; bf16_t* V; const float* rsq; f32x2* statP;
    __device__ __forceinline__ void operator()(const f32x4 (&acc)[2][2][4][2], const Unit& u, int wr, int wc, int fr, int fq) const {
        const int colt = u.pn * HALF + wc * 32 + 8 * fq;
        const int row0 = u.pm * BM + wr * 64 + fr;
#pragma unroll
        for (int ai = 0; ai < 2; ++ai)
#pragma unroll
            for (int m = 0; m < 4; ++m) { const int row = row0 + ai * HALF + m * 16; const float rs = row_rs(rsq, row);
                { const f32x4 v0 = acc[ai][0][m][0] * rs, v1 = acc[ai][0][m][1] * rs;
                  u32x4 w; w.x = cvt_pk_bf16(v0[0], v0[1]); w.y = cvt_pk_bf16(v0[2], v0[3]); w.z = cvt_pk_bf16(v1[0], v1[1]); w.w = cvt_pk_bf16(v1[2], v1[3]);
                  *(u32x4*)(U + (size_t)row * 3072 + colt) = w; }
                { const f32x4 v0 = acc[ai][1][m][0] * rs, v1 = acc[ai][1][m][1] * rs;
                  const f32x2 a = gelu_pk((f32x2){v0[0], v0[1]}), b = gelu_pk((f32x2){v0[2], v0[3]}), c = gelu_pk((f32x2){v1[0], v1[1]}), d = gelu_pk((f32x2){v1[2], v1[3]});
                  float s1 = ((a.x + a.y) + (b.x + b.y)) + ((c.x + c.y) + (d.x + d.y));
                  float s2 = ((a.x * a.x + a.y * a.y) + (b.x * b.x + b.y * b.y)) + ((c.x * c.x + c.y * c.y) + (d.x * d.x + d.y * d.y));
                  u32x4 w; w.x = cvt_pk_bf16(a.x, a.y); w.y = cvt_pk_bf16(b.x, b.y); w.z = cvt_pk_bf16(c.x, c.y); w.w = cvt_pk_bf16(d.x, d.y);
                  *(u32x4*)(V + (size_t)row * 3072 + colt) = w;
                  s1 += __shfl_xor(s1, 16); s1 += __shfl_xor(s1, 32); s2 += __shfl_xor(s2, 16); s2 += __shfl_xor(s2, 32);
                  if (fq == 0) statP[(size_t)(u.pn * 4 + wc) * EM + row] = (f32x2){s1, s2}; } }
    }
};
struct EpiSwiGLU {
    static constexpr bool PERM = true, AFTER_DRAIN = false;
    bf16_t* Hd; int ldh; const float* rsq;
    __device__ __forceinline__ void operator()(const f32x4 (&acc)[2][2][4][2], const Unit& u, int wr, int wc, int fr, int fq) const {
        const int row0 = u.pm * BM + wr * 64 + fr, col0 = u.pn * HALF + wc * 32 + 8 * fq;
#pragma unroll
        for (int ai = 0; ai < 2; ++ai)
#pragma unroll
            for (int m = 0; m < 4; ++m) { const int row = row0 + ai * HALF + m * 16; const float rs = row_rs(rsq, row);
                const f32x4 g0 = acc[ai][0][m][0] * rs, g1 = acc[ai][0][m][1] * rs, u0 = acc[ai][1][m][0] * rs, u1 = acc[ai][1][m][1] * rs;
                u32x4 w; w.x = cvt_pk_bf16(silu_f(g0[0]) * u0[0], silu_f(g0[1]) * u0[1]); w.y = cvt_pk_bf16(silu_f(g0[2]) * u0[2], silu_f(g0[3]) * u0[3]);
                w.z = cvt_pk_bf16(silu_f(g1[0]) * u1[0], silu_f(g1[1]) * u1[1]); w.w = cvt_pk_bf16(silu_f(g1[2]) * u1[2], silu_f(g1[3]) * u1[3]);
                *(u32x4*)(Hd + (size_t)row * ldh + col0) = w; }
    }
};
struct EpiGlaIn {
    static constexpr bool PERM = true, AFTER_DRAIN = false;
    bf16_t* Q; bf16_t* Kk; bf16_t* Vv; bf16_t* SR; float* GZ; const float* rsq;
    __device__ __forceinline__ void operator()(const f32x4 (&acc)[2][2][4][2], const Unit& u, int wr, int wc, int fr, int fq) const {
        const int row0 = u.pm * BM + wr * 64 + fr, pn = u.pn;
        if (pn == 12) {
            if (wc == 0 && fq < 2) {
#pragma unroll
                for (int ai = 0; ai < 2; ++ai)
#pragma unroll
                    for (int m = 0; m < 4; ++m) { const int row = row0 + ai * HALF + m * 16; const float rs = row_rs(rsq, row);
                        float* p = GZ + (size_t)row * 16 + 8 * fq; *(f32x4*)p = acc[ai][0][m][0] * rs; *(f32x4*)(p + 4) = acc[ai][0][m][1] * rs; }
            }
            return;
        }
        bf16_t* base; int ld, colt; float sc = 1.f; const bool act = pn >= 8;
        if (pn < 2) { base = Q; ld = 512; colt = pn * BM; sc = 0.08838834764831845f; } else if (pn < 4) { base = Kk; ld = 512; colt = (pn - 2) * BM; }
        else if (pn < 8) { base = Vv; ld = 1024; colt = (pn - 4) * BM; } else { base = SR; ld = 1024; colt = (pn - 8) * BM; }
        colt += wc * 32 + 8 * fq;
#pragma unroll
        for (int ai = 0; ai < 2; ++ai)
#pragma unroll
            for (int m = 0; m < 4; ++m) { const int row = row0 + ai * HALF + m * 16; const float rs = row_rs(rsq, row) * sc;
                bf16_t* rowp = base + (size_t)row * ld + colt;
#pragma unroll
                for (int bj = 0; bj < 2; ++bj) { f32x4 v0 = acc[ai][bj][m][0] * rs, v1 = acc[ai][bj][m][1] * rs;
                    if (act) { v0 = (f32x4){silu_f(v0[0]), silu_f(v0[1]), silu_f(v0[2]), silu_f(v0[3])}; v1 = (f32x4){silu_f(v1[0]), silu_f(v1[1]), silu_f(v1[2]), silu_f(v1[3])}; }
                    u32x4 w; w.x = cvt_pk_bf16(v0[0], v0[1]); w.y = cvt_pk_bf16(v0[2], v0[3]); w.z = cvt_pk_bf16(v1[0], v1[1]); w.w = cvt_pk_bf16(v1[2], v1[3]);
                    *(u32x4*)(rowp + bj * HALF) = w; } }
    }
};
template <bool F32BASE> struct EpiResid {
    static constexpr bool PERM = true, AFTER_DRAIN = true;
    const void* base; bf16_t* xb; float* rsq;
    __device__ __forceinline__ void fused(f32x4 (&acc)[2][2][4][2], const Unit& u, int wr, int wc, int fr, int fq, PG8_LAS unsigned char* lds, int wid, int lane) const {
        PG8_LAS float* P = (PG8_LAS float*)lds;
        const int col0 = u.pn * BM + wc * 32 + 8 * fq;
#pragma unroll
        for (int ai = 0; ai < 2; ++ai)
#pragma unroll
            for (int m = 0; m < 4; ++m) { const int r = ai * HALF + wr * 64 + m * 16 + fr; const size_t off = (size_t)(u.pm * BM + r) * 1024 + col0; float ss = 0.f;
#pragma unroll
                for (int bj = 0; bj < 2; ++bj) { f32x4 b0, b1;
                    if (F32BASE) { const float* bp = (const float*)base + off + bj * HALF; b0 = *(const f32x4*)bp; b1 = *(const f32x4*)(bp + 4); }
                    else { const u32x4 w = *(const u32x4*)((const bf16_t*)base + off + bj * HALF);
                        b0 = (f32x4){__builtin_bit_cast(float, w.x << 16), __builtin_bit_cast(float, w.x & 0xffff0000u), __builtin_bit_cast(float, w.y << 16), __builtin_bit_cast(float, w.y & 0xffff0000u)};
                        b1 = (f32x4){__builtin_bit_cast(float, w.z << 16), __builtin_bit_cast(float, w.z & 0xffff0000u), __builtin_bit_cast(float, w.w << 16), __builtin_bit_cast(float, w.w & 0xffff0000u)}; }
                    const f32x4 o0 = b0 + acc[ai][bj][m][0], o1 = b1 + acc[ai][bj][m][1];
                    u32x4 w; w.x = cvt_pk_bf16(o0[0], o0[1]); w.y = cvt_pk_bf16(o0[2], o0[3]); w.z = cvt_pk_bf16(o1[0], o1[1]); w.w = cvt_pk_bf16(o1[2], o1[3]);
                    *(u32x4*)(xb + off + bj * HALF) = w;
                    ss += ((o0[0] * o0[0] + o0[1] * o0[1]) + (o0[2] * o0[2] + o0[3] * o0[3])) + ((o1[0] * o1[0] + o1[1] * o1[1]) + (o1[2] * o1[2] + o1[3] * o1[3])); }
                ss += __shfl_xor(ss, 16); ss += __shfl_xor(ss, 32);
                if (fq == 0) P[r * 4 + wc] = ss;
                if (m & 1) asm volatile("" ::: "memory"); }
        asm volatile("s_waitcnt lgkmcnt(0)" ::: "memory"); __builtin_amdgcn_s_barrier(); asm volatile("" ::: "memory");
        const int t = wid * 64 + lane;
        if (t < 256) { const f32x4 p = *(const PG8_LAS f32x4*)(P + t * 4); rsq[(size_t)(u.pm * BM + t) * 4 + u.pn] = (p[0] + p[1]) + (p[2] + p[3]); }
    }
};
template <class Epi, class Sched, bool ALIGN_EPI = false, bool SP2 = false>
__device__ __forceinline__ void gemm_phase(PG8_LAS unsigned char* lds, const Gemm g, const Sched& S, const Epi& E) {
    const int tid = threadIdx.x, wid = __builtin_amdgcn_readfirstlane(tid >> 6), lane = tid & 63, wr = wid >> 2, wc = wid & 3, fr = lane & 15, fq = lane >> 4;
    const int K = g.K, nt = K / BK;
    unsigned voffA[2], voffB[2];
#pragma unroll
    for (int i = 0; i < 2; ++i) { int R, C; stage_rc(tid * 16 + i * 8192, R, C); const int Rb = Epi::PERM ? ((R & ~31) + perm32(R & 31)) : R;
        voffA[i] = (unsigned)(R * K + C) * 2u; voffB[i] = (unsigned)(Rb * K + C) * 2u; }
    const size_t kstep = (size_t)(BK * 2);
    const size_t hstep = (size_t)HALF * K * 2;
    const size_t tstep = 2 * hstep;
    const unsigned ldsw = (unsigned)wid * 1024u;
    const int aoff = lds_byte(wr * 64 + fr, fq * 8), boff = lds_byte(wc * 32 + fr, fq * 8);
#define PG8_SA(b, h) (((b) * 2 + (h)) * HTB)
#define PG8_SB(b, h) ((4 + (b) * 2 + (h)) * HTB)
#define PG8_STAGE(bufoff, gbase, voff) do { _Pragma("unroll") for (int _i = 0; _i < 2; ++_i) \
        __builtin_amdgcn_global_load_lds((const unsigned*)((const char*)(gbase) + (voff)[_i]), (PG8_LAS unsigned*)(lds + (bufoff) + ldsw + _i * 8192), 16, 0, 0); } while (0)
#define PG8_LDA(dst, b, h) do { _Pragma("unroll") for (int m = 0; m < 4; ++m) _Pragma("unroll") for (int k = 0; k < 2; ++k) dst[m][k] = *(const PG8_LAS bf16x8*)(lds + PG8_SA(b, h) + aoff + m * 2048 + k * 1024); } while (0)
#define PG8_LDB(dst, b, h) do { _Pragma("unroll") for (int n = 0; n < 2; ++n) _Pragma("unroll") for (int k = 0; k < 2; ++k) dst[n][k] = *(const PG8_LAS bf16x8*)(lds + PG8_SB(b, h) + boff + n * 2048 + k * 1024); } while (0)
#define PG8_MMA(ai, bj, At, Bt) do { __builtin_amdgcn_s_setprio(1); _Pragma("unroll") for (int m = 0; m < 4; ++m) _Pragma("unroll") for (int n = 0; n < 2; ++n) _Pragma("unroll") for (int k = 0; k < 2; ++k) \
        acc[ai][bj][m][n] = __builtin_amdgcn_mfma_f32_16x16x32_bf16(Bt[n][k], At[m][k], acc[ai][bj][m][n], 0, 0, 0); __builtin_amdgcn_s_setprio(0); } while (0)
#define PG8_WAIT_V(n) asm volatile("s_waitcnt vmcnt(" #n ")" ::: "memory")
#define PG8_WAIT_L(n) asm volatile("s_waitcnt lgkmcnt(" #n ")" ::: "memory")
#define PG8_BAR __builtin_amdgcn_s_barrier()
#define PG8_SCHED __builtin_amdgcn_sched_barrier(0)
    Unit cur, nxt; int ui = 0;
    if (!S.next(0, cur)) return;
    f32x4 acc[2][2][4][2];
#pragma unroll
    for (int a = 0; a < 2; ++a)
#pragma unroll
        for (int b = 0; b < 2; ++b)
#pragma unroll
            for (int m = 0; m < 4; ++m)
#pragma unroll
                for (int n = 0; n < 2; ++n) acc[a][b][m][n] = (f32x4){0.f, 0.f, 0.f, 0.f};
    bf16x8 At[4][2], B0[2][2], B1[2][2];
    const char* cA = (const char*)g.A + (size_t)cur.pm * tstep; const char* cB = (const char*)g.Bt + (size_t)cur.pn * tstep;
    S.a_ready(cur);
    if constexpr (SP2) {
        PG8_STAGE(PG8_SB(0, 0), cB, voffB); PG8_STAGE(PG8_SB(0, 1), cB + hstep, voffB); PG8_STAGE(PG8_SA(0, 0), cA, voffA); PG8_STAGE(PG8_SA(0, 1), cA + hstep, voffA);
        if (wr == 1) PG8_BAR;
        PG8_WAIT_V(2); PG8_BAR;
        PG8_STAGE(PG8_SB(1, 0), cB + kstep, voffB); PG8_STAGE(PG8_SA(1, 0), cA + kstep, voffA); PG8_STAGE(PG8_SB(1, 1), cB + hstep + kstep, voffB);
        PG8_WAIT_V(6); PG8_BAR;
    } else {
        PG8_STAGE(PG8_SB(0, 0), cB, voffB); PG8_STAGE(PG8_SA(0, 0), cA, voffA); PG8_STAGE(PG8_SB(0, 1), cB + hstep, voffB); PG8_STAGE(PG8_SA(0, 1), cA + hstep, voffA);
        if (wr == 1) PG8_BAR;
        PG8_WAIT_V(4); PG8_BAR;
        PG8_STAGE(PG8_SB(1, 0), cB + kstep, voffB); PG8_STAGE(PG8_SA(1, 0), cA + kstep, voffA); PG8_STAGE(PG8_SB(1, 1), cB + hstep + kstep, voffB);
        PG8_WAIT_V(6); PG8_BAR;
    }
    for (;;) {
        const bool has_next = S.next(ui + 1, nxt);
        const char* nA = has_next ? (const char*)g.A + (size_t)nxt.pm * tstep : cA; const char* nB = has_next ? (const char*)g.Bt + (size_t)nxt.pn * tstep : cB;
        for (int t = 0; t < nt; t += 2) {
            const bool last = (t == nt - 2);
            const char* a1 = cA + (size_t)(t + 1) * kstep;
            const char* a2 = last ? nA : cA + (size_t)(t + 2) * kstep; const char* b2 = last ? nB : cB + (size_t)(t + 2) * kstep;
            const char* a3 = a2 + kstep; const char* b3 = b2 + kstep;
            if (last && has_next) S.a_ready(nxt);
            if constexpr (SP2) {
            PG8_LDB(B0, 0, 0); PG8_LDB(B1, 0, 1); PG8_SCHED; PG8_LDA(At, 0, 0); PG8_STAGE(PG8_SA(1, 1), a1 + hstep, voffA);
            PG8_WAIT_V(8); PG8_WAIT_L(0); PG8_BAR; PG8_MMA(0, 0, At, B0); PG8_MMA(0, 1, At, B1); PG8_BAR; PG8_SCHED;
            PG8_LDA(At, 0, 1); PG8_STAGE(PG8_SB(0, 0), b2, voffB); PG8_STAGE(PG8_SB(0, 1), b2 + hstep, voffB); PG8_STAGE(PG8_SA(0, 0), a2, voffA);
            PG8_WAIT_V(8); PG8_WAIT_L(0); PG8_BAR; PG8_MMA(1, 0, At, B0); PG8_MMA(1, 1, At, B1); PG8_BAR; PG8_SCHED;
            PG8_LDB(B0, 1, 0); PG8_LDB(B1, 1, 1); PG8_SCHED; PG8_LDA(At, 1, 0); PG8_STAGE(PG8_SA(0, 1), a2 + hstep, voffA);
            PG8_WAIT_V(8); PG8_WAIT_L(0); PG8_BAR; PG8_MMA(0, 0, At, B0); PG8_MMA(0, 1, At, B1); PG8_BAR; PG8_SCHED;
            PG8_LDA(At, 1, 1); PG8_STAGE(PG8_SB(1, 0), b3, voffB); PG8_STAGE(PG8_SB(1, 1), b3 + hstep, voffB); PG8_STAGE(PG8_SA(1, 0), a3, voffA);
            PG8_WAIT_V(8); PG8_WAIT_L(0); PG8_BAR; PG8_MMA(1, 0, At, B0); PG8_MMA(1, 1, At, B1); PG8_BAR; PG8_SCHED;
            } else {
            PG8_LDB(B0, 0, 0); PG8_SCHED; PG8_LDA(At, 0, 0); PG8_STAGE(PG8_SA(1, 1), a1 + hstep, voffA);
            PG8_WAIT_L(8); PG8_BAR; PG8_WAIT_L(0); PG8_MMA(0, 0, At, B0); PG8_BAR; PG8_SCHED;
            PG8_LDB(B1, 0, 1); PG8_STAGE(PG8_SB(0, 0), b2, voffB);
            PG8_BAR; PG8_WAIT_L(0); PG8_MMA(0, 1, At, B1); PG8_BAR;
            PG8_LDA(At, 0, 1); PG8_STAGE(PG8_SA(0, 0), a2, voffA);
            PG8_BAR; PG8_WAIT_L(0); PG8_MMA(1, 0, At, B0); PG8_BAR; PG8_SCHED;
            PG8_STAGE(PG8_SB(0, 1), b2 + hstep, voffB);
            PG8_WAIT_V(6); PG8_BAR; PG8_MMA(1, 1, At, B1); PG8_BAR;
            PG8_LDB(B0, 1, 0); PG8_SCHED; PG8_LDA(At, 1, 0); PG8_STAGE(PG8_SA(0, 1), a2 + hstep, voffA);
            PG8_WAIT_L(8); PG8_BAR; PG8_WAIT_L(0); PG8_MMA(0, 0, At, B0); PG8_BAR; PG8_SCHED;
            PG8_LDB(B1, 1, 1); PG8_STAGE(PG8_SB(1, 0), b3, voffB);
            PG8_BAR; PG8_WAIT_L(0); PG8_MMA(0, 1, At, B1); PG8_BAR;
            PG8_LDA(At, 1, 1); PG8_STAGE(PG8_SA(1, 0), a3, voffA);
            PG8_BAR; PG8_WAIT_L(0); PG8_MMA(1, 0, At, B0); PG8_BAR; PG8_SCHED;
            PG8_STAGE(PG8_SB(1, 1), b3 + hstep, voffB);
            PG8_WAIT_V(6); PG8_BAR; PG8_MMA(1, 1, At, B1); PG8_BAR;
            }
        }
        if constexpr (ALIGN_EPI) { if (wr == 0) PG8_BAR; }
        if constexpr (!Epi::AFTER_DRAIN) { E(acc, cur, wr, wc, fr, fq); S.done(cur); }
        if (!has_next) break;
#pragma unroll
        for (int a = 0; a < 2; ++a)
#pragma unroll
            for (int b = 0; b < 2; ++b)
#pragma unroll
                for (int m = 0; m < 4; ++m)
#pragma unroll
                    for (int n = 0; n < 2; ++n) acc[a][b][m][n] = (f32x4){0.f, 0.f, 0.f, 0.f};
        cur = nxt; cA = nA; cB = nB; ++ui;
        if constexpr (ALIGN_EPI) { if (wr == 1) PG8_BAR; }
    }
    PG8_WAIT_V(0);
    if constexpr (!ALIGN_EPI) { if (wr == 0) PG8_BAR; }
    PG8_BAR;
    if constexpr (Epi::AFTER_DRAIN) { E.fused(acc, cur, wr, wc, fr, fq, lds, wid, lane); S.done(cur); }
#undef PG8_SA
#undef PG8_SB
#undef PG8_STAGE
#undef PG8_LDA
#undef PG8_LDB
#undef PG8_MMA
#undef PG8_WAIT_V
#undef PG8_WAIT_L
#undef PG8_BAR
#undef PG8_SCHED
}
}

constexpr int NWAVES = 8, NTHREADS = 512;
constexpr int BATCH = 2, T = 8192, D = 1024, M = BATCH * T;
constexpr int SGF = 6144, SGW = 3072, SGC = 384;
constexpr int KD = 512, VD = 1024, DK = 128, DV = 256, GIN = 3088, GIN_PAD = 3328;
constexpr int FH = 2816;
constexpr int NITEM = (M / 64) * 4;
constexpr float EPS = 1e-6f;
static_assert(M == pg8::EM, "rows");

constexpr size_t MiB = 1u << 20;
constexpr size_t WS_WAIN = 1 * MiB, WS_WAOUT = 13 * MiB, WS_WGU0 = 19 * MiB, WS_WGU1 = 30 * MiB, WS_WDN0 = 41 * MiB, WS_WDN1 = 46 * MiB + MiB / 2;
constexpr size_t WS_WBIN = 52 * MiB, WS_WBOUT = 58 * MiB + MiB / 2, WS_WM = 60 * MiB + MiB / 2;
constexpr size_t WS_RU = 61 * MiB, WS_RV = 157 * MiB;
constexpr size_t WS_RSQ = 253 * MiB, WS_GZ = 253 * MiB + MiB / 2, WS_DEC = 254 * MiB + MiB / 2, WS_END = 256 * MiB;
constexpr int LDS_BYTES = 147456, RING_BYTES = 131072;

#define GAS __attribute__((address_space(1)))
#define LAS __attribute__((address_space(3)))
typedef unsigned short bf16;
typedef unsigned v4u __attribute__((ext_vector_type(4)));
typedef unsigned v2u __attribute__((ext_vector_type(2)));
typedef float f32x4 __attribute__((ext_vector_type(4)));
typedef float f32x2 __attribute__((ext_vector_type(2)));
typedef short bf16x8 __attribute__((ext_vector_type(8)));
typedef short s16x4 __attribute__((ext_vector_type(4)));
#define LDS_WAIT() asm volatile("s_waitcnt lgkmcnt(0)" ::: "memory")
__device__ __forceinline__ unsigned f2bf(float f) { unsigned u = __builtin_bit_cast(unsigned, f); return (u + 0x7fffu + ((u >> 16) & 1u)) >> 16; }
__device__ __forceinline__ unsigned pk2(float lo, float hi) { return pg8::cvt_pk_bf16(lo, hi); }
__device__ __forceinline__ float bf_lo(unsigned w) { return __builtin_bit_cast(float, w << 16); }
__device__ __forceinline__ float bf_hi(unsigned w) { return __builtin_bit_cast(float, w & 0xffff0000u); }
__device__ __forceinline__ float bf1(bf16 h) { return __builtin_bit_cast(float, (unsigned)h << 16); }
__device__ __forceinline__ float wave_sum(float v) {
#pragma unroll
    for (int o = 1; o < 64; o <<= 1) v += __shfl_xor(v, o);
    return v;
}
#ifndef USE_TR
#define USE_TR 1
#endif
__device__ __forceinline__ bf16x8 tr_frag(LAS unsigned char* tile, int pitch, int k0, int n0, int lane) {
#if USE_TR
    const int g = lane >> 4, q = (lane & 15) >> 2, p = lane & 3;
    LAS unsigned char* a0 = tile + (k0 + 8 * g + q) * pitch + (n0 + 4 * p) * 2;
    const s16x4 lo = __builtin_amdgcn_ds_read_tr16_b64_v4i16((LAS s16x4*)a0);
    const s16x4 hi = __builtin_amdgcn_ds_read_tr16_b64_v4i16((LAS s16x4*)(a0 + 4 * pitch));
    return (bf16x8){lo[0], lo[1], lo[2], lo[3], hi[0], hi[1], hi[2], hi[3]};
#else
    bf16x8 r; const int g = lane >> 4;
#pragma unroll
    for (int j = 0; j < 8; ++j) r[j] = *(LAS short*)(tile + (k0 + 8 * g + j) * pitch + (n0 + (lane & 15)) * 2);
    return r;
#endif
}
__device__ __forceinline__ bf16x8 tr_frag_p(LAS unsigned char* tile, int pitch, int k0, int nbase, int pstride, int lane) {
    const int g = lane >> 4, q = (lane & 15) >> 2, p = lane & 3;
    LAS unsigned char* a0 = tile + (k0 + 8 * g + q) * pitch + (nbase + pstride * p) * 2;
    const s16x4 lo = __builtin_amdgcn_ds_read_tr16_b64_v4i16((LAS s16x4*)a0);
    const s16x4 hi = __builtin_amdgcn_ds_read_tr16_b64_v4i16((LAS s16x4*)(a0 + 4 * pitch));
    return (bf16x8){lo[0], lo[1], lo[2], lo[3], hi[0], hi[1], hi[2], hi[3]};
}
#define MFMA16(a, b, c) __builtin_amdgcn_mfma_f32_16x16x32_bf16((a), (b), (c), 0, 0, 0)

__device__ __forceinline__ void p0_transpose_item(const float* W, int K, int N, bf16* WT, int drow0, const float* gain, LAS float* scr, int k0, int n0, int lane) {
    const int n = n0 + (lane & 31); float v[32];
#pragma unroll
    for (int i = 0; i < 32; ++i) { const int kk = 2 * i + (lane >> 5); v[i] = (n < N) ? W[(size_t)(k0 + kk) * N + n] : 0.f; }
    if (gain) {
#pragma unroll
        for (int i = 0; i < 32; ++i) v[i] *= gain[k0 + 2 * i + (lane >> 5)]; }
#pragma unroll
    for (int i = 0; i < 32; ++i) scr[(2 * i + (lane >> 5)) * 33 + (lane & 31)] = v[i];
    LDS_WAIT(); asm volatile("" ::: "memory");
    const int c = lane & 7;
#pragma unroll
    for (int j = 0; j < 4; ++j) { const int nn = (lane >> 3) + 8 * j; const LAS float* s = scr + (8 * c) * 33 + nn;
        v4u o; o.x = pk2(s[0 * 33], s[1 * 33]); o.y = pk2(s[2 * 33], s[3 * 33]); o.z = pk2(s[4 * 33], s[5 * 33]); o.w = pk2(s[6 * 33], s[7 * 33]);
        *(GAS v4u*)(WT + (size_t)(drow0 + nn) * K + k0 + 8 * c) = o; }
    LDS_WAIT(); asm volatile("" ::: "memory");
}

struct Args { const float* in[18]; float* out; unsigned char* ws; int ph_lo, ph_hi; };

__device__ __forceinline__ void p0_prologue(const Args& A, LAS unsigned char* lds, int gw, int NGW, int lane, int wave, int gtid, int NGT) {
    LAS float* scr = (LAS float*)(lds + wave * 16384);
    unsigned char* ws = A.ws;
    const float* mixn = A.in[1]; const float* ffnn = A.in[13];
    constexpr int I_AIN = 16 * 192, I_AOUT = 48 * 32, I_GU = 16 * 88, I_DN = 44 * 32, I_BIN = 16 * 97, I_BOUT = 16 * 32;
    constexpr int NITEMS = I_AIN + I_AOUT + 4 * I_GU + 2 * I_DN + I_BIN + I_BOUT;
    for (int it = gw; it < NITEMS; it += NGW) {
        int r = it;
        if (r < I_AIN) { const int kb = r / 192, nb = r % 192, n0 = 32 * nb, isv = n0 >= SGW, j0 = n0 - SGW * isv;
            p0_transpose_item(A.in[2], D, SGF, (bf16*)(ws + WS_WAIN), 256 * (j0 >> 7) + (j0 & 127) + 128 * isv, mixn, scr, 64 * kb, n0, lane); continue; } r -= I_AIN;
        if (r < I_AOUT) { const int kb = r / 32, nb = r % 32; p0_transpose_item(A.in[7], SGW, D, (bf16*)(ws + WS_WAOUT), 32 * nb, nullptr, scr, 64 * kb, 32 * nb, lane); continue; } r -= I_AOUT;
        if (r < 4 * I_GU) { const int l = r / (2 * I_GU), r2 = r % (2 * I_GU), up = r2 / I_GU, r3 = r2 % I_GU, kb = r3 / 88, nb = r3 % 88, n0 = 32 * nb;
            const float* W = (up ? A.in[15] : A.in[14]) + (size_t)l * D * FH;
            p0_transpose_item(W, D, FH, (bf16*)(ws + (l ? WS_WGU1 : WS_WGU0)), 256 * (n0 >> 7) + (n0 & 127) + 128 * up, ffnn + l * D, scr, 64 * kb, n0, lane); continue; } r -= 4 * I_GU;
        if (r < 2 * I_DN) { const int l = r / I_DN, r2 = r % I_DN, kb = r2 / 32, nb = r2 % 32;
            p0_transpose_item(A.in[16] + (size_t)l * FH * D, FH, D, (bf16*)(ws + (l ? WS_WDN1 : WS_WDN0)), 32 * nb, nullptr, scr, 64 * kb, 32 * nb, lane); continue; } r -= 2 * I_DN;
        if (r < I_BIN) { const int kb = r / 97, nb = r % 97; p0_transpose_item(A.in[8], D, GIN, (bf16*)(ws + WS_WBIN), 32 * nb, mixn + D, scr, 64 * kb, 32 * nb, lane); continue; } r -= I_BIN;
        { const int kb = r / 32, nb = r % 32; p0_transpose_item(A.in[12], D, D, (bf16*)(ws + WS_WBOUT), 32 * nb, nullptr, scr, 64 * kb, 32 * nb, lane); }
    }
    { GAS v4u* z = (GAS v4u*)(ws + WS_WBIN + (size_t)3104 * D * 2); const int nz = (GIN_PAD - 3104) * D * 2 / 16;
      for (int i = gtid; i < nz; i += NGT) z[i] = (v4u){0u, 0u, 0u, 0u}; }
    { const float* wsrc = A.in[5]; bf16* wm = (bf16*)(ws + WS_WM);
      for (int i = gtid; i < 8 * 128 * 128 / 2; i += NGT) { const int e = 2 * i, t = (e >> 7) & 127, s = e & 127; const bool keep = (t >= 64) || (s < 64);
          const f32x2 v = *(const f32x2*)(wsrc + e); ((GAS unsigned*)wm)[i] = keep ? pk2(v.x, v.y) : 0u; } }
    { const float* x = A.in[0]; bf16* xb0 = (bf16*)A.out; float* rsq = (float*)(ws + WS_RSQ);
      for (int m0 = gw; m0 < M; m0 += 4 * NGW) { f32x4 v[4][4];
#pragma unroll
          for (int r = 0; r < 4; ++r) { const int m = m0 + r * NGW; if (m < M) { const GAS f32x4* xr = (const GAS f32x4*)(x + (size_t)m * D) + lane;
#pragma unroll
              for (int j = 0; j < 4; ++j) v[r][j] = xr[64 * j]; } }
#pragma unroll
          for (int r = 0; r < 4; ++r) { const int m = m0 + r * NGW; if (m < M) { float s = 0.f;
#pragma unroll
              for (int j = 0; j < 4; ++j) s += (v[r][j].x * v[r][j].x + v[r][j].y * v[r][j].y) + (v[r][j].z * v[r][j].z + v[r][j].w * v[r][j].w);
              s = wave_sum(s);
              GAS v2u* o8 = (GAS v2u*)(xb0 + (size_t)m * D) + lane;
#pragma unroll
              for (int j = 0; j < 4; ++j) o8[64 * j] = (v2u){pk2(v[r][j].x, v[r][j].y), pk2(v[r][j].z, v[r][j].w)};
              if (lane == 0) *(f32x4*)(rsq + (size_t)m * 4) = (f32x4){s, 0.f, 0.f, 0.f}; } } } }
}

__device__ __forceinline__ void sgu_phase(LAS unsigned char* lds, const bf16* Wm, const bf16* V, bf16* UY, const f32x2* statP, const float* ln_g, const float* ln_b, const float* b_s,
                                          int G, int bid, int tid, int lane, int wid) {
    constexpr int PA = 272, BSZ = 34816;
    LAS unsigned char* As = lds;
    LAS f32x2* red = (LAS f32x2*)(lds + 3 * BSZ); LAS f32x2* murs = (LAS f32x2*)(lds + 3 * BSZ + 4096);
    const int wr = wid >> 2, wc = wid & 3, fr = lane & 15, fq = lane >> 4;
    const int ch = tid & 15, srow = tid >> 4;
#define SGU_C0(i) ((hh * 4 + (i) / 3) * SGC + ((i) % 3) * 128)
#define SGU_LOADV(i) do { const int c0_ = SGU_C0(i); _Pragma("unroll") for (int q_ = 0; q_ < 4; ++q_) vraw[q_] = *(const GAS v4u*)(V + (size_t)(row0 + srow + 32 * q_) * SGW + c0_ + 8 * ch); \
        lg0 = *(const f32x4*)(ln_g + c0_ + 8 * ch); lg1 = *(const f32x4*)(ln_g + c0_ + 8 * ch + 4); lb0 = *(const f32x4*)(ln_b + c0_ + 8 * ch); lb1 = *(const f32x4*)(ln_b + c0_ + 8 * ch + 4); } while (0)
#define SGU_LN(buf) do { LAS unsigned char* Bs_ = lds + BSZ + (buf) * BSZ; _Pragma("unroll") for (int q_ = 0; q_ < 4; ++q_) { const int s_ = srow + 32 * q_; const v4u raw = vraw[q_]; const f32x2 ms = murs[s_]; \
        const f32x4 a_ = (f32x4){bf_lo(raw.x), bf_hi(raw.x), bf_lo(raw.y), bf_hi(raw.y)}, b_ = (f32x4){bf_lo(raw.z), bf_hi(raw.z), bf_lo(raw.w), bf_hi(raw.w)}; \
        const f32x4 ya = (a_ - ms.x) * ms.y * lg0 + lb0, yb = (b_ - ms.x) * ms.y * lg1 + lb1; \
        *(LAS v4u*)(Bs_ + s_ * PA + ch * 16) = (v4u){pk2(ya[0], ya[1]), pk2(ya[2], ya[3]), pk2(yb[0], yb[1]), pk2(yb[2], yb[3])}; } } while (0)
#define SGU_STAGE_A(g) do { _Pragma("unroll") for (int q_ = 0; q_ < 4; ++q_) { const int id_ = tid + 512 * q_, r_ = id_ >> 4, c_ = id_ & 15; \
        *(LAS v4u*)(As + r_ * PA + c_ * 16) = *(const GAS v4u*)(Wm + (size_t)((g) * 128 + r_) * 128 + c_ * 8); } } while (0)
    for (int item = bid; item < 256; item += G) {
        const int w = item >> 1, hh = item & 1, row0 = w * 128;
        v4u vraw[4]; f32x4 lg0, lg1, lb0, lb1;
        SGU_LOADV(0);
        { const int r = tid & 127, part = tid >> 7; float s1 = 0.f, s2 = 0.f;
#pragma unroll
          for (int j = 0; j < 24; ++j) { const f32x2 p = statP[(size_t)(part * 24 + j) * M + row0 + r]; s1 += p.x; s2 += p.y; }
          red[part * 128 + r] = (f32x2){s1, s2}; }
        SGU_STAGE_A(hh * 4);
        __syncthreads();
        if (tid < 128) { const f32x2 a = red[tid], b = red[128 + tid], c = red[256 + tid], d = red[384 + tid];
            const float mean = ((a.x + b.x) + (c.x + d.x)) * (1.0f / 3072.0f), ex2 = ((a.y + b.y) + (c.y + d.y)) * (1.0f / 3072.0f);
            murs[tid] = (f32x2){mean, __builtin_amdgcn_rsqf(fmaxf(ex2 - mean * mean, 0.f) + EPS)}; }
        __syncthreads();
        SGU_LN(0);
        SGU_LOADV(1);
        for (int i = 0; i < 12; ++i) { const int g = hh * 4 + i / 3, c0 = SGU_C0(i);
            v4u uu[4]; float bs[4];
#pragma unroll
            for (int m = 0; m < 4; ++m) { const int t = wr * 64 + m * 16 + fr; bs[m] = b_s[g * 128 + t];
                uu[m] = *(const GAS v4u*)(UY + (size_t)(row0 + t) * SGW + c0 + wc * 32 + 8 * fq); }
            __syncthreads();
            LAS unsigned char* Bs = lds + BSZ + (i & 1) * BSZ;
            f32x4 acc[4][2];
#pragma unroll
            for (int m = 0; m < 4; ++m) { acc[m][0] = (f32x4){0.f, 0.f, 0.f, 0.f}; acc[m][1] = (f32x4){0.f, 0.f, 0.f, 0.f}; }
#pragma unroll
            for (int ks = 0; ks < 4; ++ks) { bf16x8 bfr[4];
#pragma unroll
                for (int m = 0; m < 4; ++m) bfr[m] = *(const LAS bf16x8*)(As + (wr * 64 + m * 16 + fr) * PA + (ks * 32 + fq * 8) * 2);
#pragma unroll
                for (int n = 0; n < 2; ++n) { const bf16x8 afr = tr_frag_p(Bs, PA, ks * 32, wc * 32 + 4 * n, 8, lane);
#pragma unroll
                    for (int m = 0; m < 4; ++m) acc[m][n] = MFMA16(afr, bfr[m], acc[m][n]); } }
            if (i + 1 < 12) {
                if ((i + 1) % 3 == 0) { __syncthreads(); SGU_STAGE_A(g + 1); }
                SGU_LN((i + 1) & 1);
                if (i + 2 < 12) SGU_LOADV(i + 2);
            }
#pragma unroll
            for (int m = 0; m < 4; ++m) { const int t = wr * 64 + m * 16 + fr; const v4u u4 = uu[m]; const f32x4 s0 = acc[m][0] + bs[m], s1 = acc[m][1] + bs[m];
                const f32x2 ga = pg8::gelu_pk((f32x2){bf_lo(u4.x), bf_hi(u4.x)}), gb = pg8::gelu_pk((f32x2){bf_lo(u4.y), bf_hi(u4.y)}), gc = pg8::gelu_pk((f32x2){bf_lo(u4.z), bf_hi(u4.z)}), gd = pg8::gelu_pk((f32x2){bf_lo(u4.w), bf_hi(u4.w)});
                *(GAS v4u*)(UY + (size_t)(row0 + t) * SGW + c0 + wc * 32 + 8 * fq) = (v4u){pk2(ga.x * s0[0], ga.y * s0[1]), pk2(gb.x * s0[2], gb.y * s0[3]), pk2(gc.x * s1[0], gc.y * s1[1]), pk2(gd.x * s1[2], gd.y * s1[3])}; }
        }
        __syncthreads();
    }
#undef SGU_C0
#undef SGU_LOADV
#undef SGU_LN
#undef SGU_STAGE_A
}

__device__ __forceinline__ float logsig16(float z) { return (fminf(z, 0.f) - __logf(1.0f + __expf(-fabsf(z)))) * (1.0f / 16.0f); }
constexpr int L_GZ = 0, L_TOT = 4096, L_GS = 8192, L_KT = 40960, L_QT = 58368, L_VT = 75776, L_PM = 109568, L_RED = 118784;
constexpr int PK = 272, PV = 528, PP = 144;
#define GLA_G(lds, pgz, w2, bg, tid) do { \
    LAS float* gzs_ = (LAS float*)((lds) + L_GZ); LAS float* tot_ = (LAS float*)((lds) + L_TOT); LAS float* Gs_ = (LAS float*)((lds) + L_GS); \
    if ((tid) < 256) *(LAS f32x4*)(gzs_ + 4 * (tid)) = (pgz); \
    const int kk_ = (tid) & 127, seg_ = (tid) >> 7; \
    __syncthreads(); \
    float run_ = 0.f, Gv_[16]; \
    _Pragma("unroll") for (int tt_ = 0; tt_ < 16; ++tt_) { const LAS f32x4* gr_ = (const LAS f32x4*)(gzs_ + (seg_ * 16 + tt_) * 16); float z_ = (bg); \
        _Pragma("unroll") for (int q_ = 0; q_ < 4; ++q_) { const f32x4 g4_ = gr_[q_]; z_ += g4_[0] * (w2)[4 * q_] + g4_[1] * (w2)[4 * q_ + 1] + g4_[2] * (w2)[4 * q_ + 2] + g4_[3] * (w2)[4 * q_ + 3]; } \
        run_ += logsig16(z_); Gv_[tt_] = run_; } \
    tot_[seg_ * 128 + kk_] = run_; \
    __syncthreads(); \
    { const float t0_ = tot_[kk_], t1_ = tot_[128 + kk_], t2_ = tot_[256 + kk_]; \
      const float pre_ = (seg_ > 0 ? t0_ : 0.f) + (seg_ > 1 ? t1_ : 0.f) + (seg_ > 2 ? t2_ : 0.f); \
      _Pragma("unroll") for (int tt_ = 0; tt_ < 16; ++tt_) Gs_[(seg_ * 16 + tt_) * 128 + kk_] = Gv_[tt_] + pre_; } \
    __syncthreads(); \
} while (0)
#define UNPK8(W_, lo4, hi4) do { const v4u w__ = (W_); lo4 = (f32x4){bf_lo(w__.x), bf_hi(w__.x), bf_lo(w__.y), bf_hi(w__.y)}; hi4 = (f32x4){bf_lo(w__.z), bf_hi(w__.z), bf_lo(w__.w), bf_hi(w__.w)}; } while (0)
__device__ __forceinline__ f32x4 exp4(f32x4 v) { return (f32x4){__expf(v[0]), __expf(v[1]), __expf(v[2]), __expf(v[3])}; }
__device__ __forceinline__ v4u pack8(f32x4 a, f32x4 b) { return (v4u){pk2(a[0], a[1]), pk2(a[2], a[3]), pk2(b[0], b[1]), pk2(b[2], b[3])}; }

__device__ __forceinline__ void gla_state_phase(LAS unsigned char* lds, const bf16* Kg, const bf16* Vg, const float* GZ, const float* w_g2, const float* b_g, bf16* dS, float* dec,
                                                int G, int bid, int tid, int lane, int wid) {
    const int fr = lane & 15, fq = lane >> 4, h = bid & 3;
    float w2[16];
#pragma unroll
    for (int r = 0; r < 16; ++r) w2[r] = w_g2[r * KD + h * DK + (tid & 127)];
    const float bg = b_g[h * DK + (tid & 127)];
    v4u pk_[2], pv_[4]; f32x4 pgz = (f32x4){0.f, 0.f, 0.f, 0.f};
#define P7_LOAD(it_) do { const int r0_ = ((it_) >> 2) * 64; if (tid < 256) pgz = *(const GAS f32x4*)(GZ + (size_t)r0_ * 16 + 4 * tid); \
        _Pragma("unroll") for (int j_ = 0; j_ < 2; ++j_) { const int id_ = tid + 512 * j_; pk_[j_] = *(const GAS v4u*)(Kg + (size_t)(r0_ + (id_ >> 4)) * KD + h * DK + 8 * (id_ & 15)); } \
        _Pragma("unroll") for (int j_ = 0; j_ < 4; ++j_) { const int id_ = tid + 512 * j_; pv_[j_] = *(const GAS v4u*)(Vg + (size_t)(r0_ + (id_ >> 5)) * VD + h * DV + 8 * (id_ & 31)); } } while (0)
    int item = bid;
    if (item < NITEM) P7_LOAD(item);
    for (; item < NITEM; item += G) {
        GLA_G(lds, pgz, w2, bg, tid);
        const LAS float* Gs = (const LAS float*)(lds + L_GS);
#pragma unroll
        for (int j = 0; j < 2; ++j) { const int id = tid + 512 * j, t = id >> 4, c8 = id & 15; f32x4 k0, k1; UNPK8(pk_[j], k0, k1);
            const f32x4 g0 = *(const LAS f32x4*)(Gs + t * 128 + 8 * c8), g1 = *(const LAS f32x4*)(Gs + t * 128 + 8 * c8 + 4), l0 = *(const LAS f32x4*)(Gs + 63 * 128 + 8 * c8), l1 = *(const LAS f32x4*)(Gs + 63 * 128 + 8 * c8 + 4);
            *(LAS v4u*)(lds + L_KT + t * PK + c8 * 16) = pack8(k0 * exp4(l0 - g0), k1 * exp4(l1 - g1)); }
#pragma unroll
        for (int j = 0; j < 4; ++j) { const int id = tid + 512 * j; *(LAS v4u*)(lds + L_VT + (id >> 5) * PV + (id & 31) * 16) = pv_[j]; }
        if (tid < 128) dec[(size_t)item * DK + tid] = __expf(Gs[63 * 128 + tid]);
        if (item + G < NITEM) P7_LOAD(item + G);
        __syncthreads();
        f32x4 acc[2][8];
#pragma unroll
        for (int d = 0; d < 2; ++d)
#pragma unroll
            for (int kt = 0; kt < 8; ++kt) acc[d][kt] = (f32x4){0.f, 0.f, 0.f, 0.f};
#pragma unroll
        for (int ks = 0; ks < 2; ++ks) { bf16x8 bfr[2];
#pragma unroll
            for (int d = 0; d < 2; ++d) bfr[d] = tr_frag_p(lds + L_VT, PV, ks * 32, 16 * (2 * wid + d), 4, lane);
#pragma unroll
            for (int kt = 0; kt < 8; ++kt) { const bf16x8 afr = tr_frag_p(lds + L_KT, PK, ks * 32, 32 * (kt >> 1) + 4 * (kt & 1), 8, lane);
#pragma unroll
                for (int d = 0; d < 2; ++d) acc[d][kt] = MFMA16(afr, bfr[d], acc[d][kt]); } }
#pragma unroll
        for (int d = 0; d < 2; ++d) { bf16* rowp = dS + (size_t)item * (DV * DK) + (size_t)(16 * (2 * wid + d) + fr) * DK + 8 * fq;
#pragma unroll
            for (int kp = 0; kp < 4; ++kp) *(GAS v4u*)(rowp + 32 * kp) = pack8(acc[d][2 * kp], acc[d][2 * kp + 1]); }
    }
#undef P7_LOAD
}

__device__ __forceinline__ void gla_scan_phase(bf16* dS, const float* dec, int gtid, int NGT) {
    for (int e = gtid; e < 8 * DV * DK / 2; e += NGT) {
        const int bh = e >> 14, rem = e & 16383, b = bh >> 2, h = bh & 3;
        GAS unsigned* p = (GAS unsigned*)(dS + ((size_t)(b * 128) * 4 + h) * (DV * DK)) + rem;
        const GAS f32x2* dp = (const GAS f32x2*)(dec + ((size_t)(b * 128) * 4 + h) * DK) + (rem & 63);
        float s0 = 0.f, s1 = 0.f;
        for (int n0 = 0; n0 < 128; n0 += 8) { unsigned d[8]; f32x2 dc[8];
#pragma unroll
            for (int j = 0; j < 8; ++j) { d[j] = p[(size_t)(n0 + j) * (2 * DV * DK)]; dc[j] = dp[(size_t)(n0 + j) * (2 * DK)]; }
#pragma unroll
            for (int j = 0; j < 8; ++j) { p[(size_t)(n0 + j) * (2 * DV * DK)] = pk2(s0, s1); s0 = s0 * dc[j].x + bf_lo(d[j]); s1 = s1 * dc[j].y + bf_hi(d[j]); } }
    }
}

__device__ __forceinline__ void gla_out_phase(LAS unsigned char* lds, const bf16* Qg, const bf16* Kg, const bf16* Vg, bf16* SROG, const float* GZ, const float* w_g2, const float* b_g, const float* gn_g,
                                              const bf16* Sprev, int G, int bid, int tid, int lane, int wid) {
    const int fr = lane & 15, fq = lane >> 4, h = bid & 3;
    LAS float* red = (LAS float*)(lds + L_RED);
    float w2[16];
#pragma unroll
    for (int r = 0; r < 16; ++r) w2[r] = w_g2[r * KD + h * DK + (tid & 127)];
    const float bg = b_g[h * DK + (tid & 127)];
    const int dvl = 32 * wid + 8 * fq;
    const f32x4 gn0 = *(const f32x4*)(gn_g + h * DV + dvl), gn1 = *(const f32x4*)(gn_g + h * DV + dvl + 4);
    v4u pq_[2], pk_[2], pv_[4]; f32x4 pgz = (f32x4){0.f, 0.f, 0.f, 0.f};
#define P9_LOAD(it_) do { const int r0_ = ((it_) >> 2) * 64; if (tid < 256) pgz = *(const GAS f32x4*)(GZ + (size_t)r0_ * 16 + 4 * tid); \
        _Pragma("unroll") for (int j_ = 0; j_ < 2; ++j_) { const int id_ = tid + 512 * j_; const size_t go_ = (size_t)(r0_ + (id_ >> 4)) * KD + h * DK + 8 * (id_ & 15); pq_[j_] = *(const GAS v4u*)(Qg + go_); pk_[j_] = *(const GAS v4u*)(Kg + go_); } \
        _Pragma("unroll") for (int j_ = 0; j_ < 4; ++j_) { const int id_ = tid + 512 * j_; pv_[j_] = *(const GAS v4u*)(Vg + (size_t)(r0_ + (id_ >> 5)) * VD + h * DV + 8 * (id_ & 31)); } } while (0)
    int item = bid;
    if (item < NITEM) P9_LOAD(item);
    for (; item < NITEM; item += G) {
        const int r0 = (item >> 2) * 64;
        bf16x8 sp[4][2]; v4u sr[4];
        { const int i = lane & 15; const bf16* sb = Sprev + (size_t)item * (DV * DK) + 8 * fq;
#pragma unroll
          for (int ks = 0; ks < 4; ++ks)
#pragma unroll
              for (int d = 0; d < 2; ++d) sp[ks][d] = *(const GAS bf16x8*)(sb + (size_t)(32 * wid + 8 * (i >> 2) + 4 * d + (i & 3)) * DK + 32 * ks); }
#pragma unroll
        for (int it = 0; it < 4; ++it) sr[it] = *(const GAS v4u*)(SROG + (size_t)(r0 + 16 * it + fr) * VD + h * DV + dvl);
        GLA_G(lds, pgz, w2, bg, tid);
        const LAS float* Gs = (const LAS float*)(lds + L_GS);
#pragma unroll
        for (int j = 0; j < 2; ++j) { const int id = tid + 512 * j, t = id >> 4, c8 = id & 15; f32x4 q0, q1, k0, k1; UNPK8(pq_[j], q0, q1); UNPK8(pk_[j], k0, k1);
            const f32x4 g0 = *(const LAS f32x4*)(Gs + t * 128 + 8 * c8), g1 = *(const LAS f32x4*)(Gs + t * 128 + 8 * c8 + 4);
            *(LAS v4u*)(lds + L_QT + t * PK + c8 * 16) = pack8(q0 * exp4(g0), q1 * exp4(g1));
            *(LAS v4u*)(lds + L_KT + t * PK + c8 * 16) = pack8(k0 * exp4(-g0), k1 * exp4(-g1)); }
#pragma unroll
        for (int j = 0; j < 4; ++j) { const int id = tid + 512 * j; *(LAS v4u*)(lds + L_VT + (id >> 5) * PV + (id & 31) * 16) = pv_[j]; }
        if (item + G < NITEM) P9_LOAD(item + G);
        __syncthreads();
        { const int it = wid >> 1;
#pragma unroll
          for (int jj = 0; jj < 2; ++jj) { const int jt = 2 * (wid & 1) + jj; f32x4 pa = (f32x4){0.f, 0.f, 0.f, 0.f};
#pragma unroll
              for (int ks = 0; ks < 4; ++ks) { const bf16x8 a = *(const LAS bf16x8*)(lds + L_KT + (16 * jt + fr) * PK + (32 * ks + 8 * fq) * 2), b = *(const LAS bf16x8*)(lds + L_QT + (16 * it + fr) * PK + (32 * ks + 8 * fq) * 2);
                  pa = MFMA16(a, b, pa); }
              const int i = 16 * it + fr, j0 = 16 * jt + 4 * fq;
              *(LAS v2u*)(lds + L_PM + i * PP + j0 * 2) = (v2u){pk2(j0 <= i ? pa[0] : 0.f, j0 + 1 <= i ? pa[1] : 0.f), pk2(j0 + 2 <= i ? pa[2] : 0.f, j0 + 3 <= i ? pa[3] : 0.f)}; } }
        __syncthreads();
        f32x4 acc[4][2];
#pragma unroll
        for (int it = 0; it < 4; ++it) { acc[it][0] = (f32x4){0.f, 0.f, 0.f, 0.f}; acc[it][1] = (f32x4){0.f, 0.f, 0.f, 0.f}; }
#pragma unroll
        for (int ks = 0; ks < 2; ++ks) { bf16x8 a[2];
#pragma unroll
            for (int d = 0; d < 2; ++d) a[d] = tr_frag_p(lds + L_VT, PV, ks * 32, 32 * wid + 4 * d, 8, lane);
#pragma unroll
            for (int it = 0; it < 4; ++it) { const bf16x8 b = *(const LAS bf16x8*)(lds + L_PM + (16 * it + fr) * PP + (32 * ks + 8 * fq) * 2);
#pragma unroll
                for (int d = 0; d < 2; ++d) acc[it][d] = MFMA16(a[d], b, acc[it][d]); } }
#pragma unroll
        for (int ks = 0; ks < 4; ++ks) {
#pragma unroll
            for (int it = 0; it < 4; ++it) { const bf16x8 b = *(const LAS bf16x8*)(lds + L_QT + (16 * it + fr) * PK + (32 * ks + 8 * fq) * 2);
#pragma unroll
                for (int d = 0; d < 2; ++d) acc[it][d] = MFMA16(sp[ks][d], b, acc[it][d]); } }
#pragma unroll
        for (int it = 0; it < 4; ++it) { float ss = 0.f;
#pragma unroll
            for (int d = 0; d < 2; ++d) ss += (acc[it][d][0] * acc[it][d][0] + acc[it][d][1] * acc[it][d][1]) + (acc[it][d][2] * acc[it][d][2] + acc[it][d][3] * acc[it][d][3]);
            ss += __shfl_xor(ss, 16); ss += __shfl_xor(ss, 32);
            if (fq == 0) red[wid * 64 + 16 * it + fr] = ss; }
        __syncthreads();
#pragma unroll
        for (int it = 0; it < 4; ++it) { const int i = 16 * it + fr; float tot = 0.f;
#pragma unroll
            for (int w8 = 0; w8 < 8; ++w8) tot += red[w8 * 64 + i];
            const float rms = __builtin_amdgcn_rsqf(tot * (1.0f / 256.0f) + EPS);
            f32x4 s0, s1; UNPK8(sr[it], s0, s1);
            *(GAS v4u*)(SROG + (size_t)(r0 + i) * VD + h * DV + dvl) = pack8(acc[it][0] * rms * gn0 * s0, acc[it][1] * rms * gn1 * s1); }
    }
#undef P9_LOAD
}

#define XB_TMO      128
#define XB_XCNT(j)  (256  + 64 * (j))
#define XB_XSUB(j)  (1280 + 64 * (j))
#define XB_XGEN(j)  (2304 + 64 * (j))
#define XB_TOP      3328
#define XB_TOPGEN   3392
#define XCD_BAR_WORDS 3456
#define XB_SPIN_CAP (1u << 18)

__device__ __forceinline__ unsigned xb_ld(unsigned* p)              { return __hip_atomic_load(p, __ATOMIC_RELAXED, __HIP_MEMORY_SCOPE_AGENT); }
__device__ __forceinline__ unsigned xb_add(unsigned* p, unsigned v) { return __hip_atomic_fetch_add(p, v, __ATOMIC_RELAXED, __HIP_MEMORY_SCOPE_AGENT); }
__device__ __forceinline__ unsigned xb_xcc_id() { return (unsigned)__builtin_amdgcn_s_getreg((3 << 11) | 20) & 0xFu; }
#define XB_SPIN(cond, bar) do { unsigned _sp = 0; while (cond) { __builtin_amdgcn_s_sleep(1); \
    if ((++_sp & 255u) == 0u) { if (xb_ld(&(bar)[XB_TMO])) break; if (_sp > XB_SPIN_CAP) { atomicAdd(&(bar)[XB_TMO], 1u); break; } } } } while (0)

struct XcdBarrier {
    unsigned* bar; unsigned x;
    volatile LAS unsigned* st;
};

__device__ __forceinline__ XcdBarrier xcd_barrier_post(unsigned* bar, volatile LAS unsigned* st) {
    XcdBarrier b; b.bar = bar; b.x = xb_xcc_id(); b.st = st;
    if (threadIdx.x == 0) (void)xb_add(&bar[XB_XCNT(b.x)], 1u);
    return b;
}
__device__ __forceinline__ void xcd_barrier_complete(unsigned* bar, unsigned x, unsigned& nloc, unsigned& nx) {
    const unsigned G = gridDim.x * gridDim.y * gridDim.z;
    unsigned sum, cnt, mine, sp = 0u;
    for (;;) {
        sum = 0u; cnt = 0u; mine = 0u;
#pragma unroll
        for (unsigned j = 0; j < 16; ++j) { const unsigned c = xb_ld(&bar[XB_XCNT(j)]); sum += c; cnt += (c > 0u) ? 1u : 0u; mine = (j == x) ? c : mine; }
        if (sum == G) break;
        __builtin_amdgcn_s_sleep(1);
        if ((++sp & 255u) == 0u) { if (xb_ld(&bar[XB_TMO])) break; if (sp > XB_SPIN_CAP) { atomicAdd(&bar[XB_TMO], 1u); break; } }
    }
    nloc = mine > 0u ? mine : 1u; nx = cnt > 0u ? cnt : 1u;
}

__device__ __forceinline__ void xcd_barrier(const XcdBarrier& b) {
    asm volatile("s_waitcnt vmcnt(0)" ::: "memory");
    __syncthreads();
    if (threadIdx.x == 0) {
        unsigned* bar = b.bar;
        __builtin_amdgcn_s_waitcnt(0);
        unsigned nloc = b.st[0], nx = b.st[1];
        if (nloc == 0u) { xcd_barrier_complete(bar, b.x, nloc, nx); b.st[0] = nloc; b.st[1] = nx; }
        const unsigned old = xb_add(&bar[XB_XSUB(b.x)], 1u);
        const unsigned gen = old / nloc;
        if (old + 1u == (gen + 1u) * nloc) {
            __builtin_amdgcn_fence(__ATOMIC_RELEASE, "agent");
            asm volatile("s_waitcnt vmcnt(0)" ::: "memory");
            const unsigned og = xb_add(&bar[XB_TOP], 1u);
            const unsigned tg = og / nx;
            if (og + 1u == (tg + 1u) * nx) xb_add(&bar[XB_TOPGEN], 1u);
            else XB_SPIN(xb_ld(&bar[XB_TOPGEN]) == tg, bar);
            __builtin_amdgcn_fence(__ATOMIC_ACQUIRE, "agent");
            xb_add(&bar[XB_XGEN(b.x)], 1u);
            asm volatile("s_waitcnt vmcnt(0)" ::: "memory");
        } else {
            XB_SPIN(xb_ld(&bar[XB_XGEN(b.x)]) == gen, bar);
            __builtin_amdgcn_fence(__ATOMIC_ACQUIRE, "agent");
            asm volatile("s_waitcnt vmcnt(0)" ::: "memory");
        }
    }
    __syncthreads();
}

constexpr int NPHASE = 14;
__global__ void __launch_bounds__(NTHREADS, 2) mk_fwd(Args args) {
    extern __shared__ __attribute__((aligned(16))) unsigned char lds_raw[];
    LAS unsigned char* lds = (LAS unsigned char*)lds_raw;
    cg::grid_group grid = cg::this_grid();
    const int tid = threadIdx.x, lane = tid & 63, wave = __builtin_amdgcn_readfirstlane(tid >> 6);
    const int G = gridDim.x, bid = blockIdx.x;
    const int vcu = (G % 8 == 0) ? (bid % 8) * (G / 8) + bid / 8 : bid;
    const int gw = vcu * NWAVES + wave, NGW = G * NWAVES, gtid = vcu * NTHREADS + tid, NGT = G * NTHREADS;
    unsigned char* ws = args.ws;
    const int lo = args.ph_lo, hi = args.ph_hi;
#define IN(k) (lo <= (k) && (k) < hi)
    if (tid < 64) ((LAS unsigned*)(lds + RING_BYTES))[tid] = 0u;
    __syncthreads();
    XcdBarrier bar; bar.bar = (unsigned*)ws; bar.x = 0; bar.st = nullptr;
    if (hi - lo > 1) bar = xcd_barrier_post((unsigned*)ws, (volatile LAS unsigned*)(lds + RING_BYTES) + 8);
#ifdef PROBE_K
#define STAMP(k) do { if (bid == 0 && tid == 0) ((unsigned long long*)(ws + 255 * MiB))[(k)] = __builtin_amdgcn_s_memrealtime(); } while (0)
#else
#define STAMP(k) do { } while (0)
#endif
#define SEAM(k) do { if (IN(k) && IN((k) + 1)) xcd_barrier(bar); STAMP((k) + 1); } while (0)
    STAMP(0);
    if (hi > 1000) grid.sync();
    float* X = args.out;
    float* rsq = (float*)(ws + WS_RSQ);
    bf16* XB = (bf16*)(ws + WS_RV);

    if (IN(0)) { p0_prologue(args, lds, gw, NGW, lane, wave, gtid, NGT); } SEAM(0);
    if (IN(1)) {
        pg8::Gemm g{(const bf16*)args.out, (const bf16*)(ws + WS_WAIN), M, SGF, D}; pg8::StaticOrder S; S.init(M, SGF, G, bid);
        pg8::EpiSguIn E{(bf16*)(ws + WS_RU), (bf16*)(ws + WS_RV), rsq, (pg8::f32x2*)((unsigned char*)args.out + 32 * MiB)};
        pg8::gemm_phase<pg8::EpiSguIn, pg8::StaticOrder, true, true>(lds, g, S, E);
    } SEAM(1);
    if (IN(2)) { sgu_phase(lds, (const bf16*)(ws + WS_WM), (const bf16*)(ws + WS_RV), (bf16*)(ws + WS_RU), (const f32x2*)((unsigned char*)args.out + 32 * MiB), args.in[3], args.in[4], args.in[6], G, vcu, tid, lane, wave); } SEAM(2);
    if (IN(3)) {
        pg8::Gemm g{(const bf16*)(ws + WS_RU), (const bf16*)(ws + WS_WAOUT), M, D, SGW}; pg8::StaticOrder S; S.init(M, D, G, bid);
        pg8::EpiResid<true> E{args.in[0], XB, rsq};
        pg8::gemm_phase<pg8::EpiResid<true>, pg8::StaticOrder, false, true>(lds, g, S, E);
    } SEAM(3);
    if (IN(4)) {
        pg8::Gemm g{XB, (const bf16*)(ws + WS_WGU0), M, 2 * FH, D}; pg8::StaticOrder S; S.init(M, 2 * FH, G, bid);
        pg8::EpiSwiGLU E{(bf16*)(ws + WS_RU), FH, rsq};
        pg8::gemm_phase<pg8::EpiSwiGLU, pg8::StaticOrder, true, true>(lds, g, S, E);
    } SEAM(4);
    if (IN(5)) {
        pg8::Gemm g{(const bf16*)(ws + WS_RU), (const bf16*)(ws + WS_WDN0), M, D, FH}; pg8::StaticOrder S; S.init(M, D, G, bid);
        pg8::EpiResid<false> E{XB, XB, rsq};
        pg8::gemm_phase<pg8::EpiResid<false>, pg8::StaticOrder, false, true>(lds, g, S, E);
    } SEAM(5);
    bf16* Qg = (bf16*)(ws + WS_RU); bf16* Kg = (bf16*)(ws + WS_RU + 16 * MiB); bf16* Vg = (bf16*)(ws + WS_RU + 32 * MiB); bf16* SR = (bf16*)(ws + WS_RU + 64 * MiB);
    bf16* dS = (bf16*)(ws + WS_RV + 32 * MiB); float* GZ = (float*)(ws + WS_GZ); float* dec = (float*)(ws + WS_DEC);
    if (IN(6)) {
        for (int rp = vcu * 4; rp < M / 16; rp += G * 4) { const int fr = lane & 15, fq = lane >> 4, rt = rp + (wave >> 1), kh = wave & 1;
            const bf16* ap = XB + (size_t)(rt * 16 + fr) * D + 512 * kh + 8 * fq; const bf16* bp = (const bf16*)(ws + WS_WBIN) + (size_t)(3072 + fr) * D + 512 * kh + 8 * fq;
            bf16x8 av[16], bv[16];
#pragma unroll
            for (int ks = 0; ks < 16; ++ks) { av[ks] = *(const GAS bf16x8*)(bp + 32 * ks); bv[ks] = *(const GAS bf16x8*)(ap + 32 * ks); }
            f32x4 c0 = (f32x4){0.f, 0.f, 0.f, 0.f}, c1 = c0;
#pragma unroll
            for (int ks = 0; ks < 16; ks += 2) { c0 = MFMA16(av[ks], bv[ks], c0); c1 = MFMA16(av[ks + 1], bv[ks + 1], c1); }
            c0 = c0 + c1;
            LAS f32x4* xch = (LAS f32x4*)lds + (wave >> 1) * 64 + lane;
            if (kh) *xch = c0;
            __syncthreads();
            if (!kh) *(GAS f32x4*)(GZ + (size_t)(rt * 16 + fr) * 16 + 4 * fq) = (c0 + *xch) * pg8::row_rs(rsq, rt * 16 + fr);
            __syncthreads(); }
        pg8::Gemm g{XB, (const bf16*)(ws + WS_WBIN), M, 3072, D}; pg8::StaticOrder S; S.init(M, 3072, G, bid);
        pg8::EpiGlaIn E{Qg, Kg, Vg, SR, GZ, rsq};
        pg8::gemm_phase<pg8::EpiGlaIn, pg8::StaticOrder, true, true>(lds, g, S, E);
    } SEAM(6);
    if (IN(7)) { gla_state_phase(lds, Kg, Vg, GZ, args.in[9], args.in[10], dS, dec, G, vcu, tid, lane, wave); } SEAM(7);
    if (IN(8)) { gla_scan_phase(dS, dec, gtid, NGT); } SEAM(8);
    if (IN(9)) { gla_out_phase(lds, Qg, Kg, Vg, SR, GZ, args.in[9], args.in[10], args.in[11], dS, G, vcu, tid, lane, wave); } SEAM(9);
    if (IN(10)) {
        pg8::Gemm g{SR, (const bf16*)(ws + WS_WBOUT), M, D, VD}; pg8::StaticOrder S; S.init(M, D, G, bid);
        pg8::EpiResid<false> E{XB, XB, rsq};
        pg8::gemm_phase<pg8::EpiResid<false>, pg8::StaticOrder, false, true>(lds, g, S, E);
    } SEAM(10);
    if (IN(11)) {
        pg8::Gemm g{XB, (const bf16*)(ws + WS_WGU1), M, 2 * FH, D}; pg8::StaticOrder S; S.init(M, 2 * FH, G, bid);
        pg8::EpiSwiGLU E{(bf16*)(ws + WS_RU), FH, rsq};
        pg8::gemm_phase<pg8::EpiSwiGLU, pg8::StaticOrder, true, true>(lds, g, S, E);
    } SEAM(11);
    if (IN(12)) {
        pg8::Gemm g{(const bf16*)(ws + WS_RU), (const bf16*)(ws + WS_WDN1), M, D, FH}; pg8::StaticOrder S; S.init(M, D, G, bid);
        pg8::EpiResid<false> E{XB, XB, rsq};
        pg8::gemm_phase<pg8::EpiResid<false>, pg8::StaticOrder, false, true>(lds, g, S, E);
    } SEAM(12);
    if (IN(13)) {
        const float* fg = args.in[17];
        f32x4 gv[4];
#pragma unroll
        for (int j = 0; j < 4; ++j) gv[j] = *(const f32x4*)(fg + 8 * lane + 512 * (j >> 1) + 4 * (j & 1));
        for (int m0 = gw; m0 < M; m0 += 8 * NGW) { v4u w[8][2]; float rs[8];
#pragma unroll
            for (int r = 0; r < 8; ++r) { const int m = m0 + r * NGW; if (m < M) { const GAS v4u* xr = (const GAS v4u*)(XB + (size_t)m * D) + lane; w[r][0] = xr[0]; w[r][1] = xr[64]; rs[r] = pg8::row_rs(rsq, m); } }
#pragma unroll
            for (int r = 0; r < 8; ++r) { const int m = m0 + r * NGW; if (m < M) { GAS f32x4* o = (GAS f32x4*)(X + (size_t)m * D) + 2 * lane;
#pragma unroll
                for (int hh = 0; hh < 2; ++hh) { const v4u q = w[r][hh];
                    o[128 * hh] = (f32x4){bf_lo(q.x), bf_hi(q.x), bf_lo(q.y), bf_hi(q.y)} * rs[r] * gv[2 * hh];
                    o[128 * hh + 1] = (f32x4){bf_lo(q.z), bf_hi(q.z), bf_lo(q.w), bf_hi(q.w)} * rs[r] * gv[2 * hh + 1]; } } } }
    }
#ifdef PROBE_K
    xcd_barrier(bar);
    if (bid == 0 && tid == 0) { const unsigned long long* ts = (const unsigned long long*)(ws + 255 * MiB); X[0] = (float)(ts[PROBE_K + 1] - ts[PROBE_K]) * 0.001f; }
#endif
#undef IN
#undef SEAM
}


__global__ void digest_k(const unsigned short* a, size_t na, const float* f, size_t nf, float* out) {
    const size_t n = (size_t)16384 * 1024;
    for (size_t i = (size_t)blockIdx.x * blockDim.x + threadIdx.x; i < n; i += (size_t)gridDim.x * blockDim.x) {
        float v = 0.f;
        for (size_t k = 0; k * n + i < na; ++k) v += __builtin_bit_cast(float, (unsigned)a[k * n + i] << 16);
        if (nf) v += f[i % nf];
        if (!(fabsf(v) < 1e30f)) v = 1e30f;
        out[i] = v;
    }
}
#ifndef MK_N_LAUNCHES
#define MK_N_LAUNCHES 1
#define DBG_NPH 14
#endif
extern "C" void kernel_launch(void* const* d_in, const int* in_sizes, int n_in, void* d_out, int out_size, void* d_ws, size_t ws_size, hipStream_t stream) {
    static int grid = 0;
    if (grid == 0) {
        if (n_in != 18 || in_sizes[0] != M * D || out_size != M * D || ws_size < WS_END) { fprintf(stderr, "kernel_launch: unexpected shapes (n_in %d, in0 %d, out %d, ws %zu); nothing launched\n", n_in, n_in > 0 ? in_sizes[0] : -1, out_size, ws_size); grid = -1; return; }
        int dev = 0, cus = 0, per_cu = 0;
        if (hipGetDevice(&dev) != hipSuccess || hipDeviceGetAttribute(&cus, hipDeviceAttributeMultiprocessorCount, dev) != hipSuccess) { grid = -1; return; }
        if (hipFuncSetAttribute((const void*)mk_fwd, hipFuncAttributeMaxDynamicSharedMemorySize, LDS_BYTES) != hipSuccess) { fprintf(stderr, "kernel_launch: hipFuncSetAttribute failed\n"); grid = -1; return; }
        if (hipOccupancyMaxActiveBlocksPerMultiprocessor(&per_cu, (const void*)mk_fwd, NTHREADS, LDS_BYTES) != hipSuccess || per_cu < 1) { fprintf(stderr, "kernel_launch: occupancy query gives %d blocks per CU\n", per_cu); (void)hipGetLastError(); grid = -1; return; }
        grid = cus;
        if (grid != 256) { fprintf(stderr, "kernel_launch: built for a 256-CU device (got %d)\n", cus); grid = -1; return; }
    }
    if (grid < 0) return;
    Args a{};
    for (int i = 0; i < 18; ++i) a.in[i] = (const float*)d_in[i];
    a.out = (float*)d_out; a.ws = (unsigned char*)d_ws;
#if MK_N_LAUNCHES == 1
    if (hipMemsetAsync(d_ws, 0, 16384, stream) != hipSuccess) { fprintf(stderr, "kernel_launch: memset of the barrier words failed\n"); return; }
    a.ph_lo = 0; a.ph_hi = NPHASE;
    void* kargs[] = {&a};
    hipError_t e = hipLaunchCooperativeKernel((const void*)mk_fwd, dim3(grid), dim3(NTHREADS), kargs, LDS_BYTES, stream);
    if (e != hipSuccess) fprintf(stderr, "kernel_launch: cooperative launch failed: %s\n", hipGetErrorString(e));
#else
    for (int p = 0; p < DBG_NPH; ++p) { a.ph_lo = p; a.ph_hi = p + 1; hipLaunchKernelGGL(mk_fwd, dim3(grid), dim3(NTHREADS), LDS_BYTES, stream, a); }
#ifdef DBG_DIG
    { unsigned char* w = (unsigned char*)d_ws; const size_t n16 = (size_t)16384 * 1024;
      const unsigned short* da = nullptr; size_t na = 0; const float* df = nullptr; size_t nf = 0;
      if (DBG_DIG == 6) { da = (const unsigned short*)(w + WS_RU); na = 3 * n16; df = (const float*)(w + WS_GZ); nf = 262144; }
      if (DBG_DIG == 7 || DBG_DIG == 8) { da = (const unsigned short*)(w + WS_RV + 32 * MiB); na = 2 * n16; df = (const float*)(w + WS_DEC); nf = 131072; }
      if (DBG_DIG == 9) { da = (const unsigned short*)(w + WS_RU + 64 * MiB); na = n16; }
      hipLaunchKernelGGL(digest_k, dim3(2048), dim3(256), 0, stream, da, na, df, nf, (float*)d_out); }
#endif
#endif
}
```

```cpp
#include <hip/hip_runtime.h>
#include <hip/hip_cooperative_groups.h>
#include <cstdio>
#include <cstdint>
namespace cg = cooperative_groups;
namespace pg8 {
#define PG8_LAS __attribute__((address_space(3)))
typedef unsigned short bf16_t;
typedef short bf16x8 __attribute__((ext_vector_type(8)));
typedef float f32x4 __attribute__((ext_vector_type(4)));
typedef unsigned u32x4 __attribute__((ext_vector_type(4)));
constexpr int BM = 256, BK = 64, HALF = 128, HTB = HALF * BK * 2  , STAGE_BYTES = 8 * HTB, NXCD = 8, WGM = 8;

__host__ __device__ __forceinline__ int lds_byte(int r, int c) { const int st = (r >> 4) * 2 + (c >> 5), rr = r & 15, cc = c & 31, ob = rr * 64 + cc * 2; return st * 1024 + (ob ^ (((ob >> 9) & 1) << 5)); }
__host__ __device__ __forceinline__ void stage_rc(int b, int& R, int& C) { const int st = b / 1024, sb = b % 1024, swz = sb ^ (((sb >> 9) & 1) << 5); R = (st >> 1) * 16 + swz / 64; C = (st & 1) * 32 + (swz % 64) / 2; }
__host__ __device__ __forceinline__ int perm32(int rho) { const int n = rho >> 4, i = rho & 15; return 8 * (i >> 2) + 4 * n + (i & 3); }

struct Unit { int pm, pn; };
struct Gemm { const bf16_t* A; const bf16_t* Bt; int M, N, K; };

struct StaticOrder {
    int nM, nN, nwg, G, c;
    __host__ __device__ void init(int M, int N, int G_, int c_) { nM = M / BM; nN = N / BM; nwg = nM * nN; G = G_; c = c_; }
    __host__ __device__ bool next(int i, Unit& u) const {
        const long L = (long)i * G + c; if (L >= nwg) return false;
        int wgid = (int)L; { const int q = nwg / NXCD, r = nwg % NXCD, xcd = wgid % NXCD, off = wgid / NXCD; wgid = (xcd < r ? xcd * (q + 1) : r * (q + 1) + (xcd - r) * q) + off; }
        const int nig = WGM * nN, gid = wgid / nig, fm = gid * WGM, gsz = (nM - fm) < WGM ? (nM - fm) : WGM;
        u.pm = fm + ((wgid % nig) % gsz); u.pn = (wgid % nig) / gsz; return true;
    }
    __device__ __forceinline__ void a_ready(const Unit&) const {}
    __device__ __forceinline__ void done(const Unit&) const {}
};

typedef float f32x2 __attribute__((ext_vector_type(2)));
typedef __bf16 bf16x2v __attribute__((ext_vector_type(2)));
__device__ __forceinline__ unsigned cvt_pk_bf16(float lo, float hi) { const bf16x2v r = __builtin_convertvector((f32x2){lo, hi}, bf16x2v); return __builtin_bit_cast(unsigned, r); }
__device__ __forceinline__ f32x2 gelu_pk(f32x2 v) {
    f32x2 a = __builtin_elementwise_abs(v); a.x = fminf(a.x, 6.0f); a.y = fminf(a.y, 6.0f);
    f32x2 p = a * 2.339709687609881e-05f + (-0.0006192482003406358f); p = p * a + 0.0072583738289044054f; p = p * a + (-0.051417680994680484f); p = p * a + (-0.46085568318627523f); p = p * a + (-1.1504893945481205f);
    p = p * a + (-1.0f);
    f32x2 t; t.x = __builtin_amdgcn_exp2f(p.x); t.y = __builtin_amdgcn_exp2f(p.y);
    const f32x2 m = v * t, r = v - m;
    f32x2 o; o.x = v.x < 0.f ? m.x : r.x; o.y = v.y < 0.f ? m.y : r.y; return o;
}

constexpr int EM = 16384;
constexpr float EEPS = 1e-6f;
__device__ __forceinline__ float row_rs(const float* rsq, int row) {
    const f32x4 p = *(const f32x4*)(rsq + (size_t)row * 4);
    return __builtin_amdgcn_rsqf(((p[0] + p[1]) + (p[2] + p[3])) * (1.0f / 1024.0f) + EEPS);
}
__device__ __forceinline__ float silu_f(float v) { return v * __builtin_amdgcn_rcpf(1.0f + __expf(-v)); }

struct EpiSguIn {
    static constexpr bool PERM = true, AFTER_DRAIN = false, RS_TABLE = true;
    bf16_t* U; bf16_t* V; const float* rsq; f32x2* statP; PG8_LAS float* tab;
    __device__ __forceinline__ void operator()(const f32x4 (&acc)[2][2][4][2], const Unit& u, int wr, int wc, int fr, int fq) const {
        const int colt = u.pn * HALF + wc * 32 + 8 * fq;
        const int row0 = u.pm * BM + wr * 64 + fr;
#pragma unroll
        for (int ai = 0; ai < 2; ++ai)
#pragma unroll
            for (int m = 0; m < 4; ++m) { const int row = row0 + ai * HALF + m * 16; const float rs = tab[row - u.pm * BM];
                { const f32x4 v0 = acc[ai][0][m][0] * rs, v1 = acc[ai][0][m][1] * rs;
                  u32x4 w; w.x = cvt_pk_bf16(v0[0], v0[1]); w.y = cvt_pk_bf16(v0[2], v0[3]); w.z = cvt_pk_bf16(v1[0], v1[1]); w.w = cvt_pk_bf16(v1[2], v1[3]);
                  *(u32x4*)(U + (size_t)row * 3072 + colt) = w; }
                { const f32x4 v0 = acc[ai][1][m][0] * rs, v1 = acc[ai][1][m][1] * rs;
                  const f32x2 a = gelu_pk((f32x2){v0[0], v0[1]}), b = gelu_pk((f32x2){v0[2], v0[3]}), c = gelu_pk((f32x2){v1[0], v1[1]}), d = gelu_pk((f32x2){v1[2], v1[3]});
                  float s1 = ((a.x + a.y) + (b.x + b.y)) + ((c.x + c.y) + (d.x + d.y));
                  float s2 = ((a.x * a.x + a.y * a.y) + (b.x * b.x + b.y * b.y)) + ((c.x * c.x + c.y * c.y) + (d.x * d.x + d.y * d.y));
                  u32x4 w; w.x = cvt_pk_bf16(a.x, a.y); w.y = cvt_pk_bf16(b.x, b.y); w.z = cvt_pk_bf16(c.x, c.y); w.w = cvt_pk_bf16(d.x, d.y);
                  *(u32x4*)(V + (size_t)row * 3072 + colt) = w;
                  s1 += __shfl_xor(s1, 16); s1 += __shfl_xor(s1, 32); s2 += __shfl_xor(s2, 16); s2 += __shfl_xor(s2, 32);
                  if (fq == 0) statP[(size_t)(u.pn * 4 + wc) * EM + row] = (f32x2){s1, s2}; } }
    }
};
struct EpiSwiGLU {
    static constexpr bool PERM = true, AFTER_DRAIN = false, RS_TABLE = true;
    bf16_t* Hd; int ldh; const float* rsq; PG8_LAS float* tab;
    __device__ __forceinline__ void operator()(const f32x4 (&acc)[2][2][4][2], const Unit& u, int wr, int wc, int fr, int fq) const {
        const int row0 = u.pm * BM + wr * 64 + fr, col0 = u.pn * HALF + wc * 32 + 8 * fq;
#pragma unroll
        for (int ai = 0; ai < 2; ++ai)
#pragma unroll
            for (int m = 0; m < 4; ++m) { const int row = row0 + ai * HALF + m * 16; const float rs = tab[row - u.pm * BM];
                const f32x4 g0 = acc[ai][0][m][0] * rs, g1 = acc[ai][0][m][1] * rs, u0 = acc[ai][1][m][0] * rs, u1 = acc[ai][1][m][1] * rs;
                u32x4 w; w.x = cvt_pk_bf16(silu_f(g0[0]) * u0[0], silu_f(g0[1]) * u0[1]); w.y = cvt_pk_bf16(silu_f(g0[2]) * u0[2], silu_f(g0[3]) * u0[3]);
                w.z = cvt_pk_bf16(silu_f(g1[0]) * u1[0], silu_f(g1[1]) * u1[1]); w.w = cvt_pk_bf16(silu_f(g1[2]) * u1[2], silu_f(g1[3]) * u1[3]);
                *(u32x4*)(Hd + (size_t)row * ldh + col0) = w; }
    }
};
struct EpiGlaIn {
    static constexpr bool PERM = true, AFTER_DRAIN = false, RS_TABLE = true;
    bf16_t* Q; bf16_t* Kk; bf16_t* Vv; bf16_t* SR; float* GZ; const float* rsq; PG8_LAS float* tab;
    __device__ __forceinline__ void operator()(const f32x4 (&acc)[2][2][4][2], const Unit& u, int wr, int wc, int fr, int fq) const {
        const int row0 = u.pm * BM + wr * 64 + fr, pn = u.pn;
        if (pn == 12) {
            if (wc == 0 && fq < 2) {
#pragma unroll
                for (int ai = 0; ai < 2; ++ai)
#pragma unroll
                    for (int m = 0; m < 4; ++m) { const int row = row0 + ai * HALF + m * 16; const float rs = tab[row - u.pm * BM];
                        float* p = GZ + (size_t)row * 16 + 8 * fq; *(f32x4*)p = acc[ai][0][m][0] * rs; *(f32x4*)(p + 4) = acc[ai][0][m][1] * rs; }
            }
            return;
        }
        bf16_t* base; int ld, colt; float sc = 1.f; const bool act = pn >= 8;
        if (pn < 2) { base = Q; ld = 512; colt = pn * BM; sc = 0.08838834764831845f; } else if (pn < 4) { base = Kk; ld = 512; colt = (pn - 2) * BM; }
        else if (pn < 8) { base = Vv; ld = 1024; colt = (pn - 4) * BM; } else { base = SR; ld = 1024; colt = (pn - 8) * BM; }
        colt += wc * 32 + 8 * fq;
#pragma unroll
        for (int ai = 0; ai < 2; ++ai)
#pragma unroll
            for (int m = 0; m < 4; ++m) { const int row = row0 + ai * HALF + m * 16; const float rs = tab[row - u.pm * BM] * sc;
                bf16_t* rowp = base + (size_t)row * ld + colt;
#pragma unroll
                for (int bj = 0; bj < 2; ++bj) { f32x4 v0 = acc[ai][bj][m][0] * rs, v1 = acc[ai][bj][m][1] * rs;
                    if (act) { v0 = (f32x4){silu_f(v0[0]), silu_f(v0[1]), silu_f(v0[2]), silu_f(v0[3])}; v1 = (f32x4){silu_f(v1[0]), silu_f(v1[1]), silu_f(v1[2]), silu_f(v1[3])}; }
                    u32x4 w; w.x = cvt_pk_bf16(v0[0], v0[1]); w.y = cvt_pk_bf16(v0[2], v0[3]); w.z = cvt_pk_bf16(v1[0], v1[1]); w.w = cvt_pk_bf16(v1[2], v1[3]);
                    *(u32x4*)(rowp + bj * HALF) = w; } }
    }
};
template <bool F32BASE> struct EpiResid {
    static constexpr bool PERM = true, AFTER_DRAIN = true, RS_TABLE = false;
    const void* base; bf16_t* xb; float* rsq;
    __device__ __forceinline__ void fused(f32x4 (&acc)[2][2][4][2], const Unit& u, int wr, int wc, int fr, int fq, PG8_LAS unsigned char* lds, int wid, int lane) const {
        PG8_LAS float* P = (PG8_LAS float*)lds;
        const int col0 = u.pn * BM + wc * 32 + 8 * fq;
#pragma unroll
        for (int ai = 0; ai < 2; ++ai)
#pragma unroll
            for (int m = 0; m < 4; ++m) { const int r = ai * HALF + wr * 64 + m * 16 + fr; const size_t off = (size_t)(u.pm * BM + r) * 1024 + col0; float ss = 0.f;
#pragma unroll
                for (int bj = 0; bj < 2; ++bj) { f32x4 b0, b1;
                    if (F32BASE) { const float* bp = (const float*)base + off + bj * HALF; b0 = *(const f32x4*)bp; b1 = *(const f32x4*)(bp + 4); }
                    else { const u32x4 w = *(const u32x4*)((const bf16_t*)base + off + bj * HALF);
                        b0 = (f32x4){__builtin_bit_cast(float, w.x << 16), __builtin_bit_cast(float, w.x & 0xffff0000u), __builtin_bit_cast(float, w.y << 16), __builtin_bit_cast(float, w.y & 0xffff0000u)};
                        b1 = (f32x4){__builtin_bit_cast(float, w.z << 16), __builtin_bit_cast(float, w.z & 0xffff0000u), __builtin_bit_cast(float, w.w << 16), __builtin_bit_cast(float, w.w & 0xffff0000u)}; }
                    const f32x4 o0 = b0 + acc[ai][bj][m][0], o1 = b1 + acc[ai][bj][m][1];
                    u32x4 w; w.x = cvt_pk_bf16(o0[0], o0[1]); w.y = cvt_pk_bf16(o0[2], o0[3]); w.z = cvt_pk_bf16(o1[0], o1[1]); w.w = cvt_pk_bf16(o1[2], o1[3]);
                    *(u32x4*)(xb + off + bj * HALF) = w;
                    ss += ((o0[0] * o0[0] + o0[1] * o0[1]) + (o0[2] * o0[2] + o0[3] * o0[3])) + ((o1[0] * o1[0] + o1[1] * o1[1]) + (o1[2] * o1[2] + o1[3] * o1[3])); }
                ss += __shfl_xor(ss, 16); ss += __shfl_xor(ss, 32);
                if (fq == 0) P[r * 4 + wc] = ss;
                if (m & 1) asm volatile("" ::: "memory"); }
        asm volatile("s_waitcnt lgkmcnt(0)" ::: "memory"); __builtin_amdgcn_s_barrier(); asm volatile("" ::: "memory");
        const int t = wid * 64 + lane;
        if (t < 256) { const f32x4 p = *(const PG8_LAS f32x4*)(P + t * 4); rsq[(size_t)(u.pm * BM + t) * 4 + u.pn] = (p[0] + p[1]) + (p[2] + p[3]); }
    }
};
template <class Epi, class Sched, bool ALIGN_EPI = false, bool SP2 = false>
__device__ __forceinline__ void gemm_phase(PG8_LAS unsigned char* lds, const Gemm g, const Sched& S, const Epi& E) {
    const int tid = threadIdx.x, wid = __builtin_amdgcn_readfirstlane(tid >> 6), lane = tid & 63, wr = wid >> 2, wc = wid & 3, fr = lane & 15, fq = lane >> 4;
    const int K = g.K, nt = K / BK;
    unsigned voffA[2], voffB[2];
#pragma unroll
    for (int i = 0; i < 2; ++i) { int R, C; stage_rc(tid * 16 + i * 8192, R, C); const int Rb = Epi::PERM ? ((R & ~31) + perm32(R & 31)) : R;
        voffA[i] = (unsigned)(R * K + C) * 2u; voffB[i] = (unsigned)(Rb * K + C) * 2u; }
    const size_t kstep = (size_t)(BK * 2);
    const size_t hstep = (size_t)HALF * K * 2;
    const size_t tstep = 2 * hstep;
    const unsigned ldsw = (unsigned)wid * 1024u;
    const int aoff = lds_byte(wr * 64 + fr, fq * 8), boff = lds_byte(wc * 32 + fr, fq * 8);
#define PG8_SA(b, h) (((b) * 2 + (h)) * HTB)
#define PG8_SB(b, h) ((4 + (b) * 2 + (h)) * HTB)
#define PG8_STAGE(bufoff, gbase, voff) do { _Pragma("unroll") for (int _i = 0; _i < 2; ++_i) \
        __builtin_amdgcn_global_load_lds((const unsigned*)((const char*)(gbase) + (voff)[_i]), (PG8_LAS unsigned*)(lds + (bufoff) + ldsw + _i * 8192), 16, 0, 0); } while (0)
#define PG8_LDA(dst, b, h) do { _Pragma("unroll") for (int m = 0; m < 4; ++m) _Pragma("unroll") for (int k = 0; k < 2; ++k) dst[m][k] = *(const PG8_LAS bf16x8*)(lds + PG8_SA(b, h) + aoff + m * 2048 + k * 1024); } while (0)
#define PG8_LDB(dst, b, h) do { _Pragma("unroll") for (int n = 0; n < 2; ++n) _Pragma("unroll") for (int k = 0; k < 2; ++k) dst[n][k] = *(const PG8_LAS bf16x8*)(lds + PG8_SB(b, h) + boff + n * 2048 + k * 1024); } while (0)
#define PG8_MMA(ai, bj, At, Bt) do { __builtin_amdgcn_s_setprio(1); _Pragma("unroll") for (int m = 0; m < 4; ++m) _Pragma("unroll") for (int n = 0; n < 2; ++n) _Pragma("unroll") for (int k = 0; k < 2; ++k) \
        acc[ai][bj][m][n] = __builtin_amdgcn_mfma_f32_16x16x32_bf16(Bt[n][k], At[m][k], acc[ai][bj][m][n], 0, 0, 0); __builtin_amdgcn_s_setprio(0); } while (0)
#define PG8_WAIT_V(n) asm volatile("s_waitcnt vmcnt(" #n ")" ::: "memory")
#define PG8_WAIT_L(n) asm volatile("s_waitcnt lgkmcnt(" #n ")" ::: "memory")
#define PG8_BAR __builtin_amdgcn_s_barrier()
#define PG8_SCHED __builtin_amdgcn_sched_barrier(0)
    Unit cur, nxt; int ui = 0;
    if (!S.next(0, cur)) return;
    f32x4 acc[2][2][4][2];
#pragma unroll
    for (int a = 0; a < 2; ++a)
#pragma unroll
        for (int b = 0; b < 2; ++b)
#pragma unroll
            for (int m = 0; m < 4; ++m)
#pragma unroll
                for (int n = 0; n < 2; ++n) acc[a][b][m][n] = (f32x4){0.f, 0.f, 0.f, 0.f};
    bf16x8 At[4][2], B0[2][2], B1[2][2];
    const char* cA = (const char*)g.A + (size_t)cur.pm * tstep; const char* cB = (const char*)g.Bt + (size_t)cur.pn * tstep;
    S.a_ready(cur);
    if constexpr (SP2) {
        PG8_STAGE(PG8_SB(0, 0), cB, voffB); PG8_STAGE(PG8_SB(0, 1), cB + hstep, voffB); PG8_STAGE(PG8_SA(0, 0), cA, voffA); PG8_STAGE(PG8_SA(0, 1), cA + hstep, voffA);
        if (wr == 1) PG8_BAR;
        PG8_WAIT_V(2); PG8_BAR;
        PG8_STAGE(PG8_SB(1, 0), cB + kstep, voffB); PG8_STAGE(PG8_SA(1, 0), cA + kstep, voffA); PG8_STAGE(PG8_SB(1, 1), cB + hstep + kstep, voffB);
        PG8_WAIT_V(6); PG8_BAR;
    } else {
        PG8_STAGE(PG8_SB(0, 0), cB, voffB); PG8_STAGE(PG8_SA(0, 0), cA, voffA); PG8_STAGE(PG8_SB(0, 1), cB + hstep, voffB); PG8_STAGE(PG8_SA(0, 1), cA + hstep, voffA);
        if (wr == 1) PG8_BAR;
        PG8_WAIT_V(4); PG8_BAR;
        PG8_STAGE(PG8_SB(1, 0), cB + kstep, voffB); PG8_STAGE(PG8_SA(1, 0), cA + kstep, voffA); PG8_STAGE(PG8_SB(1, 1), cB + hstep + kstep, voffB);
        PG8_WAIT_V(6); PG8_BAR;
    }
    for (;;) {
        const bool has_next = S.next(ui + 1, nxt);
        const char* nA = has_next ? (const char*)g.A + (size_t)nxt.pm * tstep : cA; const char* nB = has_next ? (const char*)g.Bt + (size_t)nxt.pn * tstep : cB;
        for (int t = 0; t < nt; t += 2) {
            const bool last = (t == nt - 2);
            const char* a1 = cA + (size_t)(t + 1) * kstep;
            const char* a2 = last ? nA : cA + (size_t)(t + 2) * kstep; const char* b2 = last ? nB : cB + (size_t)(t + 2) * kstep;
            const char* a3 = a2 + kstep; const char* b3 = b2 + kstep;
            if (last && has_next) S.a_ready(nxt);
            f32x4 rp_ = (f32x4){0.f, 0.f, 0.f, 0.f};
            if constexpr (Epi::RS_TABLE) { if (last && tid < 256) { const float* rq_ = E.rsq + (size_t)(cur.pm * BM + tid) * 4;
                asm volatile("global_load_dwordx4 %0, %1, off" : "=&v"(rp_) : "v"(rq_) : "memory"); } }
            if constexpr (SP2) {
            PG8_LDB(B0, 0, 0); PG8_LDB(B1, 0, 1); PG8_SCHED; PG8_LDA(At, 0, 0); PG8_STAGE(PG8_SA(1, 1), a1 + hstep, voffA);
            PG8_WAIT_V(8); PG8_WAIT_L(0); PG8_BAR; PG8_MMA(0, 0, At, B0); PG8_MMA(0, 1, At, B1); PG8_BAR; PG8_SCHED;
            PG8_LDA(At, 0, 1); PG8_STAGE(PG8_SB(0, 0), b2, voffB); PG8_STAGE(PG8_SB(0, 1), b2 + hstep, voffB); PG8_STAGE(PG8_SA(0, 0), a2, voffA);
            PG8_WAIT_V(8); PG8_WAIT_L(0); PG8_BAR; PG8_MMA(1, 0, At, B0); PG8_MMA(1, 1, At, B1); PG8_BAR; PG8_SCHED;
            PG8_LDB(B0, 1, 0); PG8_LDB(B1, 1, 1); PG8_SCHED; PG8_LDA(At, 1, 0); PG8_STAGE(PG8_SA(0, 1), a2 + hstep, voffA);
            PG8_WAIT_V(8); PG8_WAIT_L(0); PG8_BAR; PG8_MMA(0, 0, At, B0); PG8_MMA(0, 1, At, B1); PG8_BAR; PG8_SCHED;
            PG8_LDA(At, 1, 1); PG8_STAGE(PG8_SB(1, 0), b3, voffB); PG8_STAGE(PG8_SB(1, 1), b3 + hstep, voffB); PG8_STAGE(PG8_SA(1, 0), a3, voffA);
            PG8_WAIT_V(8); PG8_WAIT_L(0); PG8_BAR; PG8_MMA(1, 0, At, B0); PG8_MMA(1, 1, At, B1); PG8_BAR; PG8_SCHED;
            } else {
            PG8_LDB(B0, 0, 0); PG8_SCHED; PG8_LDA(At, 0, 0); PG8_STAGE(PG8_SA(1, 1), a1 + hstep, voffA);
            PG8_WAIT_L(8); PG8_BAR; PG8_WAIT_L(0); PG8_MMA(0, 0, At, B0); PG8_BAR; PG8_SCHED;
            PG8_LDB(B1, 0, 1); PG8_STAGE(PG8_SB(0, 0), b2, voffB);
            PG8_BAR; PG8_WAIT_L(0); PG8_MMA(0, 1, At, B1); PG8_BAR;
            PG8_LDA(At, 0, 1); PG8_STAGE(PG8_SA(0, 0), a2, voffA);
            PG8_BAR; PG8_WAIT_L(0); PG8_MMA(1, 0, At, B0); PG8_BAR; PG8_SCHED;
            PG8_STAGE(PG8_SB(0, 1), b2 + hstep, voffB);
            PG8_WAIT_V(6); PG8_BAR; PG8_MMA(1, 1, At, B1); PG8_BAR;
            PG8_LDB(B0, 1, 0); PG8_SCHED; PG8_LDA(At, 1, 0); PG8_STAGE(PG8_SA(0, 1), a2 + hstep, voffA);
            PG8_WAIT_L(8); PG8_BAR; PG8_WAIT_L(0); PG8_MMA(0, 0, At, B0); PG8_BAR; PG8_SCHED;
            PG8_LDB(B1, 1, 1); PG8_STAGE(PG8_SB(1, 0), b3, voffB);
            PG8_BAR; PG8_WAIT_L(0); PG8_MMA(0, 1, At, B1); PG8_BAR;
            PG8_LDA(At, 1, 1); PG8_STAGE(PG8_SA(1, 0), a3, voffA);
            PG8_BAR; PG8_WAIT_L(0); PG8_MMA(1, 0, At, B0); PG8_BAR; PG8_SCHED;
            PG8_STAGE(PG8_SB(1, 1), b3 + hstep, voffB);
            PG8_WAIT_V(6); PG8_BAR; PG8_MMA(1, 1, At, B1); PG8_BAR;
            }
            if constexpr (Epi::RS_TABLE) { if (last && tid < 256) { asm volatile("" : "+v"(rp_) :: "memory"); E.tab[tid] = __builtin_amdgcn_rsqf(((rp_[0] + rp_[1]) + (rp_[2] + rp_[3])) * (1.0f / 1024.0f) + 1e-6f); PG8_WAIT_L(0); } }
        }
        if constexpr (ALIGN_EPI) { if (wr == 0) PG8_BAR; }
        if constexpr (!Epi::AFTER_DRAIN) { E(acc, cur, wr, wc, fr, fq); S.done(cur); }
        if (!has_next) break;
#pragma unroll
        for (int a = 0; a < 2; ++a)
#pragma unroll
            for (int b = 0; b < 2; ++b)
#pragma unroll
                for (int m = 0; m < 4; ++m)
#pragma unroll
                    for (int n = 0; n < 2; ++n) acc[a][b][m][n] = (f32x4){0.f, 0.f, 0.f, 0.f};
        cur = nxt; cA = nA; cB = nB; ++ui;
        if constexpr (ALIGN_EPI) { if (wr == 1) PG8_BAR; }
    }
    PG8_WAIT_V(0);
    if constexpr (!ALIGN_EPI) { if (wr == 0) PG8_BAR; }
    PG8_BAR;
    if constexpr (Epi::AFTER_DRAIN) { E.fused(acc, cur, wr, wc, fr, fq, lds, wid, lane); S.done(cur); }
#undef PG8_SA
#undef PG8_SB
#undef PG8_STAGE
#undef PG8_LDA
#undef PG8_LDB
#undef PG8_MMA
#undef PG8_WAIT_V
#undef PG8_WAIT_L
#undef PG8_BAR
#undef PG8_SCHED
}
}

constexpr int NWAVES = 8, NTHREADS = 512;
constexpr int BATCH = 2, T = 8192, D = 1024, M = BATCH * T;
constexpr int SGF = 6144, SGW = 3072, SGC = 384;
constexpr int KD = 512, VD = 1024, DK = 128, DV = 256, GIN = 3088, GIN_PAD = 3328;
constexpr int FH = 2816;
constexpr int NITEM = (M / 64) * 4;
constexpr float EPS = 1e-6f;
static_assert(M == pg8::EM, "rows");

constexpr size_t MiB = 1u << 20;
constexpr size_t WS_WAIN = 1 * MiB, WS_WAOUT = 13 * MiB, WS_WGU0 = 19 * MiB, WS_WGU1 = 30 * MiB, WS_WDN0 = 41 * MiB, WS_WDN1 = 46 * MiB + MiB / 2;
constexpr size_t WS_WBIN = 52 * MiB, WS_WBOUT = 58 * MiB + MiB / 2, WS_WM = 60 * MiB + MiB / 2;
constexpr size_t WS_RU = 61 * MiB, WS_RV = 157 * MiB;
constexpr size_t WS_RSQ = 253 * MiB, WS_GZ = 253 * MiB + MiB / 2, WS_DEC = 254 * MiB + MiB / 2, WS_END = 256 * MiB;
constexpr int LDS_BYTES = 147456, RING_BYTES = 131072;

#define GAS __attribute__((address_space(1)))
#define LAS __attribute__((address_space(3)))
typedef unsigned short bf16;
typedef unsigned v4u __attribute__((ext_vector_type(4)));
typedef unsigned v2u __attribute__((ext_vector_type(2)));
typedef float f32x4 __attribute__((ext_vector_type(4)));
typedef float f32x2 __attribute__((ext_vector_type(2)));
typedef short bf16x8 __attribute__((ext_vector_type(8)));
typedef short s16x4 __attribute__((ext_vector_type(4)));
#define LDS_WAIT() asm volatile("s_waitcnt lgkmcnt(0)" ::: "memory")
__device__ __forceinline__ unsigned f2bf(float f) { unsigned u = __builtin_bit_cast(unsigned, f); return (u + 0x7fffu + ((u >> 16) & 1u)) >> 16; }
__device__ __forceinline__ unsigned pk2(float lo, float hi) { return pg8::cvt_pk_bf16(lo, hi); }
__device__ __forceinline__ float bf_lo(unsigned w) { return __builtin_bit_cast(float, w << 16); }
__device__ __forceinline__ float bf_hi(unsigned w) { return __builtin_bit_cast(float, w & 0xffff0000u); }
__device__ __forceinline__ float bf1(bf16 h) { return __builtin_bit_cast(float, (unsigned)h << 16); }
__device__ __forceinline__ float wave_sum(float v) {
#pragma unroll
    for (int o = 1; o < 64; o <<= 1) v += __shfl_xor(v, o);
    return v;
}
#ifndef USE_TR
#define USE_TR 1
#endif
__device__ __forceinline__ bf16x8 tr_frag(LAS unsigned char* tile, int pitch, int k0, int n0, int lane) {
#if USE_TR
    const int g = lane >> 4, q = (lane & 15) >> 2, p = lane & 3;
    LAS unsigned char* a0 = tile + (k0 + 8 * g + q) * pitch + (n0 + 4 * p) * 2;
    const s16x4 lo = __builtin_amdgcn_ds_read_tr16_b64_v4i16((LAS s16x4*)a0);
    const s16x4 hi = __builtin_amdgcn_ds_read_tr16_b64_v4i16((LAS s16x4*)(a0 + 4 * pitch));
    return (bf16x8){lo[0], lo[1], lo[2], lo[3], hi[0], hi[1], hi[2], hi[3]};
#else
    bf16x8 r; const int g = lane >> 4;
#pragma unroll
    for (int j = 0; j < 8; ++j) r[j] = *(LAS short*)(tile + (k0 + 8 * g + j) * pitch + (n0 + (lane & 15)) * 2);
    return r;
#endif
}
__device__ __forceinline__ bf16x8 tr_frag_p(LAS unsigned char* tile, int pitch, int k0, int nbase, int pstride, int lane) {
    const int g = lane >> 4, q = (lane & 15) >> 2, p = lane & 3;
    LAS unsigned char* a0 = tile + (k0 + 8 * g + q) * pitch + (nbase + pstride * p) * 2;
    const s16x4 lo = __builtin_amdgcn_ds_read_tr16_b64_v4i16((LAS s16x4*)a0);
    const s16x4 hi = __builtin_amdgcn_ds_read_tr16_b64_v4i16((LAS s16x4*)(a0 + 4 * pitch));
    return (bf16x8){lo[0], lo[1], lo[2], lo[3], hi[0], hi[1], hi[2], hi[3]};
}
#define MFMA16(a, b, c) __builtin_amdgcn_mfma_f32_16x16x32_bf16((a), (b), (c), 0, 0, 0)

__device__ __forceinline__ void p0_transpose_item(const float* W, int K, int N, bf16* WT, int drow0, const float* gain, LAS float* scr, int k0, int n0, int lane) {
    const int n = n0 + (lane & 31); float v[32];
#pragma unroll
    for (int i = 0; i < 32; ++i) { const int kk = 2 * i + (lane >> 5); v[i] = (n < N) ? W[(size_t)(k0 + kk) * N + n] : 0.f; }
    if (gain) {
#pragma unroll
        for (int i = 0; i < 32; ++i) v[i] *= gain[k0 + 2 * i + (lane >> 5)]; }
#pragma unroll
    for (int i = 0; i < 32; ++i) scr[(2 * i + (lane >> 5)) * 33 + (lane & 31)] = v[i];
    LDS_WAIT(); asm volatile("" ::: "memory");
    const int c = lane & 7;
#pragma unroll
    for (int j = 0; j < 4; ++j) { const int nn = (lane >> 3) + 8 * j; const LAS float* s = scr + (8 * c) * 33 + nn;
        v4u o; o.x = pk2(s[0 * 33], s[1 * 33]); o.y = pk2(s[2 * 33], s[3 * 33]); o.z = pk2(s[4 * 33], s[5 * 33]); o.w = pk2(s[6 * 33], s[7 * 33]);
        *(GAS v4u*)(WT + (size_t)(drow0 + nn) * K + k0 + 8 * c) = o; }
    LDS_WAIT(); asm volatile("" ::: "memory");
}

struct Args { const float* in[18]; float* out; unsigned char* ws; int ph_lo, ph_hi; };

__device__ __forceinline__ void p0_prologue(const Args& A, LAS unsigned char* lds, int gw, int NGW, int lane, int wave, int gtid, int NGT) {
    LAS float* scr = (LAS float*)(lds + wave * 16384);
    unsigned char* ws = A.ws;
    const float* mixn = A.in[1]; const float* ffnn = A.in[13];
    constexpr int I_AIN = 16 * 192, I_AOUT = 48 * 32, I_GU = 16 * 88, I_DN = 44 * 32, I_BIN = 16 * 97, I_BOUT = 16 * 32;
    constexpr int NITEMS = I_AIN + I_AOUT + 4 * I_GU + 2 * I_DN + I_BIN + I_BOUT;
    for (int it = gw; it < NITEMS; it += NGW) {
        int r = it;
        if (r < I_AIN) { const int kb = r / 192, nb = r % 192, n0 = 32 * nb, isv = n0 >= SGW, j0 = n0 - SGW * isv;
            p0_transpose_item(A.in[2], D, SGF, (bf16*)(ws + WS_WAIN), 256 * (j0 >> 7) + (j0 & 127) + 128 * isv, mixn, scr, 64 * kb, n0, lane); continue; } r -= I_AIN;
        if (r < I_AOUT) { const int kb = r / 32, nb = r % 32; p0_transpose_item(A.in[7], SGW, D, (bf16*)(ws + WS_WAOUT), 32 * nb, nullptr, scr, 64 * kb, 32 * nb, lane); continue; } r -= I_AOUT;
        if (r < 4 * I_GU) { const int l = r / (2 * I_GU), r2 = r % (2 * I_GU), up = r2 / I_GU, r3 = r2 % I_GU, kb = r3 / 88, nb = r3 % 88, n0 = 32 * nb;
            const float* W = (up ? A.in[15] : A.in[14]) + (size_t)l * D * FH;
            p0_transpose_item(W, D, FH, (bf16*)(ws + (l ? WS_WGU1 : WS_WGU0)), 256 * (n0 >> 7) + (n0 & 127) + 128 * up, ffnn + l * D, scr, 64 * kb, n0, lane); continue; } r -= 4 * I_GU;
        if (r < 2 * I_DN) { const int l = r / I_DN, r2 = r % I_DN, kb = r2 / 32, nb = r2 % 32;
            p0_transpose_item(A.in[16] + (size_t)l * FH * D, FH, D, (bf16*)(ws + (l ? WS_WDN1 : WS_WDN0)), 32 * nb, nullptr, scr, 64 * kb, 32 * nb, lane); continue; } r -= 2 * I_DN;
        if (r < I_BIN) { const int kb = r / 97, nb = r % 97; p0_transpose_item(A.in[8], D, GIN, (bf16*)(ws + WS_WBIN), 32 * nb, mixn + D, scr, 64 * kb, 32 * nb, lane); continue; } r -= I_BIN;
        { const int kb = r / 32, nb = r % 32; p0_transpose_item(A.in[12], D, D, (bf16*)(ws + WS_WBOUT), 32 * nb, nullptr, scr, 64 * kb, 32 * nb, lane); }
    }
    { GAS v4u* z = (GAS v4u*)(ws + WS_WBIN + (size_t)3104 * D * 2); const int nz = (GIN_PAD - 3104) * D * 2 / 16;
      for (int i = gtid; i < nz; i += NGT) z[i] = (v4u){0u, 0u, 0u, 0u}; }
    { const float* wsrc = A.in[5]; bf16* wm = (bf16*)(ws + WS_WM);
      for (int i = gtid; i < 8 * 128 * 128 / 2; i += NGT) { const int e = 2 * i, t = (e >> 7) & 127, s = e & 127; const bool keep = (t >= 64) || (s < 64);
          const f32x2 v = *(const f32x2*)(wsrc + e); ((GAS unsigned*)wm)[i] = keep ? pk2(v.x, v.y) : 0u; } }
    { const float* x = A.in[0]; bf16* xb0 = (bf16*)A.out; float* rsq = (float*)(ws + WS_RSQ);
      for (int m0 = gw; m0 < M; m0 += 4 * NGW) { f32x4 v[4][4];
#pragma unroll
          for (int r = 0; r < 4; ++r) { const int m = m0 + r * NGW; if (m < M) { const GAS f32x4* xr = (const GAS f32x4*)(x + (size_t)m * D) + lane;
#pragma unroll
              for (int j = 0; j < 4; ++j) v[r][j] = xr[64 * j]; } }
#pragma unroll
          for (int r = 0; r < 4; ++r) { const int m = m0 + r * NGW; if (m < M) { float s = 0.f;
#pragma unroll
              for (int j = 0; j < 4; ++j) s += (v[r][j].x * v[r][j].x + v[r][j].y * v[r][j].y) + (v[r][j].z * v[r][j].z + v[r][j].w * v[r][j].w);
              s = wave_sum(s);
              GAS v2u* o8 = (GAS v2u*)(xb0 + (size_t)m * D) + lane;
#pragma unroll
              for (int j = 0; j < 4; ++j) o8[64 * j] = (v2u){pk2(v[r][j].x, v[r][j].y), pk2(v[r][j].z, v[r][j].w)};
              if (lane == 0) *(f32x4*)(rsq + (size_t)m * 4) = (f32x4){s, 0.f, 0.f, 0.f}; } } } }
}

__device__ __forceinline__ void sgu_phase(LAS unsigned char* lds, const bf16* Wm, const bf16* V, bf16* UY, const f32x2* statP, const float* ln_g, const float* ln_b, const float* b_s,
                                          int G, int bid, int tid, int lane, int wid) {
    constexpr int PA = 272, BSZ = 34816;
    LAS unsigned char* As = lds;
    LAS f32x2* red = (LAS f32x2*)(lds + 3 * BSZ); LAS f32x2* murs = (LAS f32x2*)(lds + 3 * BSZ + 4096);
    const int wr = wid >> 2, wc = wid & 3, fr = lane & 15, fq = lane >> 4;
    const int ch = tid & 15, srow = tid >> 4;
#define SGU_C0(i) ((hh * 4 + (i) / 3) * SGC + ((i) % 3) * 128)
#define SGU_LOADV(i) do { const int c0_ = SGU_C0(i); _Pragma("unroll") for (int q_ = 0; q_ < 4; ++q_) vraw[q_] = *(const GAS v4u*)(V + (size_t)(row0 + srow + 32 * q_) * SGW + c0_ + 8 * ch); \
        lg0 = *(const f32x4*)(ln_g + c0_ + 8 * ch); lg1 = *(const f32x4*)(ln_g + c0_ + 8 * ch + 4); lb0 = *(const f32x4*)(ln_b + c0_ + 8 * ch); lb1 = *(const f32x4*)(ln_b + c0_ + 8 * ch + 4); } while (0)
#define SGU_LN(buf) do { LAS unsigned char* Bs_ = lds + BSZ + (buf) * BSZ; _Pragma("unroll") for (int q_ = 0; q_ < 4; ++q_) { const int s_ = srow + 32 * q_; const v4u raw = vraw[q_]; const f32x2 ms = murs[s_]; \
        const f32x4 a_ = (f32x4){bf_lo(raw.x), bf_hi(raw.x), bf_lo(raw.y), bf_hi(raw.y)}, b_ = (f32x4){bf_lo(raw.z), bf_hi(raw.z), bf_lo(raw.w), bf_hi(raw.w)}; \
        const f32x4 ya = (a_ - ms.x) * ms.y * lg0 + lb0, yb = (b_ - ms.x) * ms.y * lg1 + lb1; \
        *(LAS v4u*)(Bs_ + s_ * PA + ch * 16) = (v4u){pk2(ya[0], ya[1]), pk2(ya[2], ya[3]), pk2(yb[0], yb[1]), pk2(yb[2], yb[3])}; } } while (0)
#define SGU_STAGE_A(g) do { _Pragma("unroll") for (int q_ = 0; q_ < 4; ++q_) { const int id_ = tid + 512 * q_, r_ = id_ >> 4, c_ = id_ & 15; \
        *(LAS v4u*)(As + r_ * PA + c_ * 16) = *(const GAS v4u*)(Wm + (size_t)((g) * 128 + r_) * 128 + c_ * 8); } } while (0)
    for (int item = bid; item < 256; item += G) {
        const int w = item >> 1, hh = item & 1, row0 = w * 128;
        v4u vraw[4]; f32x4 lg0, lg1, lb0, lb1;
        SGU_LOADV(0);
        { const int r = tid & 127, part = tid >> 7; float s1 = 0.f, s2 = 0.f;
#pragma unroll
          for (int j = 0; j < 24; ++j) { const f32x2 p = statP[(size_t)(part * 24 + j) * M + row0 + r]; s1 += p.x; s2 += p.y; }
          red[part * 128 + r] = (f32x2){s1, s2}; }
        SGU_STAGE_A(hh * 4);
        __syncthreads();
        if (tid < 128) { const f32x2 a = red[tid], b = red[128 + tid], c = red[256 + tid], d = red[384 + tid];
            const float mean = ((a.x + b.x) + (c.x + d.x)) * (1.0f / 3072.0f), ex2 = ((a.y + b.y) + (c.y + d.y)) * (1.0f / 3072.0f);
            murs[tid] = (f32x2){mean, __builtin_amdgcn_rsqf(fmaxf(ex2 - mean * mean, 0.f) + EPS)}; }
        __syncthreads();
        SGU_LN(0);
        SGU_LOADV(1);
        for (int i = 0; i < 12; ++i) { const int g = hh * 4 + i / 3, c0 = SGU_C0(i);
            v4u uu[4]; float bs[4];
#pragma unroll
            for (int m = 0; m < 4; ++m) { const int t = wr * 64 + m * 16 + fr; bs[m] = b_s[g * 128 + t];
                uu[m] = *(const GAS v4u*)(UY + (size_t)(row0 + t) * SGW + c0 + wc * 32 + 8 * fq); }
            __syncthreads();
            LAS unsigned char* Bs = lds + BSZ + (i & 1) * BSZ;
            f32x4 acc[4][2];
#pragma unroll
            for (int m = 0; m < 4; ++m) { acc[m][0] = (f32x4){0.f, 0.f, 0.f, 0.f}; acc[m][1] = (f32x4){0.f, 0.f, 0.f, 0.f}; }
#pragma unroll
            for (int ks = 0; ks < 4; ++ks) { bf16x8 bfr[4];
#pragma unroll
                for (int m = 0; m < 4; ++m) bfr[m] = *(const LAS bf16x8*)(As + (wr * 64 + m * 16 + fr) * PA + (ks * 32 + fq * 8) * 2);
#pragma unroll
                for (int n = 0; n < 2; ++n) { const bf16x8 afr = tr_frag_p(Bs, PA, ks * 32, wc * 32 + 4 * n, 8, lane);
#pragma unroll
                    for (int m = 0; m < 4; ++m) acc[m][n] = MFMA16(afr, bfr[m], acc[m][n]); } }
            if (i + 1 < 12) {
                if ((i + 1) % 3 == 0) { __syncthreads(); SGU_STAGE_A(g + 1); }
                SGU_LN((i + 1) & 1);
                if (i + 2 < 12) SGU_LOADV(i + 2);
            }
#pragma unroll
            for (int m = 0; m < 4; ++m) { const int t = wr * 64 + m * 16 + fr; const v4u u4 = uu[m]; const f32x4 s0 = acc[m][0] + bs[m], s1 = acc[m][1] + bs[m];
                const f32x2 ga = pg8::gelu_pk((f32x2){bf_lo(u4.x), bf_hi(u4.x)}), gb = pg8::gelu_pk((f32x2){bf_lo(u4.y), bf_hi(u4.y)}), gc = pg8::gelu_pk((f32x2){bf_lo(u4.z), bf_hi(u4.z)}), gd = pg8::gelu_pk((f32x2){bf_lo(u4.w), bf_hi(u4.w)});
                *(GAS v4u*)(UY + (size_t)(row0 + t) * SGW + c0 + wc * 32 + 8 * fq) = (v4u){pk2(ga.x * s0[0], ga.y * s0[1]), pk2(gb.x * s0[2], gb.y * s0[3]), pk2(gc.x * s1[0], gc.y * s1[1]), pk2(gd.x * s1[2], gd.y * s1[3])}; }
        }
        __syncthreads();
    }
#undef SGU_C0
#undef SGU_LOADV
#undef SGU_LN
#undef SGU_STAGE_A
}

__device__ __forceinline__ float logsig16(float z) { return (fminf(z, 0.f) - __logf(1.0f + __expf(-fabsf(z)))) * (1.0f / 16.0f); }
constexpr int L_GZ = 0, L_TOT = 4096, L_GS = 8192, L_KT = 40960, L_QT = 58368, L_VT = 75776, L_PM = 109568, L_RED = 118784;
constexpr int PK = 272, PV = 528, PP = 144;
#define GLA_G(lds, pgz, w2, bg, tid) do { \
    LAS float* gzs_ = (LAS float*)((lds) + L_GZ); LAS float* tot_ = (LAS float*)((lds) + L_TOT); LAS float* Gs_ = (LAS float*)((lds) + L_GS); \
    if ((tid) < 256) *(LAS f32x4*)(gzs_ + 4 * (tid)) = (pgz); \
    const int kk_ = (tid) & 127, seg_ = (tid) >> 7; \
    __syncthreads(); \
    float run_ = 0.f, Gv_[16]; \
    _Pragma("unroll") for (int tt_ = 0; tt_ < 16; ++tt_) { const LAS f32x4* gr_ = (const LAS f32x4*)(gzs_ + (seg_ * 16 + tt_) * 16); float z_ = (bg); \
        _Pragma("unroll") for (int q_ = 0; q_ < 4; ++q_) { const f32x4 g4_ = gr_[q_]; z_ += g4_[0] * (w2)[4 * q_] + g4_[1] * (w2)[4 * q_ + 1] + g4_[2] * (w2)[4 * q_ + 2] + g4_[3] * (w2)[4 * q_ + 3]; } \
        run_ += logsig16(z_); Gv_[tt_] = run_; } \
    tot_[seg_ * 128 + kk_] = run_; \
    __syncthreads(); \
    { const float t0_ = tot_[kk_], t1_ = tot_[128 + kk_], t2_ = tot_[256 + kk_]; \
      const float pre_ = (seg_ > 0 ? t0_ : 0.f) + (seg_ > 1 ? t1_ : 0.f) + (seg_ > 2 ? t2_ : 0.f); \
      _Pragma("unroll") for (int tt_ = 0; tt_ < 16; ++tt_) Gs_[(seg_ * 16 + tt_) * 128 + kk_] = Gv_[tt_] + pre_; } \
    __syncthreads(); \
} while (0)
#define UNPK8(W_, lo4, hi4) do { const v4u w__ = (W_); lo4 = (f32x4){bf_lo(w__.x), bf_hi(w__.x), bf_lo(w__.y), bf_hi(w__.y)}; hi4 = (f32x4){bf_lo(w__.z), bf_hi(w__.z), bf_lo(w__.w), bf_hi(w__.w)}; } while (0)
__device__ __forceinline__ f32x4 exp4(f32x4 v) { return (f32x4){__expf(v[0]), __expf(v[1]), __expf(v[2]), __expf(v[3])}; }
__device__ __forceinline__ v4u pack8(f32x4 a, f32x4 b) { return (v4u){pk2(a[0], a[1]), pk2(a[2], a[3]), pk2(b[0], b[1]), pk2(b[2], b[3])}; }

__device__ __forceinline__ void gla_state_phase(LAS unsigned char* lds, const bf16* Kg, const bf16* Vg, const float* GZ, const float* w_g2, const float* b_g, bf16* dS, float* dec,
                                                int G, int bid, int tid, int lane, int wid) {
    const int fr = lane & 15, fq = lane >> 4, h = bid & 3;
    float w2[16];
#pragma unroll
    for (int r = 0; r < 16; ++r) w2[r] = w_g2[r * KD + h * DK + (tid & 127)];
    const float bg = b_g[h * DK + (tid & 127)];
    v4u pk_[2], pv_[4]; f32x4 pgz = (f32x4){0.f, 0.f, 0.f, 0.f};
#define P7_LOAD(it_) do { const int r0_ = ((it_) >> 2) * 64; if (tid < 256) pgz = *(const GAS f32x4*)(GZ + (size_t)r0_ * 16 + 4 * tid); \
        _Pragma("unroll") for (int j_ = 0; j_ < 2; ++j_) { const int id_ = tid + 512 * j_; pk_[j_] = *(const GAS v4u*)(Kg + (size_t)(r0_ + (id_ >> 4)) * KD + h * DK + 8 * (id_ & 15)); } \
        _Pragma("unroll") for (int j_ = 0; j_ < 4; ++j_) { const int id_ = tid + 512 * j_; pv_[j_] = *(const GAS v4u*)(Vg + (size_t)(r0_ + (id_ >> 5)) * VD + h * DV + 8 * (id_ & 31)); } } while (0)
    int item = bid;
    if (item < NITEM) P7_LOAD(item);
    for (; item < NITEM; item += G) {
        GLA_G(lds, pgz, w2, bg, tid);
        const LAS float* Gs = (const LAS float*)(lds + L_GS);
#pragma unroll
        for (int j = 0; j < 2; ++j) { const int id = tid + 512 * j, t = id >> 4, c8 = id & 15; f32x4 k0, k1; UNPK8(pk_[j], k0, k1);
            const f32x4 g0 = *(const LAS f32x4*)(Gs + t * 128 + 8 * c8), g1 = *(const LAS f32x4*)(Gs + t * 128 + 8 * c8 + 4), l0 = *(const LAS f32x4*)(Gs + 63 * 128 + 8 * c8), l1 = *(const LAS f32x4*)(Gs + 63 * 128 + 8 * c8 + 4);
            *(LAS v4u*)(lds + L_KT + t * PK + c8 * 16) = pack8(k0 * exp4(l0 - g0), k1 * exp4(l1 - g1)); }
#pragma unroll
        for (int j = 0; j < 4; ++j) { const int id = tid + 512 * j; *(LAS v4u*)(lds + L_VT + (id >> 5) * PV + (id & 31) * 16) = pv_[j]; }
        if (tid < 128) dec[(size_t)item * DK + tid] = __expf(Gs[63 * 128 + tid]);
        if (item + G < NITEM) P7_LOAD(item + G);
        __syncthreads();
        f32x4 acc[2][8];
#pragma unroll
        for (int d = 0; d < 2; ++d)
#pragma unroll
            for (int kt = 0; kt < 8; ++kt) acc[d][kt] = (f32x4){0.f, 0.f, 0.f, 0.f};
#pragma unroll
        for (int ks = 0; ks < 2; ++ks) { bf16x8 bfr[2];
#pragma unroll
            for (int d = 0; d < 2; ++d) bfr[d] = tr_frag_p(lds + L_VT, PV, ks * 32, 16 * (2 * wid + d), 4, lane);
#pragma unroll
            for (int kt = 0; kt < 8; ++kt) { const bf16x8 afr = tr_frag_p(lds + L_KT, PK, ks * 32, 32 * (kt >> 1) + 4 * (kt & 1), 8, lane);
#pragma unroll
                for (int d = 0; d < 2; ++d) acc[d][kt] = MFMA16(afr, bfr[d], acc[d][kt]); } }
#pragma unroll
        for (int d = 0; d < 2; ++d) { bf16* rowp = dS + (size_t)item * (DV * DK) + (size_t)(16 * (2 * wid + d) + fr) * DK + 8 * fq;
#pragma unroll
            for (int kp = 0; kp < 4; ++kp) *(GAS v4u*)(rowp + 32 * kp) = pack8(acc[d][2 * kp], acc[d][2 * kp + 1]); }
    }
#undef P7_LOAD
}

__device__ __forceinline__ void gla_scan_phase(bf16* dS, const float* dec, int gtid, int NGT) {
    for (int e = gtid; e < 8 * DV * DK / 2; e += NGT) {
        const int bh = e >> 14, rem = e & 16383, b = bh >> 2, h = bh & 3;
        GAS unsigned* p = (GAS unsigned*)(dS + ((size_t)(b * 128) * 4 + h) * (DV * DK)) + rem;
        const GAS f32x2* dp = (const GAS f32x2*)(dec + ((size_t)(b * 128) * 4 + h) * DK) + (rem & 63);
        float s0 = 0.f, s1 = 0.f;
        for (int n0 = 0; n0 < 128; n0 += 8) { unsigned d[8]; f32x2 dc[8];
#pragma unroll
            for (int j = 0; j < 8; ++j) { d[j] = p[(size_t)(n0 + j) * (2 * DV * DK)]; dc[j] = dp[(size_t)(n0 + j) * (2 * DK)]; }
#pragma unroll
            for (int j = 0; j < 8; ++j) { p[(size_t)(n0 + j) * (2 * DV * DK)] = pk2(s0, s1); s0 = s0 * dc[j].x + bf_lo(d[j]); s1 = s1 * dc[j].y + bf_hi(d[j]); } }
    }
}

__device__ __forceinline__ void gla_out_phase(LAS unsigned char* lds, const bf16* Qg, const bf16* Kg, const bf16* Vg, bf16* SROG, const float* GZ, const float* w_g2, const float* b_g, const float* gn_g,
                                              const bf16* Sprev, int G, int bid, int tid, int lane, int wid) {
    const int fr = lane & 15, fq = lane >> 4, h = bid & 3;
    LAS float* red = (LAS float*)(lds + L_RED);
    float w2[16];
#pragma unroll
    for (int r = 0; r < 16; ++r) w2[r] = w_g2[r * KD + h * DK + (tid & 127)];
    const float bg = b_g[h * DK + (tid & 127)];
    const int dvl = 32 * wid + 8 * fq;
    const f32x4 gn0 = *(const f32x4*)(gn_g + h * DV + dvl), gn1 = *(const f32x4*)(gn_g + h * DV + dvl + 4);
    v4u pq_[2], pk_[2], pv_[4]; f32x4 pgz = (f32x4){0.f, 0.f, 0.f, 0.f};
#define P9_LOAD(it_) do { const int r0_ = ((it_) >> 2) * 64; if (tid < 256) pgz = *(const GAS f32x4*)(GZ + (size_t)r0_ * 16 + 4 * tid); \
        _Pragma("unroll") for (int j_ = 0; j_ < 2; ++j_) { const int id_ = tid + 512 * j_; const size_t go_ = (size_t)(r0_ + (id_ >> 4)) * KD + h * DK + 8 * (id_ & 15); pq_[j_] = *(const GAS v4u*)(Qg + go_); pk_[j_] = *(const GAS v4u*)(Kg + go_); } \
        _Pragma("unroll") for (int j_ = 0; j_ < 4; ++j_) { const int id_ = tid + 512 * j_; pv_[j_] = *(const GAS v4u*)(Vg + (size_t)(r0_ + (id_ >> 5)) * VD + h * DV + 8 * (id_ & 31)); } } while (0)
    int item = bid;
    if (item < NITEM) P9_LOAD(item);
    for (; item < NITEM; item += G) {
        const int r0 = (item >> 2) * 64;
        bf16x8 sp[4][2]; v4u sr[4];
        { const int i = lane & 15; const bf16* sb = Sprev + (size_t)item * (DV * DK) + 8 * fq;
#pragma unroll
          for (int ks = 0; ks < 4; ++ks)
#pragma unroll
              for (int d = 0; d < 2; ++d) sp[ks][d] = *(const GAS bf16x8*)(sb + (size_t)(32 * wid + 8 * (i >> 2) + 4 * d + (i & 3)) * DK + 32 * ks); }
#pragma unroll
        for (int it = 0; it < 4; ++it) sr[it] = *(const GAS v4u*)(SROG + (size_t)(r0 + 16 * it + fr) * VD + h * DV + dvl);
        GLA_G(lds, pgz, w2, bg, tid);
        const LAS float* Gs = (const LAS float*)(lds + L_GS);
#pragma unroll
        for (int j = 0; j < 2; ++j) { const int id = tid + 512 * j, t = id >> 4, c8 = id & 15; f32x4 q0, q1, k0, k1; UNPK8(pq_[j], q0, q1); UNPK8(pk_[j], k0, k1);
            const f32x4 g0 = *(const LAS f32x4*)(Gs + t * 128 + 8 * c8), g1 = *(const LAS f32x4*)(Gs + t * 128 + 8 * c8 + 4);
            *(LAS v4u*)(lds + L_QT + t * PK + c8 * 16) = pack8(q0 * exp4(g0), q1 * exp4(g1));
            *(LAS v4u*)(lds + L_KT + t * PK + c8 * 16) = pack8(k0 * exp4(-g0), k1 * exp4(-g1)); }
#pragma unroll
        for (int j = 0; j < 4; ++j) { const int id = tid + 512 * j; *(LAS v4u*)(lds + L_VT + (id >> 5) * PV + (id & 31) * 16) = pv_[j]; }
        if (item + G < NITEM) P9_LOAD(item + G);
        __syncthreads();
        { const int it = wid >> 1;
#pragma unroll
          for (int jj = 0; jj < 2; ++jj) { const int jt = 2 * (wid & 1) + jj; f32x4 pa = (f32x4){0.f, 0.f, 0.f, 0.f};
#pragma unroll
              for (int ks = 0; ks < 4; ++ks) { const bf16x8 a = *(const LAS bf16x8*)(lds + L_KT + (16 * jt + fr) * PK + (32 * ks + 8 * fq) * 2), b = *(const LAS bf16x8*)(lds + L_QT + (16 * it + fr) * PK + (32 * ks + 8 * fq) * 2);
                  pa = MFMA16(a, b, pa); }
              const int i = 16 * it + fr, j0 = 16 * jt + 4 * fq;
              *(LAS v2u*)(lds + L_PM + i * PP + j0 * 2) = (v2u){pk2(j0 <= i ? pa[0] : 0.f, j0 + 1 <= i ? pa[1] : 0.f), pk2(j0 + 2 <= i ? pa[2] : 0.f, j0 + 3 <= i ? pa[3] : 0.f)}; } }
        __syncthreads();
        f32x4 acc[4][2];
#pragma unroll
        for (int it = 0; it < 4; ++it) { acc[it][0] = (f32x4){0.f, 0.f, 0.f, 0.f}; acc[it][1] = (f32x4){0.f, 0.f, 0.f, 0.f}; }
#pragma unroll
        for (int ks = 0; ks < 2; ++ks) { bf16x8 a[2];
#pragma unroll
            for (int d = 0; d < 2; ++d) a[d] = tr_frag_p(lds + L_VT, PV, ks * 32, 32 * wid + 4 * d, 8, lane);
#pragma unroll
            for (int it = 0; it < 4; ++it) { const bf16x8 b = *(const LAS bf16x8*)(lds + L_PM + (16 * it + fr) * PP + (32 * ks + 8 * fq) * 2);
#pragma unroll
                for (int d = 0; d < 2; ++d) acc[it][d] = MFMA16(a[d], b, acc[it][d]); } }
#pragma unroll
        for (int ks = 0; ks < 4; ++ks) {
#pragma unroll
            for (int it = 0; it < 4; ++it) { const bf16x8 b = *(const LAS bf16x8*)(lds + L_QT + (16 * it + fr) * PK + (32 * ks + 8 * fq) * 2);
#pragma unroll
                for (int d = 0; d < 2; ++d) acc[it][d] = MFMA16(sp[ks][d], b, acc[it][d]); } }
#pragma unroll
        for (int it = 0; it < 4; ++it) { float ss = 0.f;
#pragma unroll
            for (int d = 0; d < 2; ++d) ss += (acc[it][d][0] * acc[it][d][0] + acc[it][d][1] * acc[it][d][1]) + (acc[it][d][2] * acc[it][d][2] + acc[it][d][3] * acc[it][d][3]);
            ss += __shfl_xor(ss, 16); ss += __shfl_xor(ss, 32);
            if (fq == 0) red[wid * 64 + 16 * it + fr] = ss; }
        __syncthreads();
#pragma unroll
        for (int it = 0; it < 4; ++it) { const int i = 16 * it + fr; float tot = 0.f;
#pragma unroll
            for (int w8 = 0; w8 < 8; ++w8) tot += red[w8 * 64 + i];
            const float rms = __builtin_amdgcn_rsqf(tot * (1.0f / 256.0f) + EPS);
            f32x4 s0, s1; UNPK8(sr[it], s0, s1);
            *(GAS v4u*)(SROG + (size_t)(r0 + i) * VD + h * DV + dvl) = pack8(acc[it][0] * rms * gn0 * s0, acc[it][1] * rms * gn1 * s1); }
    }
#undef P9_LOAD
}

#define XB_TMO      128
#define XB_XCNT(j)  (256  + 64 * (j))
#define XB_XSUB(j)  (1280 + 64 * (j))
#define XB_XGEN(j)  (2304 + 64 * (j))
#define XB_TOP      3328
#define XB_TOPGEN   3392
#define XCD_BAR_WORDS 3456
#define XB_SPIN_CAP (1u << 18)

__device__ __forceinline__ unsigned xb_ld(unsigned* p)              { return __hip_atomic_load(p, __ATOMIC_RELAXED, __HIP_MEMORY_SCOPE_AGENT); }
__device__ __forceinline__ unsigned xb_add(unsigned* p, unsigned v) { return __hip_atomic_fetch_add(p, v, __ATOMIC_RELAXED, __HIP_MEMORY_SCOPE_AGENT); }
__device__ __forceinline__ unsigned xb_xcc_id() { return (unsigned)__builtin_amdgcn_s_getreg((3 << 11) | 20) & 0xFu; }
#define XB_SPIN(cond, bar) do { unsigned _sp = 0; while (cond) { __builtin_amdgcn_s_sleep(1); \
    if ((++_sp & 255u) == 0u) { if (xb_ld(&(bar)[XB_TMO])) break; if (_sp > XB_SPIN_CAP) { atomicAdd(&(bar)[XB_TMO], 1u); break; } } } } while (0)

struct XcdBarrier {
    unsigned* bar; unsigned x;
    volatile LAS unsigned* st;
};

__device__ __forceinline__ XcdBarrier xcd_barrier_post(unsigned* bar, volatile LAS unsigned* st) {
    XcdBarrier b; b.bar = bar; b.x = xb_xcc_id(); b.st = st;
    if (threadIdx.x == 0) (void)xb_add(&bar[XB_XCNT(b.x)], 1u);
    return b;
}
__device__ __forceinline__ void xcd_barrier_complete(unsigned* bar, unsigned x, unsigned& nloc, unsigned& nx) {
    const unsigned G = gridDim.x * gridDim.y * gridDim.z;
    unsigned sum, cnt, mine, sp = 0u;
    for (;;) {
        sum = 0u; cnt = 0u; mine = 0u;
#pragma unroll
        for (unsigned j = 0; j < 16; ++j) { const unsigned c = xb_ld(&bar[XB_XCNT(j)]); sum += c; cnt += (c > 0u) ? 1u : 0u; mine = (j == x) ? c : mine; }
        if (sum == G) break;
        __builtin_amdgcn_s_sleep(1);
        if ((++sp & 255u) == 0u) { if (xb_ld(&bar[XB_TMO])) break; if (sp > XB_SPIN_CAP) { atomicAdd(&bar[XB_TMO], 1u); break; } }
    }
    nloc = mine > 0u ? mine : 1u; nx = cnt > 0u ? cnt : 1u;
}

__device__ __forceinline__ void xcd_barrier(const XcdBarrier& b) {
    asm volatile("s_waitcnt vmcnt(0)" ::: "memory");
    __syncthreads();
    if (threadIdx.x == 0) {
        unsigned* bar = b.bar;
        __builtin_amdgcn_s_waitcnt(0);
        unsigned nloc = b.st[0], nx = b.st[1];
        if (nloc == 0u) { xcd_barrier_complete(bar, b.x, nloc, nx); b.st[0] = nloc; b.st[1] = nx; }
        const unsigned old = xb_add(&bar[XB_XSUB(b.x)], 1u);
        const unsigned gen = old / nloc;
        if (old + 1u == (gen + 1u) * nloc) {
            __builtin_amdgcn_fence(__ATOMIC_RELEASE, "agent");
            asm volatile("s_waitcnt vmcnt(0)" ::: "memory");
            const unsigned og = xb_add(&bar[XB_TOP], 1u);
            const unsigned tg = og / nx;
            if (og + 1u == (tg + 1u) * nx) xb_add(&bar[XB_TOPGEN], 1u);
            else XB_SPIN(xb_ld(&bar[XB_TOPGEN]) == tg, bar);
            __builtin_amdgcn_fence(__ATOMIC_ACQUIRE, "agent");
            xb_add(&bar[XB_XGEN(b.x)], 1u);
            asm volatile("s_waitcnt vmcnt(0)" ::: "memory");
        } else {
            XB_SPIN(xb_ld(&bar[XB_XGEN(b.x)]) == gen, bar);
            __builtin_amdgcn_fence(__ATOMIC_ACQUIRE, "agent");
            asm volatile("s_waitcnt vmcnt(0)" ::: "memory");
        }
    }
    __syncthreads();
}

constexpr int NPHASE = 14;
__global__ void __launch_bounds__(NTHREADS, 2) mk_fwd(Args args) {
    extern __shared__ __attribute__((aligned(16))) unsigned char lds_raw[];
    LAS unsigned char* lds = (LAS unsigned char*)lds_raw;
    cg::grid_group grid = cg::this_grid();
    const int tid = threadIdx.x, lane = tid & 63, wave = __builtin_amdgcn_readfirstlane(tid >> 6);
    const int G = gridDim.x, bid = blockIdx.x;
    const int vcu = (G % 8 == 0) ? (bid % 8) * (G / 8) + bid / 8 : bid;
    const int gw = vcu * NWAVES + wave, NGW = G * NWAVES, gtid = vcu * NTHREADS + tid, NGT = G * NTHREADS;
    unsigned char* ws = args.ws;
    const int lo = args.ph_lo, hi = args.ph_hi;
#define IN(k) (lo <= (k) && (k) < hi)
    if (tid < 64) ((LAS unsigned*)(lds + RING_BYTES))[tid] = 0u;
    __syncthreads();
    XcdBarrier bar; bar.bar = (unsigned*)ws; bar.x = 0; bar.st = nullptr;
    if (hi - lo > 1) bar = xcd_barrier_post((unsigned*)ws, (volatile LAS unsigned*)(lds + RING_BYTES) + 8);
#ifdef PROBE_K
#define STAMP(k) do { if (bid == 0 && tid == 0) ((unsigned long long*)(ws + 255 * MiB))[(k)] = __builtin_amdgcn_s_memrealtime(); } while (0)
#else
#define STAMP(k) do { } while (0)
#endif
#define SEAM(k) do { if (IN(k) && IN((k) + 1)) xcd_barrier(bar); STAMP((k) + 1); } while (0)
    STAMP(0);
    if (hi > 1000) grid.sync();
    float* X = args.out;
    float* rsq = (float*)(ws + WS_RSQ);
    bf16* XB = (bf16*)(ws + WS_RV);
    LAS float* rstab = (LAS float*)(lds + RING_BYTES + 1024);

    if (IN(0)) { p0_prologue(args, lds, gw, NGW, lane, wave, gtid, NGT); } SEAM(0);
    if (IN(1)) {
        pg8::Gemm g{(const bf16*)args.out, (const bf16*)(ws + WS_WAIN), M, SGF, D}; pg8::StaticOrder S; S.init(M, SGF, G, bid);
        pg8::EpiSguIn E{(bf16*)(ws + WS_RU), (bf16*)(ws + WS_RV), rsq, (pg8::f32x2*)((unsigned char*)args.out + 32 * MiB), rstab};
        pg8::gemm_phase<pg8::EpiSguIn, pg8::StaticOrder, true, true>(lds, g, S, E);
    } SEAM(1);
    if (IN(2)) { sgu_phase(lds, (const bf16*)(ws + WS_WM), (const bf16*)(ws + WS_RV), (bf16*)(ws + WS_RU), (const f32x2*)((unsigned char*)args.out + 32 * MiB), args.in[3], args.in[4], args.in[6], G, vcu, tid, lane, wave); } SEAM(2);
    if (IN(3)) {
        pg8::Gemm g{(const bf16*)(ws + WS_RU), (const bf16*)(ws + WS_WAOUT), M, D, SGW}; pg8::StaticOrder S; S.init(M, D, G, bid);
        pg8::EpiResid<true> E{args.in[0], XB, rsq};
        pg8::gemm_phase<pg8::EpiResid<true>, pg8::StaticOrder, false, true>(lds, g, S, E);
    } SEAM(3);
    if (IN(4)) {
        pg8::Gemm g{XB, (const bf16*)(ws + WS_WGU0), M, 2 * FH, D}; pg8::StaticOrder S; S.init(M, 2 * FH, G, bid);
        pg8::EpiSwiGLU E{(bf16*)(ws + WS_RU), FH, rsq, rstab};
        pg8::gemm_phase<pg8::EpiSwiGLU, pg8::StaticOrder, true, true>(lds, g, S, E);
    } SEAM(4);
    if (IN(5)) {
        pg8::Gemm g{(const bf16*)(ws + WS_RU), (const bf16*)(ws + WS_WDN0), M, D, FH}; pg8::StaticOrder S; S.init(M, D, G, bid);
        pg8::EpiResid<false> E{XB, XB, rsq};
        pg8::gemm_phase<pg8::EpiResid<false>, pg8::StaticOrder, false, true>(lds, g, S, E);
    } SEAM(5);
    bf16* Qg = (bf16*)(ws + WS_RU); bf16* Kg = (bf16*)(ws + WS_RU + 16 * MiB); bf16* Vg = (bf16*)(ws + WS_RU + 32 * MiB); bf16* SR = (bf16*)(ws + WS_RU + 64 * MiB);
    bf16* dS = (bf16*)(ws + WS_RV + 32 * MiB); float* GZ = (float*)(ws + WS_GZ); float* dec = (float*)(ws + WS_DEC);
    if (IN(6)) {
        for (int rp = vcu * 4; rp < M / 16; rp += G * 4) { const int fr = lane & 15, fq = lane >> 4, rt = rp + (wave >> 1), kh = wave & 1;
            const bf16* ap = XB + (size_t)(rt * 16 + fr) * D + 512 * kh + 8 * fq; const bf16* bp = (const bf16*)(ws + WS_WBIN) + (size_t)(3072 + fr) * D + 512 * kh + 8 * fq;
            bf16x8 av[16], bv[16];
#pragma unroll
            for (int ks = 0; ks < 16; ++ks) { av[ks] = *(const GAS bf16x8*)(bp + 32 * ks); bv[ks] = *(const GAS bf16x8*)(ap + 32 * ks); }
            f32x4 c0 = (f32x4){0.f, 0.f, 0.f, 0.f}, c1 = c0;
#pragma unroll
            for (int ks = 0; ks < 16; ks += 2) { c0 = MFMA16(av[ks], bv[ks], c0); c1 = MFMA16(av[ks + 1], bv[ks + 1], c1); }
            c0 = c0 + c1;
            LAS f32x4* xch = (LAS f32x4*)lds + (wave >> 1) * 64 + lane;
            if (kh) *xch = c0;
            __syncthreads();
            if (!kh) *(GAS f32x4*)(GZ + (size_t)(rt * 16 + fr) * 16 + 4 * fq) = (c0 + *xch) * pg8::row_rs(rsq, rt * 16 + fr);
            __syncthreads(); }
        pg8::Gemm g{XB, (const bf16*)(ws + WS_WBIN), M, 3072, D}; pg8::StaticOrder S; S.init(M, 3072, G, bid);
        pg8::EpiGlaIn E{Qg, Kg, Vg, SR, GZ, rsq, rstab};
        pg8::gemm_phase<pg8::EpiGlaIn, pg8::StaticOrder, true, true>(lds, g, S, E);
    } SEAM(6);
    if (IN(7)) { gla_state_phase(lds, Kg, Vg, GZ, args.in[9], args.in[10], dS, dec, G, vcu, tid, lane, wave); } SEAM(7);
    if (IN(8)) { gla_scan_phase(dS, dec, gtid, NGT); } SEAM(8);
    if (IN(9)) { gla_out_phase(lds, Qg, Kg, Vg, SR, GZ, args.in[9], args.in[10], args.in[11], dS, G, vcu, tid, lane, wave); } SEAM(9);
    if (IN(10)) {
        pg8::Gemm g{SR, (const bf16*)(ws + WS_WBOUT), M, D, VD}; pg8::StaticOrder S; S.init(M, D, G, bid);
        pg8::EpiResid<false> E{XB, XB, rsq};
        pg8::gemm_phase<pg8::EpiResid<false>, pg8::StaticOrder, false, true>(lds, g, S, E);
    } SEAM(10);
    if (IN(11)) {
        pg8::Gemm g{XB, (const bf16*)(ws + WS_WGU1), M, 2 * FH, D}; pg8::StaticOrder S; S.init(M, 2 * FH, G, bid);
        pg8::EpiSwiGLU E{(bf16*)(ws + WS_RU), FH, rsq, rstab};
        pg8::gemm_phase<pg8::EpiSwiGLU, pg8::StaticOrder, true, true>(lds, g, S, E);
    } SEAM(11);
    if (IN(12)) {
        pg8::Gemm g{(const bf16*)(ws + WS_RU), (const bf16*)(ws + WS_WDN1), M, D, FH}; pg8::StaticOrder S; S.init(M, D, G, bid);
        pg8::EpiResid<false> E{XB, XB, rsq};
        pg8::gemm_phase<pg8::EpiResid<false>, pg8::StaticOrder, false, true>(lds, g, S, E);
    } SEAM(12);
    if (IN(13)) {
        const float* fg = args.in[17];
        f32x4 gv[4];
#pragma unroll
        for (int j = 0; j < 4; ++j) gv[j] = *(const f32x4*)(fg + 8 * lane + 512 * (j >> 1) + 4 * (j & 1));
        for (int m0 = gw; m0 < M; m0 += 8 * NGW) { v4u w[8][2]; float rs[8];
#pragma unroll
            for (int r = 0; r < 8; ++r) { const int m = m0 + r * NGW; if (m < M) { const GAS v4u* xr = (const GAS v4u*)(XB + (size_t)m * D) + lane; w[r][0] = xr[0]; w[r][1] = xr[64]; rs[r] = pg8::row_rs(rsq, m); } }
#pragma unroll
            for (int r = 0; r < 8; ++r) { const int m = m0 + r * NGW; if (m < M) { GAS f32x4* o = (GAS f32x4*)(X + (size_t)m * D) + 2 * lane;
#pragma unroll
                for (int hh = 0; hh < 2; ++hh) { const v4u q = w[r][hh];
                    o[128 * hh] = (f32x4){bf_lo(q.x), bf_hi(q.x), bf_lo(q.y), bf_hi(q.y)} * rs[r] * gv[2 * hh];
                    o[128 * hh + 1] = (f32x4){bf_lo(q.z), bf_hi(q.z), bf_lo(q.w), bf_hi(q.w)} * rs[r] * gv[2 * hh + 1]; } } } }
    }
#ifdef PROBE_K
    xcd_barrier(bar);
    if (bid == 0 && tid == 0) { const unsigned long long* ts = (const unsigned long long*)(ws + 255 * MiB); X[0] = (float)(ts[PROBE_K + 1] - ts[PROBE_K]) * 0.001f; }
#endif
#undef IN
#undef SEAM
}


__global__ void digest_k(const unsigned short* a, size_t na, const float* f, size_t nf, float* out) {
    const size_t n = (size_t)16384 * 1024;
    for (size_t i = (size_t)blockIdx.x * blockDim.x + threadIdx.x; i < n; i += (size_t)gridDim.x * blockDim.x) {
        float v = 0.f;
        for (size_t k = 0; k * n + i < na; ++k) v += __builtin_bit_cast(float, (unsigned)a[k * n + i] << 16);
        if (nf) v += f[i % nf];
        if (!(fabsf(v) < 1e30f)) v = 1e30f;
        out[i] = v;
    }
}
#ifndef MK_N_LAUNCHES
#define MK_N_LAUNCHES 1
#define DBG_NPH 14
#endif
extern "C" void kernel_launch(void* const* d_in, const int* in_sizes, int n_in, void* d_out, int out_size, void* d_ws, size_t ws_size, hipStream_t stream) {
    static int grid = 0;
    if (grid == 0) {
        if (n_in != 18 || in_sizes[0] != M * D || out_size != M * D || ws_size < WS_END) { fprintf(stderr, "kernel_launch: unexpected shapes (n_in %d, in0 %d, out %d, ws %zu); nothing launched\n", n_in, n_in > 0 ? in_sizes[0] : -1, out_size, ws_size); grid = -1; return; }
        int dev = 0, cus = 0, per_cu = 0;
        if (hipGetDevice(&dev) != hipSuccess || hipDeviceGetAttribute(&cus, hipDeviceAttributeMultiprocessorCount, dev) != hipSuccess) { grid = -1; return; }
        if (hipFuncSetAttribute((const void*)mk_fwd, hipFuncAttributeMaxDynamicSharedMemorySize, LDS_BYTES) != hipSuccess) { fprintf(stderr, "kernel_launch: hipFuncSetAttribute failed\n"); grid = -1; return; }
        if (hipOccupancyMaxActiveBlocksPerMultiprocessor(&per_cu, (const void*)mk_fwd, NTHREADS, LDS_BYTES) != hipSuccess || per_cu < 1) { fprintf(stderr, "kernel_launch: occupancy query gives %d blocks per CU\n", per_cu); (void)hipGetLastError(); grid = -1; return; }
        grid = cus;
        if (grid != 256) { fprintf(stderr, "kernel_launch: built for a 256-CU device (got %d)\n", cus); grid = -1; return; }
    }
    if (grid < 0) return;
    Args a{};
    for (int i = 0; i < 18; ++i) a.in[i] = (const float*)d_in[i];
    a.out = (float*)d_out; a.ws = (unsigned char*)d_ws;
#if MK_N_LAUNCHES == 1
    if (hipMemsetAsync(d_ws, 0, 16384, stream) != hipSuccess) { fprintf(stderr, "kernel_launch: memset of the barrier words failed\n"); return; }
    a.ph_lo = 0; a.ph_hi = NPHASE;
    void* kargs[] = {&a};
    hipError_t e = hipLaunchCooperativeKernel((const void*)mk_fwd, dim3(grid), dim3(NTHREADS), kargs, LDS_BYTES, stream);
    if (e != hipSuccess) fprintf(stderr, "kernel_launch: cooperative launch failed: %s\n", hipGetErrorString(e));
#else
    for (int p = 0; p < DBG_NPH; ++p) { a.ph_lo = p; a.ph_hi = p + 1; hipLaunchKernelGGL(mk_fwd, dim3(grid), dim3(NTHREADS), LDS_BYTES, stream, a); }
#ifdef DBG_DIG
    { unsigned char* w = (unsigned char*)d_ws; const size_t n16 = (size_t)16384 * 1024;
      const unsigned short* da = nullptr; size_t na = 0; const float* df = nullptr; size_t nf = 0;
      if (DBG_DIG == 6) { da = (const unsigned short*)(w + WS_RU); na = 3 * n16; df = (const float*)(w + WS_GZ); nf = 262144; }
      if (DBG_DIG == 7 || DBG_DIG == 8) { da = (const unsigned short*)(w + WS_RV + 32 * MiB); na = 2 * n16; df = (const float*)(w + WS_DEC); nf = 131072; }
      if (DBG_DIG == 9) { da = (const unsigned short*)(w + WS_RU + 64 * MiB); na = n16; }
      hipLaunchKernelGGL(digest_k, dim3(2048), dim3(256), 0, stream, da, na, df, nf, (float*)d_out); }
#endif
#endif
}
```

```cpp
#include <hip/hip_runtime.h>
#include <hip/hip_cooperative_groups.h>
#include <cstdio>
#include <cstdint>
namespace cg = cooperative_groups;
namespace pg8 {
#define PG8_LAS __attribute__((address_space(3)))
typedef unsigned short bf16_t;
typedef short bf16x8 __attribute__((ext_vector_type(8)));
typedef float f32x4 __attribute__((ext_vector_type(4)));
typedef unsigned u32x4 __attribute__((ext_vector_type(4)));
constexpr int BM = 256, BK = 64, HALF = 128, HTB = HALF * BK * 2  , STAGE_BYTES = 8 * HTB, NXCD = 8, WGM = 8;

__host__ __device__ __forceinline__ int lds_byte(int r, int c) { const int st = (r >> 4) * 2 + (c >> 5), rr = r & 15, cc = c & 31, ob = rr * 64 + cc * 2; return st * 1024 + (ob ^ (((ob >> 9) & 1) << 5)); }
__host__ __device__ __forceinline__ void stage_rc(int b, int& R, int& C) { const int st = b / 1024, sb = b % 1024, swz = sb ^ (((sb >> 9) & 1) << 5); R = (st >> 1) * 16 + swz / 64; C = (st & 1) * 32 + (swz % 64) / 2; }
__host__ __device__ __forceinline__ int perm32(int rho) { const int n = rho >> 4, i = rho & 15; return 8 * (i >> 2) + 4 * n + (i & 3); }

struct Unit { int pm, pn; };
struct Gemm { const bf16_t* A; const bf16_t* Bt; int M, N, K; };

struct StaticOrder {
    int nM, nN, nwg, G, c;
    __host__ __device__ void init(int M, int N, int G_, int c_) { nM = M / BM; nN = N / BM; nwg = nM * nN; G = G_; c = c_; }
    __host__ __device__ bool next(int i, Unit& u) const {
        const long L = (long)i * G + c; if (L >= nwg) return false;
        int wgid = (int)L; { const int q = nwg / NXCD, r = nwg % NXCD, xcd = wgid % NXCD, off = wgid / NXCD; wgid = (xcd < r ? xcd * (q + 1) : r * (q + 1) + (xcd - r) * q) + off; }
        const int nig = WGM * nN, gid = wgid / nig, fm = gid * WGM, gsz = (nM - fm) < WGM ? (nM - fm) : WGM;
        u.pm = fm + ((wgid % nig) % gsz); u.pn = (wgid % nig) / gsz; return true;
    }
    __device__ __forceinline__ void a_ready(const Unit&) const {}
    __device__ __forceinline__ void done(const Unit&) const {}
};

typedef float f32x2 __attribute__((ext_vector_type(2)));
typedef __bf16 bf16x2v __attribute__((ext_vector_type(2)));
__device__ __forceinline__ unsigned cvt_pk_bf16(float lo, float hi) { const bf16x2v r = __builtin_convertvector((f32x2){lo, hi}, bf16x2v); return __builtin_bit_cast(unsigned, r); }
__device__ __forceinline__ void st16_wt(void* p, u32x4 w) { asm volatile("global_store_dwordx4 %0, %1, off sc0 sc1\n\ts_nop 1" :: "v"(p), "v"(w) : "memory"); }
__device__ __forceinline__ f32x2 gelu_pk(f32x2 v) {
    f32x2 a = __builtin_elementwise_abs(v); a.x = fminf(a.x, 6.0f); a.y = fminf(a.y, 6.0f);
    f32x2 p = a * 2.339709687609881e-05f + (-0.0006192482003406358f); p = p * a + 0.0072583738289044054f; p = p * a + (-0.051417680994680484f); p = p * a + (-0.46085568318627523f); p = p * a + (-1.1504893945481205f);
    p = p * a + (-1.0f);
    f32x2 t; t.x = __builtin_amdgcn_exp2f(p.x); t.y = __builtin_amdgcn_exp2f(p.y);
    const f32x2 m = v * t, r = v - m;
    f32x2 o; o.x = v.x < 0.f ? m.x : r.x; o.y = v.y < 0.f ? m.y : r.y; return o;
}

constexpr int EM = 16384;
constexpr float EEPS = 1e-6f;
__device__ __forceinline__ float row_rs(const float* rsq, int row) {
    const f32x4 p = *(const f32x4*)(rsq + (size_t)row * 4);
    return __builtin_amdgcn_rsqf(((p[0] + p[1]) + (p[2] + p[3])) * (1.0f / 1024.0f) + EEPS);
}
__device__ __forceinline__ float silu_f(float v) { return v * __builtin_amdgcn_rcpf(1.0f + __expf(-v)); }

struct EpiSguIn {
    static constexpr bool PERM = true, AFTER_DRAIN = false, RS_TABLE = true;
    bf16_t* U; bf16_t* V; const float* rsq; f32x2* statP; PG8_LAS float* tab;
    __device__ __forceinline__ void operator()(const f32x4 (&acc)[2][2][4][2], const Unit& u, int wr, int wc, int fr, int fq) const {
        const int colt = u.pn * HALF + wc * 32 + 8 * fq;
        const int row0 = u.pm * BM + wr * 64 + fr;
#pragma unroll
        for (int ai = 0; ai < 2; ++ai)
#pragma unroll
            for (int m = 0; m < 4; ++m) { const int row = row0 + ai * HALF + m * 16; const float rs = tab[row - u.pm * BM];
                { const f32x4 v0 = acc[ai][0][m][0] * rs, v1 = acc[ai][0][m][1] * rs;
                  u32x4 w; w.x = cvt_pk_bf16(v0[0], v0[1]); w.y = cvt_pk_bf16(v0[2], v0[3]); w.z = cvt_pk_bf16(v1[0], v1[1]); w.w = cvt_pk_bf16(v1[2], v1[3]);
                  st16_wt((void*)(U + (size_t)row * 3072 + colt), w); }
                { const f32x4 v0 = acc[ai][1][m][0] * rs, v1 = acc[ai][1][m][1] * rs;
                  const f32x2 a = gelu_pk((f32x2){v0[0], v0[1]}), b = gelu_pk((f32x2){v0[2], v0[3]}), c = gelu_pk((f32x2){v1[0], v1[1]}), d = gelu_pk((f32x2){v1[2], v1[3]});
                  float s1 = ((a.x + a.y) + (b.x + b.y)) + ((c.x + c.y) + (d.x + d.y));
                  float s2 = ((a.x * a.x + a.y * a.y) + (b.x * b.x + b.y * b.y)) + ((c.x * c.x + c.y * c.y) + (d.x * d.x + d.y * d.y));
                  u32x4 w; w.x = cvt_pk_bf16(a.x, a.y); w.y = cvt_pk_bf16(b.x, b.y); w.z = cvt_pk_bf16(c.x, c.y); w.w = cvt_pk_bf16(d.x, d.y);
                  st16_wt((void*)(V + (size_t)row * 3072 + colt), w);
                  s1 += __shfl_xor(s1, 16); s1 += __shfl_xor(s1, 32); s2 += __shfl_xor(s2, 16); s2 += __shfl_xor(s2, 32);
                  if (fq == 0) statP[(size_t)(u.pn * 4 + wc) * EM + row] = (f32x2){s1, s2}; } }
    }
};
struct EpiSwiGLU {
    static constexpr bool PERM = true, AFTER_DRAIN = false, RS_TABLE = true;
    bf16_t* Hd; int ldh; const float* rsq; PG8_LAS float* tab;
    __device__ __forceinline__ void operator()(const f32x4 (&acc)[2][2][4][2], const Unit& u, int wr, int wc, int fr, int fq) const {
        const int row0 = u.pm * BM + wr * 64 + fr, col0 = u.pn * HALF + wc * 32 + 8 * fq;
#pragma unroll
        for (int ai = 0; ai < 2; ++ai)
#pragma unroll
            for (int m = 0; m < 4; ++m) { const int row = row0 + ai * HALF + m * 16; const float rs = tab[row - u.pm * BM];
                const f32x4 g0 = acc[ai][0][m][0] * rs, g1 = acc[ai][0][m][1] * rs, u0 = acc[ai][1][m][0] * rs, u1 = acc[ai][1][m][1] * rs;
                u32x4 w; w.x = cvt_pk_bf16(silu_f(g0[0]) * u0[0], silu_f(g0[1]) * u0[1]); w.y = cvt_pk_bf16(silu_f(g0[2]) * u0[2], silu_f(g0[3]) * u0[3]);
                w.z = cvt_pk_bf16(silu_f(g1[0]) * u1[0], silu_f(g1[1]) * u1[1]); w.w = cvt_pk_bf16(silu_f(g1[2]) * u1[2], silu_f(g1[3]) * u1[3]);
                st16_wt((void*)(Hd + (size_t)row * ldh + col0), w); }
    }
};
struct EpiGlaIn {
    static constexpr bool PERM = true, AFTER_DRAIN = false, RS_TABLE = true;
    bf16_t* Q; bf16_t* Kk; bf16_t* Vv; bf16_t* SR; float* GZ; const float* rsq; PG8_LAS float* tab;
    __device__ __forceinline__ void operator()(const f32x4 (&acc)[2][2][4][2], const Unit& u, int wr, int wc, int fr, int fq) const {
        const int row0 = u.pm * BM + wr * 64 + fr, pn = u.pn;
        if (pn == 12) {
            if (wc == 0 && fq < 2) {
#pragma unroll
                for (int ai = 0; ai < 2; ++ai)
#pragma unroll
                    for (int m = 0; m < 4; ++m) { const int row = row0 + ai * HALF + m * 16; const float rs = tab[row - u.pm * BM];
                        float* p = GZ + (size_t)row * 16 + 8 * fq; *(f32x4*)p = acc[ai][0][m][0] * rs; *(f32x4*)(p + 4) = acc[ai][0][m][1] * rs; }
            }
            return;
        }
        bf16_t* base; int ld, colt; float sc = 1.f; const bool act = pn >= 8;
        if (pn < 2) { base = Q; ld = 512; colt = pn * BM; sc = 0.08838834764831845f; } else if (pn < 4) { base = Kk; ld = 512; colt = (pn - 2) * BM; }
        else if (pn < 8) { base = Vv; ld = 1024; colt = (pn - 4) * BM; } else { base = SR; ld = 1024; colt = (pn - 8) * BM; }
        colt += wc * 32 + 8 * fq;
#pragma unroll
        for (int ai = 0; ai < 2; ++ai)
#pragma unroll
            for (int m = 0; m < 4; ++m) { const int row = row0 + ai * HALF + m * 16; const float rs = tab[row - u.pm * BM] * sc;
                bf16_t* rowp = base + (size_t)row * ld + colt;
#pragma unroll
                for (int bj = 0; bj < 2; ++bj) { f32x4 v0 = acc[ai][bj][m][0] * rs, v1 = acc[ai][bj][m][1] * rs;
                    if (act) { v0 = (f32x4){silu_f(v0[0]), silu_f(v0[1]), silu_f(v0[2]), silu_f(v0[3])}; v1 = (f32x4){silu_f(v1[0]), silu_f(v1[1]), silu_f(v1[2]), silu_f(v1[3])}; }
                    u32x4 w; w.x = cvt_pk_bf16(v0[0], v0[1]); w.y = cvt_pk_bf16(v0[2], v0[3]); w.z = cvt_pk_bf16(v1[0], v1[1]); w.w = cvt_pk_bf16(v1[2], v1[3]);
                    st16_wt((void*)(rowp + bj * HALF), w); } }
    }
};
template <bool F32BASE> struct EpiResid {
    static constexpr bool PERM = true, AFTER_DRAIN = true, RS_TABLE = false;
    const void* base; bf16_t* xb; float* rsq;
    __device__ __forceinline__ void fused(f32x4 (&acc)[2][2][4][2], const Unit& u, int wr, int wc, int fr, int fq, PG8_LAS unsigned char* lds, int wid, int lane) const {
        PG8_LAS float* P = (PG8_LAS float*)lds;
        const int col0 = u.pn * BM + wc * 32 + 8 * fq;
#pragma unroll
        for (int ai = 0; ai < 2; ++ai)
#pragma unroll
            for (int m = 0; m < 4; ++m) { const int r = ai * HALF + wr * 64 + m * 16 + fr; const size_t off = (size_t)(u.pm * BM + r) * 1024 + col0; float ss = 0.f;
#pragma unroll
                for (int bj = 0; bj < 2; ++bj) { f32x4 b0, b1;
                    if (F32BASE) { const float* bp = (const float*)base + off + bj * HALF; b0 = *(const f32x4*)bp; b1 = *(const f32x4*)(bp + 4); }
                    else { const u32x4 w = *(const u32x4*)((const bf16_t*)base + off + bj * HALF);
                        b0 = (f32x4){__builtin_bit_cast(float, w.x << 16), __builtin_bit_cast(float, w.x & 0xffff0000u), __builtin_bit_cast(float, w.y << 16), __builtin_bit_cast(float, w.y & 0xffff0000u)};
                        b1 = (f32x4){__builtin_bit_cast(float, w.z << 16), __builtin_bit_cast(float, w.z & 0xffff0000u), __builtin_bit_cast(float, w.w << 16), __builtin_bit_cast(float, w.w & 0xffff0000u)}; }
                    const f32x4 o0 = b0 + acc[ai][bj][m][0], o1 = b1 + acc[ai][bj][m][1];
                    u32x4 w; w.x = cvt_pk_bf16(o0[0], o0[1]); w.y = cvt_pk_bf16(o0[2], o0[3]); w.z = cvt_pk_bf16(o1[0], o1[1]); w.w = cvt_pk_bf16(o1[2], o1[3]);
                    st16_wt((void*)(xb + off + bj * HALF), w);
                    ss += ((o0[0] * o0[0] + o0[1] * o0[1]) + (o0[2] * o0[2] + o0[3] * o0[3])) + ((o1[0] * o1[0] + o1[1] * o1[1]) + (o1[2] * o1[2] + o1[3] * o1[3])); }
                ss += __shfl_xor(ss, 16); ss += __shfl_xor(ss, 32);
                if (fq == 0) P[r * 4 + wc] = ss;
                if (m & 1) asm volatile("" ::: "memory"); }
        asm volatile("s_waitcnt lgkmcnt(0)" ::: "memory"); __builtin_amdgcn_s_barrier(); asm volatile("" ::: "memory");
        const int t = wid * 64 + lane;
        if (t < 256) { const f32x4 p = *(const PG8_LAS f32x4*)(P + t * 4); rsq[(size_t)(u.pm * BM + t) * 4 + u.pn] = (p[0] + p[1]) + (p[2] + p[3]); }
    }
};
template <class Epi, class Sched, bool ALIGN_EPI = false, bool SP2 = false>
__device__ __forceinline__ void gemm_phase(PG8_LAS unsigned char* lds, const Gemm g, const Sched& S, const Epi& E) {
    const int tid = threadIdx.x, wid = __builtin_amdgcn_readfirstlane(tid >> 6), lane = tid & 63, wr = wid >> 2, wc = wid & 3, fr = lane & 15, fq = lane >> 4;
    const int K = g.K, nt = K / BK;
    unsigned voffA[2], voffB[2];
#pragma unroll
    for (int i = 0; i < 2; ++i) { int R, C; stage_rc(tid * 16 + i * 8192, R, C); const int Rb = Epi::PERM ? ((R & ~31) + perm32(R & 31)) : R;
        voffA[i] = (unsigned)(R * K + C) * 2u; voffB[i] = (unsigned)(Rb * K + C) * 2u; }
    const size_t kstep = (size_t)(BK * 2);
    const size_t hstep = (size_t)HALF * K * 2;
    const size_t tstep = 2 * hstep;
    const unsigned ldsw = (unsigned)wid * 1024u;
    const int aoff = lds_byte(wr * 64 + fr, fq * 8), boff = lds_byte(wc * 32 + fr, fq * 8);
#define PG8_SA(b, h) (((b) * 2 + (h)) * HTB)
#define PG8_SB(b, h) ((4 + (b) * 2 + (h)) * HTB)
#define PG8_STAGE(bufoff, gbase, voff) do { _Pragma("unroll") for (int _i = 0; _i < 2; ++_i) \
        __builtin_amdgcn_global_load_lds((const unsigned*)((const char*)(gbase) + (voff)[_i]), (PG8_LAS unsigned*)(lds + (bufoff) + ldsw + _i * 8192), 16, 0, 0); } while (0)
#define PG8_LDA(dst, b, h) do { _Pragma("unroll") for (int m = 0; m < 4; ++m) _Pragma("unroll") for (int k = 0; k < 2; ++k) dst[m][k] = *(const PG8_LAS bf16x8*)(lds + PG8_SA(b, h) + aoff + m * 2048 + k * 1024); } while (0)
#define PG8_LDB(dst, b, h) do { _Pragma("unroll") for (int n = 0; n < 2; ++n) _Pragma("unroll") for (int k = 0; k < 2; ++k) dst[n][k] = *(const PG8_LAS bf16x8*)(lds + PG8_SB(b, h) + boff + n * 2048 + k * 1024); } while (0)
#define PG8_MMA(ai, bj, At, Bt) do { __builtin_amdgcn_s_setprio(1); _Pragma("unroll") for (int m = 0; m < 4; ++m) _Pragma("unroll") for (int n = 0; n < 2; ++n) _Pragma("unroll") for (int k = 0; k < 2; ++k) \
        acc[ai][bj][m][n] = __builtin_amdgcn_mfma_f32_16x16x32_bf16(Bt[n][k], At[m][k], acc[ai][bj][m][n], 0, 0, 0); __builtin_amdgcn_s_setprio(0); } while (0)
#define PG8_WAIT_V(n) asm volatile("s_waitcnt vmcnt(" #n ")" ::: "memory")
#define PG8_WAIT_L(n) asm volatile("s_waitcnt lgkmcnt(" #n ")" ::: "memory")
#define PG8_BAR __builtin_amdgcn_s_barrier()
#define PG8_SCHED __builtin_amdgcn_sched_barrier(0)
    Unit cur, nxt; int ui = 0;
    if (!S.next(0, cur)) return;
    f32x4 acc[2][2][4][2];
#pragma unroll
    for (int a = 0; a < 2; ++a)
#pragma unroll
        for (int b = 0; b < 2; ++b)
#pragma unroll
            for (int m = 0; m < 4; ++m)
#pragma unroll
                for (int n = 0; n < 2; ++n) acc[a][b][m][n] = (f32x4){0.f, 0.f, 0.f, 0.f};
    bf16x8 At[4][2], B0[2][2], B1[2][2];
    const char* cA = (const char*)g.A + (size_t)cur.pm * tstep; const char* cB = (const char*)g.Bt + (size_t)cur.pn * tstep;
    S.a_ready(cur);
    if constexpr (SP2) {
        PG8_STAGE(PG8_SB(0, 0), cB, voffB); PG8_STAGE(PG8_SB(0, 1), cB + hstep, voffB); PG8_STAGE(PG8_SA(0, 0), cA, voffA); PG8_STAGE(PG8_SA(0, 1), cA + hstep, voffA);
        if (wr == 1) PG8_BAR;
        PG8_WAIT_V(2); PG8_BAR;
        PG8_STAGE(PG8_SB(1, 0), cB + kstep, voffB); PG8_STAGE(PG8_SA(1, 0), cA + kstep, voffA); PG8_STAGE(PG8_SB(1, 1), cB + hstep + kstep, voffB);
        PG8_WAIT_V(6); PG8_BAR;
    } else {
        PG8_STAGE(PG8_SB(0, 0), cB, voffB); PG8_STAGE(PG8_SA(0, 0), cA, voffA); PG8_STAGE(PG8_SB(0, 1), cB + hstep, voffB); PG8_STAGE(PG8_SA(0, 1), cA + hstep, voffA);
        if (wr == 1) PG8_BAR;
        PG8_WAIT_V(4); PG8_BAR;
        PG8_STAGE(PG8_SB(1, 0), cB + kstep, voffB); PG8_STAGE(PG8_SA(1, 0), cA + kstep, voffA); PG8_STAGE(PG8_SB(1, 1), cB + hstep + kstep, voffB);
        PG8_WAIT_V(6); PG8_BAR;
    }
    for (;;) {
        const bool has_next = S.next(ui + 1, nxt);
        const char* nA = has_next ? (const char*)g.A + (size_t)nxt.pm * tstep : cA; const char* nB = has_next ? (const char*)g.Bt + (size_t)nxt.pn * tstep : cB;
        for (int t = 0; t < nt; t += 2) {
            const bool last = (t == nt - 2);
            const char* a1 = cA + (size_t)(t + 1) * kstep;
            const char* a2 = last ? nA : cA + (size_t)(t + 2) * kstep; const char* b2 = last ? nB : cB + (size_t)(t + 2) * kstep;
            const char* a3 = a2 + kstep; const char* b3 = b2 + kstep;
            if (last && has_next) S.a_ready(nxt);
            f32x4 rp_ = (f32x4){0.f, 0.f, 0.f, 0.f};
            if constexpr (Epi::RS_TABLE) { if (last && tid < 256) { const float* rq_ = E.rsq + (size_t)(cur.pm * BM + tid) * 4;
                asm volatile("global_load_dwordx4 %0, %1, off" : "=&v"(rp_) : "v"(rq_) : "memory"); } }
            if constexpr (SP2) {
            PG8_LDB(B0, 0, 0); PG8_LDB(B1, 0, 1); PG8_SCHED; PG8_LDA(At, 0, 0); PG8_STAGE(PG8_SA(1, 1), a1 + hstep, voffA);
            PG8_WAIT_V(8); PG8_WAIT_L(0); PG8_BAR; PG8_MMA(0, 0, At, B0); PG8_MMA(0, 1, At, B1); PG8_BAR; PG8_SCHED;
            PG8_LDA(At, 0, 1); PG8_STAGE(PG8_SB(0, 0), b2, voffB); PG8_STAGE(PG8_SB(0, 1), b2 + hstep, voffB); PG8_STAGE(PG8_SA(0, 0), a2, voffA);
            PG8_WAIT_V(8); PG8_WAIT_L(0); PG8_BAR; PG8_MMA(1, 0, At, B0); PG8_MMA(1, 1, At, B1); PG8_BAR; PG8_SCHED;
            PG8_LDB(B0, 1, 0); PG8_LDB(B1, 1, 1); PG8_SCHED; PG8_LDA(At, 1, 0); PG8_STAGE(PG8_SA(0, 1), a2 + hstep, voffA);
            PG8_WAIT_V(8); PG8_WAIT_L(0); PG8_BAR; PG8_MMA(0, 0, At, B0); PG8_MMA(0, 1, At, B1); PG8_BAR; PG8_SCHED;
            PG8_LDA(At, 1, 1); PG8_STAGE(PG8_SB(1, 0), b3, voffB); PG8_STAGE(PG8_SB(1, 1), b3 + hstep, voffB); PG8_STAGE(PG8_SA(1, 0), a3, voffA);
            PG8_WAIT_V(8); PG8_WAIT_L(0); PG8_BAR; PG8_MMA(1, 0, At, B0); PG8_MMA(1, 1, At, B1); PG8_BAR; PG8_SCHED;
            } else {
            PG8_LDB(B0, 0, 0); PG8_SCHED; PG8_LDA(At, 0, 0); PG8_STAGE(PG8_SA(1, 1), a1 + hstep, voffA);
            PG8_WAIT_L(8); PG8_BAR; PG8_WAIT_L(0); PG8_MMA(0, 0, At, B0); PG8_BAR; PG8_SCHED;
            PG8_LDB(B1, 0, 1); PG8_STAGE(PG8_SB(0, 0), b2, voffB);
            PG8_BAR; PG8_WAIT_L(0); PG8_MMA(0, 1, At, B1); PG8_BAR;
            PG8_LDA(At, 0, 1); PG8_STAGE(PG8_SA(0, 0), a2, voffA);
            PG8_BAR; PG8_WAIT_L(0); PG8_MMA(1, 0, At, B0); PG8_BAR; PG8_SCHED;
            PG8_STAGE(PG8_SB(0, 1), b2 + hstep, voffB);
            PG8_WAIT_V(6); PG8_BAR; PG8_MMA(1, 1, At, B1); PG8_BAR;
            PG8_LDB(B0, 1, 0); PG8_SCHED; PG8_LDA(At, 1, 0); PG8_STAGE(PG8_SA(0, 1), a2 + hstep, voffA);
            PG8_WAIT_L(8); PG8_BAR; PG8_WAIT_L(0); PG8_MMA(0, 0, At, B0); PG8_BAR; PG8_SCHED;
            PG8_LDB(B1, 1, 1); PG8_STAGE(PG8_SB(1, 0), b3, voffB);
            PG8_BAR; PG8_WAIT_L(0); PG8_MMA(0, 1, At, B1); PG8_BAR;
            PG8_LDA(At, 1, 1); PG8_STAGE(PG8_SA(1, 0), a3, voffA);
            PG8_BAR; PG8_WAIT_L(0); PG8_MMA(1, 0, At, B0); PG8_BAR; PG8_SCHED;
            PG8_STAGE(PG8_SB(1, 1), b3 + hstep, voffB);
            PG8_WAIT_V(6); PG8_BAR; PG8_MMA(1, 1, At, B1); PG8_BAR;
            }
            if constexpr (Epi::RS_TABLE) { if (last && tid < 256) { asm volatile("" : "+v"(rp_) :: "memory"); E.tab[tid] = __builtin_amdgcn_rsqf(((rp_[0] + rp_[1]) + (rp_[2] + rp_[3])) * (1.0f / 1024.0f) + 1e-6f); PG8_WAIT_L(0); } }
        }
        if constexpr (ALIGN_EPI) { if (wr == 0) PG8_BAR; }
        if constexpr (!Epi::AFTER_DRAIN) { E(acc, cur, wr, wc, fr, fq); S.done(cur); }
        if (!has_next) break;
#pragma unroll
        for (int a = 0; a < 2; ++a)
#pragma unroll
            for (int b = 0; b < 2; ++b)
#pragma unroll
                for (int m = 0; m < 4; ++m)
#pragma unroll
                    for (int n = 0; n < 2; ++n) acc[a][b][m][n] = (f32x4){0.f, 0.f, 0.f, 0.f};
        cur = nxt; cA = nA; cB = nB; ++ui;
        if constexpr (ALIGN_EPI) { if (wr == 1) PG8_BAR; }
    }
    PG8_WAIT_V(0);
    if constexpr (!ALIGN_EPI) { if (wr == 0) PG8_BAR; }
    PG8_BAR;
    if constexpr (Epi::AFTER_DRAIN) { E.fused(acc, cur, wr, wc, fr, fq, lds, wid, lane); S.done(cur); }
#undef PG8_SA
#undef PG8_SB
#undef PG8_STAGE
#undef PG8_LDA
#undef PG8_LDB
#undef PG8_MMA
#undef PG8_WAIT_V
#undef PG8_WAIT_L
#undef PG8_BAR
#undef PG8_SCHED
}
}

constexpr int NWAVES = 8, NTHREADS = 512;
constexpr int BATCH = 2, T = 8192, D = 1024, M = BATCH * T;
constexpr int SGF = 6144, SGW = 3072, SGC = 384;
constexpr int KD = 512, VD = 1024, DK = 128, DV = 256, GIN = 3088, GIN_PAD = 3328;
constexpr int FH = 2816;
constexpr int NITEM = (M / 64) * 4;
constexpr float EPS = 1e-6f;
static_assert(M == pg8::EM, "rows");

constexpr size_t MiB = 1u << 20;
constexpr size_t WS_WAIN = 1 * MiB, WS_WAOUT = 13 * MiB, WS_WGU0 = 19 * MiB, WS_WGU1 = 30 * MiB, WS_WDN0 = 41 * MiB, WS_WDN1 = 46 * MiB + MiB / 2;
constexpr size_t WS_WBIN = 52 * MiB, WS_WBOUT = 58 * MiB + MiB / 2, WS_WM = 60 * MiB + MiB / 2;
constexpr size_t WS_RU = 61 * MiB, WS_RV = 157 * MiB;
constexpr size_t WS_RSQ = 253 * MiB, WS_GZ = 253 * MiB + MiB / 2, WS_DEC = 254 * MiB + MiB / 2, WS_END = 256 * MiB;
constexpr int LDS_BYTES = 147456, RING_BYTES = 131072;

#define GAS __attribute__((address_space(1)))
#define LAS __attribute__((address_space(3)))
typedef unsigned short bf16;
typedef unsigned v4u __attribute__((ext_vector_type(4)));
typedef unsigned v2u __attribute__((ext_vector_type(2)));
typedef float f32x4 __attribute__((ext_vector_type(4)));
typedef float f32x2 __attribute__((ext_vector_type(2)));
typedef short bf16x8 __attribute__((ext_vector_type(8)));
typedef short s16x4 __attribute__((ext_vector_type(4)));
#define LDS_WAIT() asm volatile("s_waitcnt lgkmcnt(0)" ::: "memory")
__device__ __forceinline__ unsigned f2bf(float f) { unsigned u = __builtin_bit_cast(unsigned, f); return (u + 0x7fffu + ((u >> 16) & 1u)) >> 16; }
__device__ __forceinline__ unsigned pk2(float lo, float hi) { return pg8::cvt_pk_bf16(lo, hi); }
__device__ __forceinline__ float bf_lo(unsigned w) { return __builtin_bit_cast(float, w << 16); }
__device__ __forceinline__ float bf_hi(unsigned w) { return __builtin_bit_cast(float, w & 0xffff0000u); }
__device__ __forceinline__ float bf1(bf16 h) { return __builtin_bit_cast(float, (unsigned)h << 16); }
__device__ __forceinline__ float wave_sum(float v) {
#pragma unroll
    for (int o = 1; o < 64; o <<= 1) v += __shfl_xor(v, o);
    return v;
}
#ifndef USE_TR
#define USE_TR 1
#endif
__device__ __forceinline__ bf16x8 tr_frag(LAS unsigned char* tile, int pitch, int k0, int n0, int lane) {
#if USE_TR
    const int g = lane >> 4, q = (lane & 15) >> 2, p = lane & 3;
    LAS unsigned char* a0 = tile + (k0 + 8 * g + q) * pitch + (n0 + 4 * p) * 2;
    const s16x4 lo = __builtin_amdgcn_ds_read_tr16_b64_v4i16((LAS s16x4*)a0);
    const s16x4 hi = __builtin_amdgcn_ds_read_tr16_b64_v4i16((LAS s16x4*)(a0 + 4 * pitch));
    return (bf16x8){lo[0], lo[1], lo[2], lo[3], hi[0], hi[1], hi[2], hi[3]};
#else
    bf16x8 r; const int g = lane >> 4;
#pragma unroll
    for (int j = 0; j < 8; ++j) r[j] = *(LAS short*)(tile + (k0 + 8 * g + j) * pitch + (n0 + (lane & 15)) * 2);
    return r;
#endif
}
__device__ __forceinline__ bf16x8 tr_frag_p(LAS unsigned char* tile, int pitch, int k0, int nbase, int pstride, int lane) {
    const int g = lane >> 4, q = (lane & 15) >> 2, p = lane & 3;
    LAS unsigned char* a0 = tile + (k0 + 8 * g + q) * pitch + (nbase + pstride * p) * 2;
    const s16x4 lo = __builtin_amdgcn_ds_read_tr16_b64_v4i16((LAS s16x4*)a0);
    const s16x4 hi = __builtin_amdgcn_ds_read_tr16_b64_v4i16((LAS s16x4*)(a0 + 4 * pitch));
    return (bf16x8){lo[0], lo[1], lo[2], lo[3], hi[0], hi[1], hi[2], hi[3]};
}
#define MFMA16(a, b, c) __builtin_amdgcn_mfma_f32_16x16x32_bf16((a), (b), (c), 0, 0, 0)

__device__ __forceinline__ void p0_transpose_item(const float* W, int K, int N, bf16* WT, int drow0, const float* gain, LAS float* scr, int k0, int n0, int lane) {
    const int n = n0 + (lane & 31); float v[32];
#pragma unroll
    for (int i = 0; i < 32; ++i) { const int kk = 2 * i + (lane >> 5); v[i] = (n < N) ? W[(size_t)(k0 + kk) * N + n] : 0.f; }
    if (gain) {
#pragma unroll
        for (int i = 0; i < 32; ++i) v[i] *= gain[k0 + 2 * i + (lane >> 5)]; }
#pragma unroll
    for (int i = 0; i < 32; ++i) scr[(2 * i + (lane >> 5)) * 33 + (lane & 31)] = v[i];
    LDS_WAIT(); asm volatile("" ::: "memory");
    const int c = lane & 7;
#pragma unroll
    for (int j = 0; j < 4; ++j) { const int nn = (lane >> 3) + 8 * j; const LAS float* s = scr + (8 * c) * 33 + nn;
        v4u o; o.x = pk2(s[0 * 33], s[1 * 33]); o.y = pk2(s[2 * 33], s[3 * 33]); o.z = pk2(s[4 * 33], s[5 * 33]); o.w = pk2(s[6 * 33], s[7 * 33]);
        *(GAS v4u*)(WT + (size_t)(drow0 + nn) * K + k0 + 8 * c) = o; }
    LDS_WAIT(); asm volatile("" ::: "memory");
}

struct Args { const float* in[18]; float* out; unsigned char* ws; int ph_lo, ph_hi; };

__device__ __forceinline__ void p0_prologue(const Args& A, LAS unsigned char* lds, int gw, int NGW, int lane, int wave, int gtid, int NGT) {
    LAS float* scr = (LAS float*)(lds + wave * 16384);
    unsigned char* ws = A.ws;
    const float* mixn = A.in[1]; const float* ffnn = A.in[13];
    constexpr int I_AIN = 16 * 192, I_AOUT = 48 * 32, I_GU = 16 * 88, I_DN = 44 * 32, I_BIN = 16 * 97, I_BOUT = 16 * 32;
    constexpr int NITEMS = I_AIN + I_AOUT + 4 * I_GU + 2 * I_DN + I_BIN + I_BOUT;
    for (int it = gw; it < NITEMS; it += NGW) {
        int r = it;
        if (r < I_AIN) { const int kb = r / 192, nb = r % 192, n0 = 32 * nb, isv = n0 >= SGW, j0 = n0 - SGW * isv;
            p0_transpose_item(A.in[2], D, SGF, (bf16*)(ws + WS_WAIN), 256 * (j0 >> 7) + (j0 & 127) + 128 * isv, mixn, scr, 64 * kb, n0, lane); continue; } r -= I_AIN;
        if (r < I_AOUT) { const int kb = r / 32, nb = r % 32; p0_transpose_item(A.in[7], SGW, D, (bf16*)(ws + WS_WAOUT), 32 * nb, nullptr, scr, 64 * kb, 32 * nb, lane); continue; } r -= I_AOUT;
        if (r < 4 * I_GU) { const int l = r / (2 * I_GU), r2 = r % (2 * I_GU), up = r2 / I_GU, r3 = r2 % I_GU, kb = r3 / 88, nb = r3 % 88, n0 = 32 * nb;
            const float* W = (up ? A.in[15] : A.in[14]) + (size_t)l * D * FH;
            p0_transpose_item(W, D, FH, (bf16*)(ws + (l ? WS_WGU1 : WS_WGU0)), 256 * (n0 >> 7) + (n0 & 127) + 128 * up, ffnn + l * D, scr, 64 * kb, n0, lane); continue; } r -= 4 * I_GU;
        if (r < 2 * I_DN) { const int l = r / I_DN, r2 = r % I_DN, kb = r2 / 32, nb = r2 % 32;
            p0_transpose_item(A.in[16] + (size_t)l * FH * D, FH, D, (bf16*)(ws + (l ? WS_WDN1 : WS_WDN0)), 32 * nb, nullptr, scr, 64 * kb, 32 * nb, lane); continue; } r -= 2 * I_DN;
        if (r < I_BIN) { const int kb = r / 97, nb = r % 97; p0_transpose_item(A.in[8], D, GIN, (bf16*)(ws + WS_WBIN), 32 * nb, mixn + D, scr, 64 * kb, 32 * nb, lane); continue; } r -= I_BIN;
        { const int kb = r / 32, nb = r % 32; p0_transpose_item(A.in[12], D, D, (bf16*)(ws + WS_WBOUT), 32 * nb, nullptr, scr, 64 * kb, 32 * nb, lane); }
    }
    { GAS v4u* z = (GAS v4u*)(ws + WS_WBIN + (size_t)3104 * D * 2); const int nz = (GIN_PAD - 3104) * D * 2 / 16;
      for (int i = gtid; i < nz; i += NGT) z[i] = (v4u){0u, 0u, 0u, 0u}; }
    { const float* wsrc = A.in[5]; bf16* wm = (bf16*)(ws + WS_WM);
      for (int i = gtid; i < 8 * 128 * 128 / 2; i += NGT) { const int e = 2 * i, t = (e >> 7) & 127, s = e & 127; const bool keep = (t >= 64) || (s < 64);
          const f32x2 v = *(const f32x2*)(wsrc + e); ((GAS unsigned*)wm)[i] = keep ? pk2(v.x, v.y) : 0u; } }
    { const float* x = A.in[0]; bf16* xb0 = (bf16*)A.out; float* rsq = (float*)(ws + WS_RSQ);
      for (int m0 = gw; m0 < M; m0 += 4 * NGW) { f32x4 v[4][4];
#pragma unroll
          for (int r = 0; r < 4; ++r) { const int m = m0 + r * NGW; if (m < M) { const GAS f32x4* xr = (const GAS f32x4*)(x + (size_t)m * D) + lane;
#pragma unroll
              for (int j = 0; j < 4; ++j) v[r][j] = xr[64 * j]; } }
#pragma unroll
          for (int r = 0; r < 4; ++r) { const int m = m0 + r * NGW; if (m < M) { float s = 0.f;
#pragma unroll
              for (int j = 0; j < 4; ++j) s += (v[r][j].x * v[r][j].x + v[r][j].y * v[r][j].y) + (v[r][j].z * v[r][j].z + v[r][j].w * v[r][j].w);
              s = wave_sum(s);
              GAS v2u* o8 = (GAS v2u*)(xb0 + (size_t)m * D) + lane;
#pragma unroll
              for (int j = 0; j < 4; ++j) o8[64 * j] = (v2u){pk2(v[r][j].x, v[r][j].y), pk2(v[r][j].z, v[r][j].w)};
              if (lane == 0) *(f32x4*)(rsq + (size_t)m * 4) = (f32x4){s, 0.f, 0.f, 0.f}; } } } }
}

__device__ __forceinline__ void sgu_phase(LAS unsigned char* lds, const bf16* Wm, const bf16* V, bf16* UY, const f32x2* statP, const float* ln_g, const float* ln_b, const float* b_s,
                                          int G, int bid, int tid, int lane, int wid) {
    constexpr int PA = 272, BSZ = 34816;
    LAS unsigned char* As = lds;
    LAS f32x2* red = (LAS f32x2*)(lds + 3 * BSZ); LAS f32x2* murs = (LAS f32x2*)(lds + 3 * BSZ + 4096);
    const int wr = wid >> 2, wc = wid & 3, fr = lane & 15, fq = lane >> 4;
    const int ch = tid & 15, srow = tid >> 4;
#define SGU_C0(i) ((hh * 4 + (i) / 3) * SGC + ((i) % 3) * 128)
#define SGU_LOADV(i) do { const int c0_ = SGU_C0(i); _Pragma("unroll") for (int q_ = 0; q_ < 4; ++q_) vraw[q_] = *(const GAS v4u*)(V + (size_t)(row0 + srow + 32 * q_) * SGW + c0_ + 8 * ch); \
        lg0 = *(const f32x4*)(ln_g + c0_ + 8 * ch); lg1 = *(const f32x4*)(ln_g + c0_ + 8 * ch + 4); lb0 = *(const f32x4*)(ln_b + c0_ + 8 * ch); lb1 = *(const f32x4*)(ln_b + c0_ + 8 * ch + 4); } while (0)
#define SGU_LN(buf) do { LAS unsigned char* Bs_ = lds + BSZ + (buf) * BSZ; _Pragma("unroll") for (int q_ = 0; q_ < 4; ++q_) { const int s_ = srow + 32 * q_; const v4u raw = vraw[q_]; const f32x2 ms = murs[s_]; \
        const f32x4 a_ = (f32x4){bf_lo(raw.x), bf_hi(raw.x), bf_lo(raw.y), bf_hi(raw.y)}, b_ = (f32x4){bf_lo(raw.z), bf_hi(raw.z), bf_lo(raw.w), bf_hi(raw.w)}; \
        const f32x4 ya = (a_ - ms.x) * ms.y * lg0 + lb0, yb = (b_ - ms.x) * ms.y * lg1 + lb1; \
        *(LAS v4u*)(Bs_ + s_ * PA + ch * 16) = (v4u){pk2(ya[0], ya[1]), pk2(ya[2], ya[3]), pk2(yb[0], yb[1]), pk2(yb[2], yb[3])}; } } while (0)
#define SGU_STAGE_A(g) do { _Pragma("unroll") for (int q_ = 0; q_ < 4; ++q_) { const int id_ = tid + 512 * q_, r_ = id_ >> 4, c_ = id_ & 15; \
        *(LAS v4u*)(As + r_ * PA + c_ * 16) = *(const GAS v4u*)(Wm + (size_t)((g) * 128 + r_) * 128 + c_ * 8); } } while (0)
    for (int item = bid; item < 256; item += G) {
        const int w = item >> 1, hh = item & 1, row0 = w * 128;
        v4u vraw[4]; f32x4 lg0, lg1, lb0, lb1;
        SGU_LOADV(0);
        { const int r = tid & 127, part = tid >> 7; float s1 = 0.f, s2 = 0.f;
#pragma unroll
          for (int j = 0; j < 24; ++j) { const f32x2 p = statP[(size_t)(part * 24 + j) * M + row0 + r]; s1 += p.x; s2 += p.y; }
          red[part * 128 + r] = (f32x2){s1, s2}; }
        SGU_STAGE_A(hh * 4);
        __syncthreads();
        if (tid < 128) { const f32x2 a = red[tid], b = red[128 + tid], c = red[256 + tid], d = red[384 + tid];
            const float mean = ((a.x + b.x) + (c.x + d.x)) * (1.0f / 3072.0f), ex2 = ((a.y + b.y) + (c.y + d.y)) * (1.0f / 3072.0f);
            murs[tid] = (f32x2){mean, __builtin_amdgcn_rsqf(fmaxf(ex2 - mean * mean, 0.f) + EPS)}; }
        __syncthreads();
        SGU_LN(0);
        SGU_LOADV(1);
        for (int i = 0; i < 12; ++i) { const int g = hh * 4 + i / 3, c0 = SGU_C0(i);
            v4u uu[4]; float bs[4];
#pragma unroll
            for (int m = 0; m < 4; ++m) { const int t = wr * 64 + m * 16 + fr; bs[m] = b_s[g * 128 + t];
                uu[m] = *(const GAS v4u*)(UY + (size_t)(row0 + t) * SGW + c0 + wc * 32 + 8 * fq); }
            __syncthreads();
            LAS unsigned char* Bs = lds + BSZ + (i & 1) * BSZ;
            f32x4 acc[4][2];
#pragma unroll
            for (int m = 0; m < 4; ++m) { acc[m][0] = (f32x4){0.f, 0.f, 0.f, 0.f}; acc[m][1] = (f32x4){0.f, 0.f, 0.f, 0.f}; }
#pragma unroll
            for (int ks = 0; ks < 4; ++ks) { bf16x8 bfr[4];
#pragma unroll
                for (int m = 0; m < 4; ++m) bfr[m] = *(const LAS bf16x8*)(As + (wr * 64 + m * 16 + fr) * PA + (ks * 32 + fq * 8) * 2);
#pragma unroll
                for (int n = 0; n < 2; ++n) { const bf16x8 afr = tr_frag_p(Bs, PA, ks * 32, wc * 32 + 4 * n, 8, lane);
#pragma unroll
                    for (int m = 0; m < 4; ++m) acc[m][n] = MFMA16(afr, bfr[m], acc[m][n]); } }
            if (i + 1 < 12) {
                if ((i + 1) % 3 == 0) { __syncthreads(); SGU_STAGE_A(g + 1); }
                SGU_LN((i + 1) & 1);
                if (i + 2 < 12) SGU_LOADV(i + 2);
            }
#pragma unroll
            for (int m = 0; m < 4; ++m) { const int t = wr * 64 + m * 16 + fr; const v4u u4 = uu[m]; const f32x4 s0 = acc[m][0] + bs[m], s1 = acc[m][1] + bs[m];
                const f32x2 ga = pg8::gelu_pk((f32x2){bf_lo(u4.x), bf_hi(u4.x)}), gb = pg8::gelu_pk((f32x2){bf_lo(u4.y), bf_hi(u4.y)}), gc = pg8::gelu_pk((f32x2){bf_lo(u4.z), bf_hi(u4.z)}), gd = pg8::gelu_pk((f32x2){bf_lo(u4.w), bf_hi(u4.w)});
                *(GAS v4u*)(UY + (size_t)(row0 + t) * SGW + c0 + wc * 32 + 8 * fq) = (v4u){pk2(ga.x * s0[0], ga.y * s0[1]), pk2(gb.x * s0[2], gb.y * s0[3]), pk2(gc.x * s1[0], gc.y * s1[1]), pk2(gd.x * s1[2], gd.y * s1[3])}; }
        }
        __syncthreads();
    }
#undef SGU_C0
#undef SGU_LOADV
#undef SGU_LN
#undef SGU_STAGE_A
}

__device__ __forceinline__ float logsig16(float z) { return (fminf(z, 0.f) - __logf(1.0f + __expf(-fabsf(z)))) * (1.0f / 16.0f); }
constexpr int L_GZ = 0, L_TOT = 4096, L_GS = 8192, L_KT = 40960, L_QT = 58368, L_VT = 75776, L_PM = 109568, L_RED = 118784;
constexpr int PK = 272, PV = 528, PP = 144;
#define GLA_G(lds, pgz, w2, bg, tid) do { \
    LAS float* gzs_ = (LAS float*)((lds) + L_GZ); LAS float* tot_ = (LAS float*)((lds) + L_TOT); LAS float* Gs_ = (LAS float*)((lds) + L_GS); \
    if ((tid) < 256) *(LAS f32x4*)(gzs_ + 4 * (tid)) = (pgz); \
    const int kk_ = (tid) & 127, seg_ = (tid) >> 7; \
    __syncthreads(); \
    float run_ = 0.f, Gv_[16]; \
    _Pragma("unroll") for (int tt_ = 0; tt_ < 16; ++tt_) { const LAS f32x4* gr_ = (const LAS f32x4*)(gzs_ + (seg_ * 16 + tt_) * 16); float z_ = (bg); \
        _Pragma("unroll") for (int q_ = 0; q_ < 4; ++q_) { const f32x4 g4_ = gr_[q_]; z_ += g4_[0] * (w2)[4 * q_] + g4_[1] * (w2)[4 * q_ + 1] + g4_[2] * (w2)[4 * q_ + 2] + g4_[3] * (w2)[4 * q_ + 3]; } \
        run_ += logsig16(z_); Gv_[tt_] = run_; } \
    tot_[seg_ * 128 + kk_] = run_; \
    __syncthreads(); \
    { const float t0_ = tot_[kk_], t1_ = tot_[128 + kk_], t2_ = tot_[256 + kk_]; \
      const float pre_ = (seg_ > 0 ? t0_ : 0.f) + (seg_ > 1 ? t1_ : 0.f) + (seg_ > 2 ? t2_ : 0.f); \
      _Pragma("unroll") for (int tt_ = 0; tt_ < 16; ++tt_) Gs_[(seg_ * 16 + tt_) * 128 + kk_] = Gv_[tt_] + pre_; } \
    __syncthreads(); \
} while (0)
#define UNPK8(W_, lo4, hi4) do { const v4u w__ = (W_); lo4 = (f32x4){bf_lo(w__.x), bf_hi(w__.x), bf_lo(w__.y), bf_hi(w__.y)}; hi4 = (f32x4){bf_lo(w__.z), bf_hi(w__.z), bf_lo(w__.w), bf_hi(w__.w)}; } while (0)
__device__ __forceinline__ f32x4 exp4(f32x4 v) { return (f32x4){__expf(v[0]), __expf(v[1]), __expf(v[2]), __expf(v[3])}; }
__device__ __forceinline__ v4u pack8(f32x4 a, f32x4 b) { return (v4u){pk2(a[0], a[1]), pk2(a[2], a[3]), pk2(b[0], b[1]), pk2(b[2], b[3])}; }

__device__ __forceinline__ void gla_state_phase(LAS unsigned char* lds, const bf16* Kg, const bf16* Vg, const float* GZ, const float* w_g2, const float* b_g, bf16* dS, float* dec,
                                                int G, int bid, int tid, int lane, int wid) {
    const int fr = lane & 15, fq = lane >> 4, h = bid & 3;
    float w2[16];
#pragma unroll
    for (int r = 0; r < 16; ++r) w2[r] = w_g2[r * KD + h * DK + (tid & 127)];
    const float bg = b_g[h * DK + (tid & 127)];
    v4u pk_[2], pv_[4]; f32x4 pgz = (f32x4){0.f, 0.f, 0.f, 0.f};
#define P7_LOAD(it_) do { const int r0_ = ((it_) >> 2) * 64; if (tid < 256) pgz = *(const GAS f32x4*)(GZ + (size_t)r0_ * 16 + 4 * tid); \
        _Pragma("unroll") for (int j_ = 0; j_ < 2; ++j_) { const int id_ = tid + 512 * j_; pk_[j_] = *(const GAS v4u*)(Kg + (size_t)(r0_ + (id_ >> 4)) * KD + h * DK + 8 * (id_ & 15)); } \
        _Pragma("unroll") for (int j_ = 0; j_ < 4; ++j_) { const int id_ = tid + 512 * j_; pv_[j_] = *(const GAS v4u*)(Vg + (size_t)(r0_ + (id_ >> 5)) * VD + h * DV + 8 * (id_ & 31)); } } while (0)
    int item = bid;
    if (item < NITEM) P7_LOAD(item);
    for (; item < NITEM; item += G) {
        GLA_G(lds, pgz, w2, bg, tid);
        const LAS float* Gs = (const LAS float*)(lds + L_GS);
#pragma unroll
        for (int j = 0; j < 2; ++j) { const int id = tid + 512 * j, t = id >> 4, c8 = id & 15; f32x4 k0, k1; UNPK8(pk_[j], k0, k1);
            const f32x4 g0 = *(const LAS f32x4*)(Gs + t * 128 + 8 * c8), g1 = *(const LAS f32x4*)(Gs + t * 128 + 8 * c8 + 4), l0 = *(const LAS f32x4*)(Gs + 63 * 128 + 8 * c8), l1 = *(const LAS f32x4*)(Gs + 63 * 128 + 8 * c8 + 4);
            *(LAS v4u*)(lds + L_KT + t * PK + c8 * 16) = pack8(k0 * exp4(l0 - g0), k1 * exp4(l1 - g1)); }
#pragma unroll
        for (int j = 0; j < 4; ++j) { const int id = tid + 512 * j; *(LAS v4u*)(lds + L_VT + (id >> 5) * PV + (id & 31) * 16) = pv_[j]; }
        if (tid < 128) dec[(size_t)item * DK + tid] = __expf(Gs[63 * 128 + tid]);
        if (item + G < NITEM) P7_LOAD(item + G);
        __syncthreads();
        f32x4 acc[2][8];
#pragma unroll
        for (int d = 0; d < 2; ++d)
#pragma unroll
            for (int kt = 0; kt < 8; ++kt) acc[d][kt] = (f32x4){0.f, 0.f, 0.f, 0.f};
#pragma unroll
        for (int ks = 0; ks < 2; ++ks) { bf16x8 bfr[2];
#pragma unroll
            for (int d = 0; d < 2; ++d) bfr[d] = tr_frag_p(lds + L_VT, PV, ks * 32, 16 * (2 * wid + d), 4, lane);
#pragma unroll
            for (int kt = 0; kt < 8; ++kt) { const bf16x8 afr = tr_frag_p(lds + L_KT, PK, ks * 32, 32 * (kt >> 1) + 4 * (kt & 1), 8, lane);
#pragma unroll
                for (int d = 0; d < 2; ++d) acc[d][kt] = MFMA16(afr, bfr[d], acc[d][kt]); } }
#pragma unroll
        for (int d = 0; d < 2; ++d) { bf16* rowp = dS + (size_t)item * (DV * DK) + (size_t)(16 * (2 * wid + d) + fr) * DK + 8 * fq;
#pragma unroll
            for (int kp = 0; kp < 4; ++kp) *(GAS v4u*)(rowp + 32 * kp) = pack8(acc[d][2 * kp], acc[d][2 * kp + 1]); }
    }
#undef P7_LOAD
}

__device__ __forceinline__ void gla_scan_phase(bf16* dS, const float* dec, int gtid, int NGT) {
    for (int e = gtid; e < 8 * DV * DK / 2; e += NGT) {
        const int bh = e >> 14, rem = e & 16383, b = bh >> 2, h = bh & 3;
        GAS unsigned* p = (GAS unsigned*)(dS + ((size_t)(b * 128) * 4 + h) * (DV * DK)) + rem;
        const GAS f32x2* dp = (const GAS f32x2*)(dec + ((size_t)(b * 128) * 4 + h) * DK) + (rem & 63);
        float s0 = 0.f, s1 = 0.f;
        for (int n0 = 0; n0 < 128; n0 += 8) { unsigned d[8]; f32x2 dc[8];
#pragma unroll
            for (int j = 0; j < 8; ++j) { d[j] = p[(size_t)(n0 + j) * (2 * DV * DK)]; dc[j] = dp[(size_t)(n0 + j) * (2 * DK)]; }
#pragma unroll
            for (int j = 0; j < 8; ++j) { p[(size_t)(n0 + j) * (2 * DV * DK)] = pk2(s0, s1); s0 = s0 * dc[j].x + bf_lo(d[j]); s1 = s1 * dc[j].y + bf_hi(d[j]); } }
    }
}

__device__ __forceinline__ void gla_out_phase(LAS unsigned char* lds, const bf16* Qg, const bf16* Kg, const bf16* Vg, bf16* SROG, const float* GZ, const float* w_g2, const float* b_g, const float* gn_g,
                                              const bf16* Sprev, int G, int bid, int tid, int lane, int wid) {
    const int fr = lane & 15, fq = lane >> 4, h = bid & 3;
    LAS float* red = (LAS float*)(lds + L_RED);
    float w2[16];
#pragma unroll
    for (int r = 0; r < 16; ++r) w2[r] = w_g2[r * KD + h * DK + (tid & 127)];
    const float bg = b_g[h * DK + (tid & 127)];
    const int dvl = 32 * wid + 8 * fq;
    const f32x4 gn0 = *(const f32x4*)(gn_g + h * DV + dvl), gn1 = *(const f32x4*)(gn_g + h * DV + dvl + 4);
    v4u pq_[2], pk_[2], pv_[4]; f32x4 pgz = (f32x4){0.f, 0.f, 0.f, 0.f};
#define P9_LOAD(it_) do { const int r0_ = ((it_) >> 2) * 64; if (tid < 256) pgz = *(const GAS f32x4*)(GZ + (size_t)r0_ * 16 + 4 * tid); \
        _Pragma("unroll") for (int j_ = 0; j_ < 2; ++j_) { const int id_ = tid + 512 * j_; const size_t go_ = (size_t)(r0_ + (id_ >> 4)) * KD + h * DK + 8 * (id_ & 15); pq_[j_] = *(const GAS v4u*)(Qg + go_); pk_[j_] = *(const GAS v4u*)(Kg + go_); } \
        _Pragma("unroll") for (int j_ = 0; j_ < 4; ++j_) { const int id_ = tid + 512 * j_; pv_[j_] = *(const GAS v4u*)(Vg + (size_t)(r0_ + (id_ >> 5)) * VD + h * DV + 8 * (id_ & 31)); } } while (0)
    int item = bid;
    if (item < NITEM) P9_LOAD(item);
    for (; item < NITEM; item += G) {
        const int r0 = (item >> 2) * 64;
        bf16x8 sp[4][2]; v4u sr[4];
        { const int i = lane & 15; const bf16* sb = Sprev + (size_t)item * (DV * DK) + 8 * fq;
#pragma unroll
          for (int ks = 0; ks < 4; ++ks)
#pragma unroll
              for (int d = 0; d < 2; ++d) sp[ks][d] = *(const GAS bf16x8*)(sb + (size_t)(32 * wid + 8 * (i >> 2) + 4 * d + (i & 3)) * DK + 32 * ks); }
#pragma unroll
        for (int it = 0; it < 4; ++it) sr[it] = *(const GAS v4u*)(SROG + (size_t)(r0 + 16 * it + fr) * VD + h * DV + dvl);
        GLA_G(lds, pgz, w2, bg, tid);
        const LAS float* Gs = (const LAS float*)(lds + L_GS);
#pragma unroll
        for (int j = 0; j < 2; ++j) { const int id = tid + 512 * j, t = id >> 4, c8 = id & 15; f32x4 q0, q1, k0, k1; UNPK8(pq_[j], q0, q1); UNPK8(pk_[j], k0, k1);
            const f32x4 g0 = *(const LAS f32x4*)(Gs + t * 128 + 8 * c8), g1 = *(const LAS f32x4*)(Gs + t * 128 + 8 * c8 + 4);
            *(LAS v4u*)(lds + L_QT + t * PK + c8 * 16) = pack8(q0 * exp4(g0), q1 * exp4(g1));
            *(LAS v4u*)(lds + L_KT + t * PK + c8 * 16) = pack8(k0 * exp4(-g0), k1 * exp4(-g1)); }
#pragma unroll
        for (int j = 0; j < 4; ++j) { const int id = tid + 512 * j; *(LAS v4u*)(lds + L_VT + (id >> 5) * PV + (id & 31) * 16) = pv_[j]; }
        if (item + G < NITEM) P9_LOAD(item + G);
        __syncthreads();
        { const int it = wid >> 1;
#pragma unroll
          for (int jj = 0; jj < 2; ++jj) { const int jt = 2 * (wid & 1) + jj; f32x4 pa = (f32x4){0.f, 0.f, 0.f, 0.f};
#pragma unroll
              for (int ks = 0; ks < 4; ++ks) { const bf16x8 a = *(const LAS bf16x8*)(lds + L_KT + (16 * jt + fr) * PK + (32 * ks + 8 * fq) * 2), b = *(const LAS bf16x8*)(lds + L_QT + (16 * it + fr) * PK + (32 * ks + 8 * fq) * 2);
                  pa = MFMA16(a, b, pa); }
              const int i = 16 * it + fr, j0 = 16 * jt + 4 * fq;
              *(LAS v2u*)(lds + L_PM + i * PP + j0 * 2) = (v2u){pk2(j0 <= i ? pa[0] : 0.f, j0 + 1 <= i ? pa[1] : 0.f), pk2(j0 + 2 <= i ? pa[2] : 0.f, j0 + 3 <= i ? pa[3] : 0.f)}; } }
        __syncthreads();
        f32x4 acc[4][2];
#pragma unroll
        for (int it = 0; it < 4; ++it) { acc[it][0] = (f32x4){0.f, 0.f, 0.f, 0.f}; acc[it][1] = (f32x4){0.f, 0.f, 0.f, 0.f}; }
#pragma unroll
        for (int ks = 0; ks < 2; ++ks) { bf16x8 a[2];
#pragma unroll
            for (int d = 0; d < 2; ++d) a[d] = tr_frag_p(lds + L_VT, PV, ks * 32, 32 * wid + 4 * d, 8, lane);
#pragma unroll
            for (int it = 0; it < 4; ++it) { const bf16x8 b = *(const LAS bf16x8*)(lds + L_PM + (16 * it + fr) * PP + (32 * ks + 8 * fq) * 2);
#pragma unroll
                for (int d = 0; d < 2; ++d) acc[it][d] = MFMA16(a[d], b, acc[it][d]); } }
#pragma unroll
        for (int ks = 0; ks < 4; ++ks) {
#pragma unroll
            for (int it = 0; it < 4; ++it) { const bf16x8 b = *(const LAS bf16x8*)(lds + L_QT + (16 * it + fr) * PK + (32 * ks + 8 * fq) * 2);
#pragma unroll
                for (int d = 0; d < 2; ++d) acc[it][d] = MFMA16(sp[ks][d], b, acc[it][d]); } }
#pragma unroll
        for (int it = 0; it < 4; ++it) { float ss = 0.f;
#pragma unroll
            for (int d = 0; d < 2; ++d) ss += (acc[it][d][0] * acc[it][d][0] + acc[it][d][1] * acc[it][d][1]) + (acc[it][d][2] * acc[it][d][2] + acc[it][d][3] * acc[it][d][3]);
            ss += __shfl_xor(ss, 16); ss += __shfl_xor(ss, 32);
            if (fq == 0) red[wid * 64 + 16 * it + fr] = ss; }
        __syncthreads();
#pragma unroll
        for (int it = 0; it < 4; ++it) { const int i = 16 * it + fr; float tot = 0.f;
#pragma unroll
            for (int w8 = 0; w8 < 8; ++w8) tot += red[w8 * 64 + i];
            const float rms = __builtin_amdgcn_rsqf(tot * (1.0f / 256.0f) + EPS);
            f32x4 s0, s1; UNPK8(sr[it], s0, s1);
            *(GAS v4u*)(SROG + (size_t)(r0 + i) * VD + h * DV + dvl) = pack8(acc[it][0] * rms * gn0 * s0, acc[it][1] * rms * gn1 * s1); }
    }
#undef P9_LOAD
}

#define XB_TMO      128
#define XB_XCNT(j)  (256  + 64 * (j))
#define XB_XSUB(j)  (1280 + 64 * (j))
#define XB_XGEN(j)  (2304 + 64 * (j))
#define XB_TOP      3328
#define XB_TOPGEN   3392
#define XCD_BAR_WORDS 3456
#define XB_SPIN_CAP (1u << 18)

__device__ __forceinline__ unsigned xb_ld(unsigned* p)              { return __hip_atomic_load(p, __ATOMIC_RELAXED, __HIP_MEMORY_SCOPE_AGENT); }
__device__ __forceinline__ unsigned xb_add(unsigned* p, unsigned v) { return __hip_atomic_fetch_add(p, v, __ATOMIC_RELAXED, __HIP_MEMORY_SCOPE_AGENT); }
__device__ __forceinline__ unsigned xb_xcc_id() { return (unsigned)__builtin_amdgcn_s_getreg((3 << 11) | 20) & 0xFu; }
#define XB_SPIN(cond, bar) do { unsigned _sp = 0; while (cond) { __builtin_amdgcn_s_sleep(1); \
    if ((++_sp & 255u) == 0u) { if (xb_ld(&(bar)[XB_TMO])) break; if (_sp > XB_SPIN_CAP) { atomicAdd(&(bar)[XB_TMO], 1u); break; } } } } while (0)

struct XcdBarrier {
    unsigned* bar; unsigned x;
    volatile LAS unsigned* st;
};

__device__ __forceinline__ XcdBarrier xcd_barrier_post(unsigned* bar, volatile LAS unsigned* st) {
    XcdBarrier b; b.bar = bar; b.x = xb_xcc_id(); b.st = st;
    if (threadIdx.x == 0) (void)xb_add(&bar[XB_XCNT(b.x)], 1u);
    return b;
}
__device__ __forceinline__ void xcd_barrier_complete(unsigned* bar, unsigned x, unsigned& nloc, unsigned& nx) {
    const unsigned G = gridDim.x * gridDim.y * gridDim.z;
    unsigned sum, cnt, mine, sp = 0u;
    for (;;) {
        sum = 0u; cnt = 0u; mine = 0u;
#pragma unroll
        for (unsigned j = 0; j < 16; ++j) { const unsigned c = xb_ld(&bar[XB_XCNT(j)]); sum += c; cnt += (c > 0u) ? 1u : 0u; mine = (j == x) ? c : mine; }
        if (sum == G) break;
        __builtin_amdgcn_s_sleep(1);
        if ((++sp & 255u) == 0u) { if (xb_ld(&bar[XB_TMO])) break; if (sp > XB_SPIN_CAP) { atomicAdd(&bar[XB_TMO], 1u); break; } }
    }
    nloc = mine > 0u ? mine : 1u; nx = cnt > 0u ? cnt : 1u;
}

__device__ __forceinline__ void xcd_barrier(const XcdBarrier& b) {
    asm volatile("s_waitcnt vmcnt(0)" ::: "memory");
    __syncthreads();
    if (threadIdx.x == 0) {
        unsigned* bar = b.bar;
        __builtin_amdgcn_s_waitcnt(0);
        unsigned nloc = b.st[0], nx = b.st[1];
        if (nloc == 0u) { xcd_barrier_complete(bar, b.x, nloc, nx); b.st[0] = nloc; b.st[1] = nx; }
        const unsigned old = xb_add(&bar[XB_XSUB(b.x)], 1u);
        const unsigned gen = old / nloc;
        if (old + 1u == (gen + 1u) * nloc) {
            __builtin_amdgcn_fence(__ATOMIC_RELEASE, "agent");
            asm volatile("s_waitcnt vmcnt(0)" ::: "memory");
            const unsigned og = xb_add(&bar[XB_TOP], 1u);
            const unsigned tg = og / nx;
            if (og + 1u == (tg + 1u) * nx) xb_add(&bar[XB_TOPGEN], 1u);
            else XB_SPIN(xb_ld(&bar[XB_TOPGEN]) == tg, bar);
            __builtin_amdgcn_fence(__ATOMIC_ACQUIRE, "agent");
            xb_add(&bar[XB_XGEN(b.x)], 1u);
            asm volatile("s_waitcnt vmcnt(0)" ::: "memory");
        } else {
            XB_SPIN(xb_ld(&bar[XB_XGEN(b.x)]) == gen, bar);
            __builtin_amdgcn_fence(__ATOMIC_ACQUIRE, "agent");
            asm volatile("s_waitcnt vmcnt(0)" ::: "memory");
        }
    }
    __syncthreads();
}

constexpr int NPHASE = 14;
__global__ void __launch_bounds__(NTHREADS, 2) mk_fwd(Args args) {
    extern __shared__ __attribute__((aligned(16))) unsigned char lds_raw[];
    LAS unsigned char* lds = (LAS unsigned char*)lds_raw;
    cg::grid_group grid = cg::this_grid();
    const int tid = threadIdx.x, lane = tid & 63, wave = __builtin_amdgcn_readfirstlane(tid >> 6);
    const int G = gridDim.x, bid = blockIdx.x;
    const int vcu = (G % 8 == 0) ? (bid % 8) * (G / 8) + bid / 8 : bid;
    const int gw = vcu * NWAVES + wave, NGW = G * NWAVES, gtid = vcu * NTHREADS + tid, NGT = G * NTHREADS;
    unsigned char* ws = args.ws;
    const int lo = args.ph_lo, hi = args.ph_hi;
#define IN(k) (lo <= (k) && (k) < hi)
    if (tid < 64) ((LAS unsigned*)(lds + RING_BYTES))[tid] = 0u;
    __syncthreads();
    XcdBarrier bar; bar.bar = (unsigned*)ws; bar.x = 0; bar.st = nullptr;
    if (hi - lo > 1) bar = xcd_barrier_post((unsigned*)ws, (volatile LAS unsigned*)(lds + RING_BYTES) + 8);
#ifdef PROBE_K
#define STAMP(k) do { if (bid == 0 && tid == 0) ((unsigned long long*)(ws + 255 * MiB))[(k)] = __builtin_amdgcn_s_memrealtime(); } while (0)
#else
#define STAMP(k) do { } while (0)
#endif
#define SEAM(k) do { if (IN(k) && IN((k) + 1)) xcd_barrier(bar); STAMP((k) + 1); } while (0)
    STAMP(0);
    if (hi > 1000) grid.sync();
    float* X = args.out;
    float* rsq = (float*)(ws + WS_RSQ);
    bf16* XB = (bf16*)(ws + WS_RV);
    LAS float* rstab = (LAS float*)(lds + RING_BYTES + 1024);

    if (IN(0)) { p0_prologue(args, lds, gw, NGW, lane, wave, gtid, NGT); } SEAM(0);
    if (IN(1)) {
        pg8::Gemm g{(const bf16*)args.out, (const bf16*)(ws + WS_WAIN), M, SGF, D}; pg8::StaticOrder S; S.init(M, SGF, G, bid);
        pg8::EpiSguIn E{(bf16*)(ws + WS_RU), (bf16*)(ws + WS_RV), rsq, (pg8::f32x2*)((unsigned char*)args.out + 32 * MiB), rstab};
        pg8::gemm_phase<pg8::EpiSguIn, pg8::StaticOrder, true, true>(lds, g, S, E);
    } SEAM(1);
    if (IN(2)) { sgu_phase(lds, (const bf16*)(ws + WS_WM), (const bf16*)(ws + WS_RV), (bf16*)(ws + WS_RU), (const f32x2*)((unsigned char*)args.out + 32 * MiB), args.in[3], args.in[4], args.in[6], G, vcu, tid, lane, wave); } SEAM(2);
    if (IN(3)) {
        pg8::Gemm g{(const bf16*)(ws + WS_RU), (const bf16*)(ws + WS_WAOUT), M, D, SGW}; pg8::StaticOrder S; S.init(M, D, G, bid);
        pg8::EpiResid<true> E{args.in[0], XB, rsq};
        pg8::gemm_phase<pg8::EpiResid<true>, pg8::StaticOrder, false, true>(lds, g, S, E);
    } SEAM(3);
    if (IN(4)) {
        pg8::Gemm g{XB, (const bf16*)(ws + WS_WGU0), M, 2 * FH, D}; pg8::StaticOrder S; S.init(M, 2 * FH, G, bid);
        pg8::EpiSwiGLU E{(bf16*)(ws + WS_RU), FH, rsq, rstab};
        pg8::gemm_phase<pg8::EpiSwiGLU, pg8::StaticOrder, true, true>(lds, g, S, E);
    } SEAM(4);
    if (IN(5)) {
        pg8::Gemm g{(const bf16*)(ws + WS_RU), (const bf16*)(ws + WS_WDN0), M, D, FH}; pg8::StaticOrder S; S.init(M, D, G, bid);
        pg8::EpiResid<false> E{XB, XB, rsq};
        pg8::gemm_phase<pg8::EpiResid<false>, pg8::StaticOrder, false, true>(lds, g, S, E);
    } SEAM(5);
    bf16* Qg = (bf16*)(ws + WS_RU); bf16* Kg = (bf16*)(ws + WS_RU + 16 * MiB); bf16* Vg = (bf16*)(ws + WS_RU + 32 * MiB); bf16* SR = (bf16*)(ws + WS_RU + 64 * MiB);
    bf16* dS = (bf16*)(ws + WS_RV + 32 * MiB); float* GZ = (float*)(ws + WS_GZ); float* dec = (float*)(ws + WS_DEC);
    if (IN(6)) {
        for (int rp = vcu * 4; rp < M / 16; rp += G * 4) { const int fr = lane & 15, fq = lane >> 4, rt = rp + (wave >> 1), kh = wave & 1;
            const bf16* ap = XB + (size_t)(rt * 16 + fr) * D + 512 * kh + 8 * fq; const bf16* bp = (const bf16*)(ws + WS_WBIN) + (size_t)(3072 + fr) * D + 512 * kh + 8 * fq;
            bf16x8 av[16], bv[16];
#pragma unroll
            for (int ks = 0; ks < 16; ++ks) { av[ks] = *(const GAS bf16x8*)(bp + 32 * ks); bv[ks] = *(const GAS bf16x8*)(ap + 32 * ks); }
            f32x4 c0 = (f32x4){0.f, 0.f, 0.f, 0.f}, c1 = c0;
#pragma unroll
            for (int ks = 0; ks < 16; ks += 2) { c0 = MFMA16(av[ks], bv[ks], c0); c1 = MFMA16(av[ks + 1], bv[ks + 1], c1); }
            c0 = c0 + c1;
            LAS f32x4* xch = (LAS f32x4*)lds + (wave >> 1) * 64 + lane;
            if (kh) *xch = c0;
            __syncthreads();
            if (!kh) *(GAS f32x4*)(GZ + (size_t)(rt * 16 + fr) * 16 + 4 * fq) = (c0 + *xch) * pg8::row_rs(rsq, rt * 16 + fr);
            __syncthreads(); }
        pg8::Gemm g{XB, (const bf16*)(ws + WS_WBIN), M, 3072, D}; pg8::StaticOrder S; S.init(M, 3072, G, bid);
        pg8::EpiGlaIn E{Qg, Kg, Vg, SR, GZ, rsq, rstab};
        pg8::gemm_phase<pg8::EpiGlaIn, pg8::StaticOrder, true, true>(lds, g, S, E);
    } SEAM(6);
    if (IN(7)) { gla_state_phase(lds, Kg, Vg, GZ, args.in[9], args.in[10], dS, dec, G, vcu, tid, lane, wave); } SEAM(7);
    if (IN(8)) { gla_scan_phase(dS, dec, gtid, NGT); } SEAM(8);
    if (IN(9)) { gla_out_phase(lds, Qg, Kg, Vg, SR, GZ, args.in[9], args.in[10], args.in[11], dS, G, vcu, tid, lane, wave); } SEAM(9);
    if (IN(10)) {
        pg8::Gemm g{SR, (const bf16*)(ws + WS_WBOUT), M, D, VD}; pg8::StaticOrder S; S.init(M, D, G, bid);
        pg8::EpiResid<false> E{XB, XB, rsq};
        pg8::gemm_phase<pg8::EpiResid<false>, pg8::StaticOrder, false, true>(lds, g, S, E);
    } SEAM(10);
    if (IN(11)) {
        pg8::Gemm g{XB, (const bf16*)(ws + WS_WGU1), M, 2 * FH, D}; pg8::StaticOrder S; S.init(M, 2 * FH, G, bid);
        pg8::EpiSwiGLU E{(bf16*)(ws + WS_RU), FH, rsq, rstab};
        pg8::gemm_phase<pg8::EpiSwiGLU, pg8::StaticOrder, true, true>(lds, g, S, E);
    } SEAM(11);
    if (IN(12)) {
        pg8::Gemm g{(const bf16*)(ws + WS_RU), (const bf16*)(ws + WS_WDN1), M, D, FH}; pg8::StaticOrder S; S.init(M, D, G, bid);
        pg8::EpiResid<false> E{XB, XB, rsq};
        pg8::gemm_phase<pg8::EpiResid<false>, pg8::StaticOrder, false, true>(lds, g, S, E);
    } SEAM(12);
    if (IN(13)) {
        const float* fg = args.in[17];
        f32x4 gv[4];
#pragma unroll
        for (int j = 0; j < 4; ++j) gv[j] = *(const f32x4*)(fg + 8 * lane + 512 * (j >> 1) + 4 * (j & 1));
        for (int m0 = gw; m0 < M; m0 += 8 * NGW) { v4u w[8][2]; float rs[8];
#pragma unroll
            for (int r = 0; r < 8; ++r) { const int m = m0 + r * NGW; if (m < M) { const GAS v4u* xr = (const GAS v4u*)(XB + (size_t)m * D) + lane; w[r][0] = xr[0]; w[r][1] = xr[64]; rs[r] = pg8::row_rs(rsq, m); } }
#pragma unroll
            for (int r = 0; r < 8; ++r) { const int m = m0 + r * NGW; if (m < M) { GAS f32x4* o = (GAS f32x4*)(X + (size_t)m * D) + 2 * lane;
#pragma unroll
                for (int hh = 0; hh < 2; ++hh) { const v4u q = w[r][hh];
                    o[128 * hh] = (f32x4){bf_lo(q.x), bf_hi(q.x), bf_lo(q.y), bf_hi(q.y)} * rs[r] * gv[2 * hh];
                    o[128 * hh + 1] = (f32x4){bf_lo(q.z), bf_hi(q.z), bf_lo(q.w), bf_hi(q.w)} * rs[r] * gv[2 * hh + 1]; } } } }
    }
#ifdef PROBE_K
    xcd_barrier(bar);
    if (bid == 0 && tid == 0) { const unsigned long long* ts = (const unsigned long long*)(ws + 255 * MiB); X[0] = (float)(ts[PROBE_K + 1] - ts[PROBE_K]) * 0.001f; }
#endif
#undef IN
#undef SEAM
}


__global__ void digest_k(const unsigned short* a, size_t na, const float* f, size_t nf, float* out) {
    const size_t n = (size_t)16384 * 1024;
    for (size_t i = (size_t)blockIdx.x * blockDim.x + threadIdx.x; i < n; i += (size_t)gridDim.x * blockDim.x) {
        float v = 0.f;
        for (size_t k = 0; k * n + i < na; ++k) v += __builtin_bit_cast(float, (unsigned)a[k * n + i] << 16);
        if (nf) v += f[i % nf];
        if (!(fabsf(v) < 1e30f)) v = 1e30f;
        out[i] = v;
    }
}
#ifndef MK_N_LAUNCHES
#define MK_N_LAUNCHES 1
#define DBG_NPH 14
#endif
extern "C" void kernel_launch(void* const* d_in, const int* in_sizes, int n_in, void* d_out, int out_size, void* d_ws, size_t ws_size, hipStream_t stream) {
    static int grid = 0;
    if (grid == 0) {
        if (n_in != 18 || in_sizes[0] != M * D || out_size != M * D || ws_size < WS_END) { fprintf(stderr, "kernel_launch: unexpected shapes (n_in %d, in0 %d, out %d, ws %zu); nothing launched\n", n_in, n_in > 0 ? in_sizes[0] : -1, out_size, ws_size); grid = -1; return; }
        int dev = 0, cus = 0, per_cu = 0;
        if (hipGetDevice(&dev) != hipSuccess || hipDeviceGetAttribute(&cus, hipDeviceAttributeMultiprocessorCount, dev) != hipSuccess) { grid = -1; return; }
        if (hipFuncSetAttribute((const void*)mk_fwd, hipFuncAttributeMaxDynamicSharedMemorySize, LDS_BYTES) != hipSuccess) { fprintf(stderr, "kernel_launch: hipFuncSetAttribute failed\n"); grid = -1; return; }
        if (hipOccupancyMaxActiveBlocksPerMultiprocessor(&per_cu, (const void*)mk_fwd, NTHREADS, LDS_BYTES) != hipSuccess || per_cu < 1) { fprintf(stderr, "kernel_launch: occupancy query gives %d blocks per CU\n", per_cu); (void)hipGetLastError(); grid = -1; return; }
        grid = cus;
        if (grid != 256) { fprintf(stderr, "kernel_launch: built for a 256-CU device (got %d)\n", cus); grid = -1; return; }
    }
    if (grid < 0) return;
    Args a{};
    for (int i = 0; i < 18; ++i) a.in[i] = (const float*)d_in[i];
    a.out = (float*)d_out; a.ws = (unsigned char*)d_ws;
#if MK_N_LAUNCHES == 1
    if (hipMemsetAsync(d_ws, 0, 16384, stream) != hipSuccess) { fprintf(stderr, "kernel_launch: memset of the barrier words failed\n"); return; }
    a.ph_lo = 0; a.ph_hi = NPHASE;
    void* kargs[] = {&a};
    hipError_t e = hipLaunchCooperativeKernel((const void*)mk_fwd, dim3(grid), dim3(NTHREADS), kargs, LDS_BYTES, stream);
    if (e != hipSuccess) fprintf(stderr, "kernel_launch: cooperative launch failed: %s\n", hipGetErrorString(e));
#else
    for (int p = 0; p < DBG_NPH; ++p) { a.ph_lo = p; a.ph_hi = p + 1; hipLaunchKernelGGL(mk_fwd, dim3(grid), dim3(NTHREADS), LDS_BYTES, stream, a); }
#ifdef DBG_DIG
    { unsigned char* w = (unsigned char*)d_ws; const size_t n16 = (size_t)16384 * 1024;
      const unsigned short* da = nullptr; size_t na = 0; const float* df = nullptr; size_t nf = 0;
      if (DBG_DIG == 6) { da = (const unsigned short*)(w + WS_RU); na = 3 * n16; df = (const float*)(w + WS_GZ); nf = 262144; }
      if (DBG_DIG == 7 || DBG_DIG == 8) { da = (const unsigned short*)(w + WS_RV + 32 * MiB); na = 2 * n16; df = (const float*)(w + WS_DEC); nf = 131072; }
      if (DBG_DIG == 9) { da = (const unsigned short*)(w + WS_RU + 64 * MiB); na = n16; }
      hipLaunchKernelGGL(digest_k, dim3(2048), dim3(256), 0, stream, da, na, df, nf, (float*)d_out); }
#endif
#endif
}
```
